# Optimizing an MI355X kernel written in HIP

```python
import math
import jax, jax.numpy as jnp
from jax import lax
import numpy as np

D_MODEL = 1024
BATCH = 16
SEQ = 2048
DEPTH = 2

N_MIXERS = 2
N_META = 16
N_HEADS = 16
HEAD_DIM = D_MODEL // N_HEADS
N_IDX_HEADS = 8
IDX_DIM = 64
TOPK_MAX = 256
Q_BLOCK = 128
REL_BUCKETS = 32
REL_MAX_DIST = 128
CONV_WIDTH = 31
D_FF = -(-8 * D_MODEL // (3 * 256)) * 256
LN_EPS = 1e-5
DEEPNORM_ALPHA = (2 * DEPTH) ** 0.25
DEEPNORM_BETA = (8 * DEPTH) ** -0.25

N_ATTN_LAYERS = (DEPTH + N_MIXERS - 1) // N_MIXERS
N_CONV_LAYERS = DEPTH // N_MIXERS

ATTN_W = N_HEADS * HEAD_DIM
SPLITS = [ATTN_W, 2 * ATTN_W, 3 * ATTN_W,
          3 * ATTN_W + N_IDX_HEADS * IDX_DIM,
          3 * ATTN_W + N_IDX_HEADS * IDX_DIM + IDX_DIM]
IN_W = SPLITS[-1] + N_IDX_HEADS

kernel_name = "hybrid_dsa_conformer_deepnorm"


def layer_norm(x, g, b):
    xf = x.astype(jnp.float32)
    mu = jnp.mean(xf, axis=-1, keepdims=True)
    var = jnp.mean(jnp.square(xf - mu), axis=-1, keepdims=True)
    return ((xf - mu) * lax.rsqrt(var + LN_EPS)).astype(x.dtype) * g + b


def t5_bucket(dist):
    max_exact = REL_BUCKETS // 2
    d = jnp.maximum(dist, 1).astype(jnp.float32)
    large = max_exact + (jnp.log(d / max_exact) / math.log(REL_MAX_DIST / max_exact)
                         * (REL_BUCKETS - max_exact)).astype(jnp.int32)
    large = jnp.minimum(large, REL_BUCKETS - 1)
    return jnp.where(dist < max_exact, dist, large)


def dsa_attention(h, w_in, w_o, rel_bias, k_top):
    B, T, _ = h.shape
    proj = h @ w_in
    q, k, v, qi, ki, wi = jnp.split(proj, SPLITS, axis=-1)
    q = q.reshape(B, T, N_HEADS, HEAD_DIM)
    k = k.reshape(B, T, N_HEADS, HEAD_DIM)
    v = v.reshape(B, T, N_HEADS, HEAD_DIM)
    qi = qi.reshape(B, T, N_IDX_HEADS, IDX_DIM)
    wi = wi * (N_IDX_HEADS ** -0.5 * IDX_DIM ** -0.5)
    n_blk = -(-T // Q_BLOCK)
    pad = n_blk * Q_BLOCK - T
    padq = lambda a: jnp.pad(a, [(0, 0), (0, pad)] + [(0, 0)] * (a.ndim - 2))
    q_p, qi_p, wi_p = padq(q), padq(qi), padq(wi)
    key_pos = jnp.arange(T)
    scale = HEAD_DIM ** -0.5
    gather = jax.vmap(lambda a, idx: a[idx])

    def block(i):
        q0 = i * Q_BLOCK
        qb = lax.dynamic_slice_in_dim(q_p, q0, Q_BLOCK, axis=1)
        qib = lax.dynamic_slice_in_dim(qi_p, q0, Q_BLOCK, axis=1)
        wib = lax.dynamic_slice_in_dim(wi_p, q0, Q_BLOCK, axis=1)
        t = q0 + jnp.arange(Q_BLOCK)
        causal = key_pos[None, :] <= t[:, None]
        idx_logits = jnp.einsum('bqhd,bsd->bqhs', qib, ki)
        score = jnp.einsum('bqhs,bqh->bqs', jax.nn.relu(idx_logits), wib).astype(jnp.float32)
        score = jnp.where(causal[None], score, -jnp.inf)
        top_val, top_idx = lax.top_k(score, k_top)
        valid = jnp.isfinite(top_val)
        k_sel = gather(k, top_idx)
        v_sel = gather(v, top_idx)
        dist = jnp.maximum(t[None, :, None] - top_idx, 0)
        bias = rel_bias[t5_bucket(dist)]
        logits = (jnp.einsum('bqhd,bqkhd->bqhk', qb, k_sel).astype(jnp.float32) * scale
                  + jnp.transpose(bias, (0, 1, 3, 2)).astype(jnp.float32))
        logits = jnp.where(valid[:, :, None, :], logits, -jnp.inf)
        p = jax.nn.softmax(logits, axis=-1).astype(v.dtype)
        return jnp.einsum('bqhk,bqkhd->bqhd', p, v_sel)

    out = lax.map(block, jnp.arange(n_blk))
    out = jnp.transpose(out, (1, 0, 2, 3, 4)).reshape(B, n_blk * Q_BLOCK, ATTN_W)[:, :T]
    return out @ w_o


def conformer_conv(h, w_pw1, b_pw1, w_dw, b_dw, ln_g, ln_b, w_pw2, b_pw2):
    D = h.shape[-1]
    a = h @ w_pw1 + b_pw1
    u = a[..., :D] * jax.nn.sigmoid(a[..., D:])
    y = lax.conv_general_dilated(u, w_dw[:, None, :], window_strides=(1,),
                                 padding=[(CONV_WIDTH - 1, 0)],
                                 dimension_numbers=('NWC', 'WIO', 'NWC'),
                                 feature_group_count=D) + b_dw
    y = jax.nn.silu(layer_norm(y, ln_g, ln_b))
    return y @ w_pw2 + b_pw2


def swiglu(h, w_gate, w_up, w_down):
    return (jax.nn.silu(h @ w_gate) * (h @ w_up)) @ w_down


def setup_inputs(seed: int = 0) -> dict:
    key = jax.random.key(seed)
    ks = jax.random.split(key, 24)
    nrm = lambda k, shape, s: jax.random.normal(k, shape, jnp.float32) * s
    D = D_MODEL
    col_scale = jnp.ones((IN_W,), jnp.float32).at[2 * ATTN_W:3 * ATTN_W].set(DEEPNORM_BETA)
    return {
        "x": nrm(ks[0], (BATCH, SEQ, D), 1.0),
        "meta_tokens": nrm(ks[1], (N_META, D), 1.0),
        "rel_bias": nrm(ks[2], (REL_BUCKETS, N_HEADS), 0.5),
        "w_in_attn": nrm(ks[3], (N_ATTN_LAYERS, D, IN_W), D ** -0.5) * col_scale,
        "w_o_attn": nrm(ks[4], (N_ATTN_LAYERS, ATTN_W, D), ATTN_W ** -0.5 * DEEPNORM_BETA),
        "w_pw1": nrm(ks[5], (N_CONV_LAYERS, D, 2 * D), D ** -0.5),
        "b_pw1": nrm(ks[6], (N_CONV_LAYERS, 2 * D), 0.02),
        "w_dw": nrm(ks[7], (N_CONV_LAYERS, CONV_WIDTH, D), CONV_WIDTH ** -0.5),
        "b_dw": nrm(ks[8], (N_CONV_LAYERS, D), 0.02),
        "conv_ln_g": 1.0 + nrm(ks[9], (N_CONV_LAYERS, D), 0.02),
        "conv_ln_b": nrm(ks[10], (N_CONV_LAYERS, D), 0.02),
        "w_pw2": nrm(ks[11], (N_CONV_LAYERS, D, D), D ** -0.5 * DEEPNORM_BETA),
        "b_pw2": nrm(ks[12], (N_CONV_LAYERS, D), 0.02),
        "ln1_g": 1.0 + nrm(ks[13], (DEPTH, D), 0.02),
        "ln1_b": nrm(ks[14], (DEPTH, D), 0.02),
        "ffn_w_gate": nrm(ks[15], (DEPTH, D, D_FF), D ** -0.5),
        "ffn_w_up": nrm(ks[16], (DEPTH, D, D_FF), D ** -0.5),
        "ffn_w_down": nrm(ks[17], (DEPTH, D_FF, D), D_FF ** -0.5 * DEEPNORM_BETA),
        "ln2_g": 1.0 + nrm(ks[18], (DEPTH, D), 0.02),
        "ln2_b": nrm(ks[19], (DEPTH, D), 0.02),
    }


def reference(x, meta_tokens, rel_bias, w_in_attn, w_o_attn, w_pw1, b_pw1, w_dw, b_dw,
              conv_ln_g, conv_ln_b, w_pw2, b_pw2, ln1_g, ln1_b, ffn_w_gate, ffn_w_up,
              ffn_w_down, ln2_g, ln2_b):
    B, S, D = x.shape
    k_top = min(TOPK_MAX, S // 4)
    meta = jnp.broadcast_to(meta_tokens[None].astype(x.dtype), (B, N_META, D))
    h = jnp.concatenate([meta, x], axis=1)
    for i in range(DEPTH):
        j = i // N_MIXERS
        if i % N_MIXERS == 0:
            mix = dsa_attention(h, w_in_attn[j], w_o_attn[j], rel_bias, k_top)
        else:
            mix = conformer_conv(h, w_pw1[j], b_pw1[j], w_dw[j], b_dw[j],
                                 conv_ln_g[j], conv_ln_b[j], w_pw2[j], b_pw2[j])
        h = layer_norm(DEEPNORM_ALPHA * h + mix, ln1_g[i], ln1_b[i])
        ffn = swiglu(h, ffn_w_gate[i], ffn_w_up[i], ffn_w_down[i])
        h = layer_norm(DEEPNORM_ALPHA * h + ffn, ln2_g[i], ln2_b[i])
    return h[:, N_META:]
```

```cpp
#include <hip/hip_runtime.h>
#include <hip/hip_cooperative_groups.h>
#include <cstdio>
#include <cstdint>
namespace cg = cooperative_groups;

#ifndef MODE_COOP
#define MODE_COOP 0
#endif

#define DEVFN __device__ __forceinline__
typedef _Float16 half_t;
typedef _Float16 f16x8 __attribute__((ext_vector_type(8)));
typedef _Float16 f16x4 __attribute__((ext_vector_type(4)));
typedef _Float16 f16x2 __attribute__((ext_vector_type(2)));
typedef float f32x4 __attribute__((ext_vector_type(4)));

constexpr int D = 1024, NBATCH = 16, SEQ = 2048, NMETA = 16;
constexpr int MX = NBATCH * SEQ;
constexpr int MV = MX + NMETA;
constexpr int MP = 33024;
constexpr int NPROJ = 3840, NPROJ_VALID = 3656;
constexpr int DFF = 2816;
constexpr int COL_K = 1024, COL_V = 2048, COL_QI = 3072, COL_KI = 3584, COL_WI = 3648;
constexpr int MASK_W64 = 33;
constexpr float ALPHA = 1.41421356237309515f;
constexpr float LN_EPS = 1e-5f;
constexpr int NTHREADS = 256;

constexpr size_t MiB = 1u << 20;
constexpr size_t OFF_W_IN = 0, OFF_W_O = 8 * MiB, OFF_W_GU0 = 10 * MiB, OFF_W_GU1 = 21 * MiB, OFF_W_D0 = 32 * MiB, OFF_W_D1 = 38 * MiB,
                 OFF_W_PW1 = 44 * MiB, OFF_W_PW2 = 48 * MiB, OFF_MASK = 50 * MiB, OFF_R = 60 * MiB, OFF_HA = 190 * MiB, OFF_BIG = 256 * MiB,
                 OFF_C = OFF_BIG + 65 * MiB, WS_END = OFF_BIG + 242 * MiB;
static_assert((size_t)NPROJ * D * 2 <= 8 * MiB && (size_t)2 * DFF * D * 2 <= 11 * MiB && (size_t)DFF * D * 2 <= 6 * MiB, "weights");
static_assert((size_t)MP * MASK_W64 * 8 <= 10 * MiB && (size_t)MP * D * 4 <= 130 * MiB && (size_t)MP * D * 2 <= 65 * MiB && (size_t)MP * NPROJ * 2 <= 242 * MiB, "acts");

struct Params {
    const float *x, *meta, *rel_bias, *w_in, *w_o, *w_pw1, *b_pw1, *w_dw, *b_dw, *cln_g, *cln_b, *w_pw2, *b_pw2, *ln1_g, *ln1_b, *wg, *wu, *wd, *ln2_g, *ln2_b;
    float* out; unsigned char* ws;
};

DEVFN float wave_sum(float v) {
#pragma unroll
    for (int o = 1; o < 64; o <<= 1) v += __shfl_xor(v, o);
    return v;
}
DEVFN float sigmoidf_(float x) { return 1.0f / (1.0f + __expf(-x)); }

DEVFN void prep_tile(const float* srcA, const float* srcB, int ld, int K, int Nsrc, int mode, half_t* dst, int tile, float* scr  ) {
    const int nkt = K / 32, tn = tile / nkt, tk = tile % nkt, n0 = tn * 32, k0 = tk * 32;
    const int tx = threadIdx.x & 31, ty = threadIdx.x >> 5;
#pragma unroll
    for (int i = 0; i < 4; ++i) {
        const int k = k0 + ty + 8 * i, n = n0 + tx; float v = 0.f;
        if (mode == 0) { if (n < Nsrc) v = srcA[(size_t)k * ld + n]; }
        else { const float* s = (n & 1) ? srcB : srcA; v = s[(size_t)k * ld + (n >> 1)]; }
        scr[(ty + 8 * i) * 33 + tx] = v;
    }
    __syncthreads();
#pragma unroll
    for (int i = 0; i < 4; ++i) {
        const int n = n0 + ty + 8 * i, k = k0 + tx;
        dst[(size_t)n * K + k] = (half_t)scr[tx * 33 + ty + 8 * i];
    }
    __syncthreads();
}

DEVFN void phase_prep(const Params& P, char* lds, int bid, int nb) {
    float* scr = (float*)lds;
    unsigned char* ws = P.ws;
    constexpr int T_IN = (NPROJ / 32) * (D / 32), T_SQ = (D / 32) * (D / 32), T_GU = (2 * DFF / 32) * (D / 32), T_DN = (D / 32) * (DFF / 32), T_PW1 = (2 * D / 32) * (D / 32);
    constexpr int TOTAL = T_IN + T_SQ + 2 * T_GU + 2 * T_DN + T_PW1 + T_SQ;
    for (int it = bid; it < TOTAL; it += nb) {
        int r = it;
        if (r < T_IN) { prep_tile(P.w_in, nullptr, NPROJ_VALID, D, NPROJ_VALID, 0, (half_t*)(ws + OFF_W_IN), r, scr); continue; } r -= T_IN;
        if (r < T_SQ) { prep_tile(P.w_o, nullptr, D, D, D, 0, (half_t*)(ws + OFF_W_O), r, scr); continue; } r -= T_SQ;
        if (r < T_GU) { prep_tile(P.wg, P.wu, DFF, D, DFF, 1, (half_t*)(ws + OFF_W_GU0), r, scr); continue; } r -= T_GU;
        if (r < T_GU) { prep_tile(P.wg + (size_t)D * DFF, P.wu + (size_t)D * DFF, DFF, D, DFF, 1, (half_t*)(ws + OFF_W_GU1), r, scr); continue; } r -= T_GU;
        if (r < T_DN) { prep_tile(P.wd, nullptr, D, DFF, D, 0, (half_t*)(ws + OFF_W_D0), r, scr); continue; } r -= T_DN;
        if (r < T_DN) { prep_tile(P.wd + (size_t)DFF * D, nullptr, D, DFF, D, 0, (half_t*)(ws + OFF_W_D1), r, scr); continue; } r -= T_DN;
        if (r < T_PW1) { prep_tile(P.w_pw1, P.w_pw1 + D, 2 * D, D, D, 1, (half_t*)(ws + OFF_W_PW1), r, scr); continue; } r -= T_PW1;
        prep_tile(P.w_pw2, nullptr, D, D, D, 0, (half_t*)(ws + OFF_W_PW2), r, scr);
    }
    float* R = (float*)(ws + OFF_R); half_t* HA = (half_t*)(ws + OFF_HA);
    const int lane = threadIdx.x & 63, gw = bid * (NTHREADS / 64) + (threadIdx.x >> 6), ngw = nb * (NTHREADS / 64);
    for (int r = gw; r < MP; r += ngw) {
        const float* src = r < MX ? P.x + (size_t)r * D : (r < MV ? P.meta + (size_t)(r - MX) * D : nullptr);
#pragma unroll
        for (int j = 0; j < 4; ++j) {
            const int c = lane * 4 + 256 * j;
            f32x4 v = src ? *(const f32x4*)(src + c) : (f32x4){0.f, 0.f, 0.f, 0.f};
            *(f32x4*)(R + (size_t)r * D + c) = v;
            f16x4 h; h[0] = (half_t)v[0]; h[1] = (half_t)v[1]; h[2] = (half_t)v[2]; h[3] = (half_t)v[3];
            *(f16x4*)(HA + (size_t)r * D + c) = h;
        }
    }
}

struct EpiStoreF16 { half_t* O; int ld;
    DEVFN void operator()(int row, int col, f32x4 v) const { f16x4 h; h[0] = (half_t)v[0]; h[1] = (half_t)v[1]; h[2] = (half_t)v[2]; h[3] = (half_t)v[3]; *(f16x4*)(O + (size_t)row * ld + col) = h; } };
struct EpiSwiGLU { half_t* O; int ld;
    DEVFN void operator()(int row, int col, f32x4 v) const { f16x2 h; h[0] = (half_t)(v[0] * sigmoidf_(v[0]) * v[1]); h[1] = (half_t)(v[2] * sigmoidf_(v[2]) * v[3]); *(f16x2*)(O + (size_t)row * ld + (col >> 1)) = h; } };
struct EpiGLU { half_t* O; int ld; const float* bias;
    DEVFN void operator()(int row, int col, f32x4 v) const { const int j = col >> 1; f16x2 h;
        h[0] = (half_t)((v[0] + bias[j]) * sigmoidf_(v[1] + bias[D + j])); h[1] = (half_t)((v[2] + bias[j + 1]) * sigmoidf_(v[3] + bias[D + j + 1])); *(f16x2*)(O + (size_t)row * ld + j) = h; } };
struct EpiResid { float* R; const float* bias;
    DEVFN void operator()(int row, int col, f32x4 v) const { float* p = R + (size_t)row * D + col; f32x4 r = *(f32x4*)p; f32x4 b = bias ? *(const f32x4*)(bias + col) : (f32x4){0.f, 0.f, 0.f, 0.f};
        *(f32x4*)p = r * ALPHA + v + b; } };

constexpr int G_LDS_STRIDE = 40;
template <class Epi>
DEVFN void gemm_phase(const half_t* A, const half_t* Bt, int M, int N, int K, const Epi& epi, char* lds, int bid, int nb) {
    half_t* sA = (half_t*)lds; half_t* sB = sA + 128 * G_LDS_STRIDE;
    const int tid = threadIdx.x, lane = tid & 63, wid = tid >> 6, wr = wid >> 1, wc = wid & 1, fr = lane & 15, fq = lane >> 4;
    const int nTn = N / 128, nT = (M / 128) * nTn;
    for (int tile = bid; tile < nT; tile += nb) {
        const int tm = tile / nTn, tn = tile % nTn;
        f32x4 acc[4][4];
#pragma unroll
        for (int m = 0; m < 4; ++m)
#pragma unroll
            for (int n = 0; n < 4; ++n) acc[m][n] = (f32x4){0.f, 0.f, 0.f, 0.f};
        const half_t* Ab = A + (size_t)tm * 128 * K; const half_t* Bb = Bt + (size_t)tn * 128 * K;
        for (int k0 = 0; k0 < K; k0 += 32) {
#pragma unroll
            for (int i = 0; i < 2; ++i) { const int idx = tid + 256 * i, row = idx >> 2, ch = idx & 3;
                *(f16x8*)(sA + row * G_LDS_STRIDE + ch * 8) = *(const f16x8*)(Ab + (size_t)row * K + k0 + ch * 8);
                *(f16x8*)(sB + row * G_LDS_STRIDE + ch * 8) = *(const f16x8*)(Bb + (size_t)row * K + k0 + ch * 8); }
            __syncthreads();
            f16x8 af[4], bf[4];
#pragma unroll
            for (int m = 0; m < 4; ++m) af[m] = *(const f16x8*)(sA + (wr * 64 + m * 16 + fr) * G_LDS_STRIDE + fq * 8);
#pragma unroll
            for (int n = 0; n < 4; ++n) bf[n] = *(const f16x8*)(sB + (wc * 64 + n * 16 + fr) * G_LDS_STRIDE + fq * 8);
#pragma unroll
            for (int m = 0; m < 4; ++m)
#pragma unroll
                for (int n = 0; n < 4; ++n) acc[m][n] = __builtin_amdgcn_mfma_f32_16x16x32_f16(bf[n], af[m], acc[m][n], 0, 0, 0);
            __syncthreads();
        }
#pragma unroll
        for (int m = 0; m < 4; ++m)
#pragma unroll
            for (int n = 0; n < 4; ++n) epi(tm * 128 + wr * 64 + m * 16 + fr, tn * 128 + wc * 64 + n * 16 + fq * 4, acc[m][n]);
    }
}

DEVFN void phase_ln(const Params& P, const float* g, const float* b, float* out, int bid, int nb) {
    float* R = (float*)(P.ws + OFF_R); half_t* HA = (half_t*)(P.ws + OFF_HA);
    const int lane = threadIdx.x & 63, gw = bid * (NTHREADS / 64) + (threadIdx.x >> 6), ngw = nb * (NTHREADS / 64);
    for (int r = gw; r < MP; r += ngw) {
        f32x4 v[4]; float s = 0.f;
#pragma unroll
        for (int j = 0; j < 4; ++j) { v[j] = *(const f32x4*)(R + (size_t)r * D + lane * 4 + 256 * j); s += (v[j][0] + v[j][1]) + (v[j][2] + v[j][3]); }
        const float mean = wave_sum(s) * (1.f / D); float q = 0.f;
#pragma unroll
        for (int j = 0; j < 4; ++j) { v[j] = v[j] - mean; q += (v[j][0] * v[j][0] + v[j][1] * v[j][1]) + (v[j][2] * v[j][2] + v[j][3] * v[j][3]); }
        const float rstd = 1.0f / sqrtf(wave_sum(q) * (1.f / D) + LN_EPS);
#pragma unroll
        for (int j = 0; j < 4; ++j) { const int c = lane * 4 + 256 * j;
            const f32x4 o = v[j] * rstd * *(const f32x4*)(g + c) + *(const f32x4*)(b + c);
            *(f32x4*)(R + (size_t)r * D + c) = o;
            f16x4 h; h[0] = (half_t)o[0]; h[1] = (half_t)o[1]; h[2] = (half_t)o[2]; h[3] = (half_t)o[3];
            *(f16x4*)(HA + (size_t)r * D + c) = h;
            if (out && r < MX) *(f32x4*)(out + (size_t)r * D + c) = o; }
    }
}

DEVFN int key_row(int b, int p) { return p < NMETA ? MX + p : b * SEQ + p - NMETA; }
DEVFN void phase_indexer(const Params& P, char* lds, int bid, int nb) {
    float* qs = (float*)lds;
    float* wsc = qs + 512;
    unsigned* sk = (unsigned*)(lds + 2048 + 64);
    unsigned* hist = sk + 2080;
    volatile int* misc = (volatile int*)(hist + 256);
    const half_t* proj = (const half_t*)(P.ws + OFF_BIG);
    const int tid = threadIdx.x;
    for (int r = bid; r < MV; r += nb) {
        unsigned long long* mrow = (unsigned long long*)(P.ws + OFF_MASK) + (size_t)r * MASK_W64;
        int b, t; if (r < MX) { b = r >> 11; t = (r & 2047) + NMETA; } else { b = 0; t = r - MX; }
        const int nk = t + 1;
        if (nk <= 256) {
            if (tid < MASK_W64) { unsigned long long bits = 0ull;
                for (int j = 0; j < 64; ++j) { const bool ok = (tid == 0) ? (j < NMETA && j < nk) : (NMETA + (tid - 1) * 64 + j < nk); if (ok) bits |= 1ull << j; }
                mrow[tid] = bits; }
            continue;
        }
        const half_t* prow = proj + (size_t)r * NPROJ;
        for (int i = tid; i < 512; i += NTHREADS) qs[i] = (float)prow[COL_QI + i];
        if (tid < 8) wsc[tid] = (float)prow[COL_WI + tid] * 0.04419417382415922f;
        __syncthreads();
        for (int p = tid; p < nk; p += NTHREADS) {
            const f16x8* kp = (const f16x8*)(proj + (size_t)key_row(b, p) * NPROJ + COL_KI);
            float kf[64];
#pragma unroll
            for (int c = 0; c < 8; ++c) { const f16x8 kv = kp[c];
#pragma unroll
                for (int j = 0; j < 8; ++j) kf[c * 8 + j] = (float)kv[j]; }
            float sc = 0.f;
#pragma unroll 1
            for (int h = 0; h < 8; ++h) { float d = 0.f;
                asm volatile("" ::: "memory");
#pragma unroll
                for (int j = 0; j < 64; ++j) d = fmaf(qs[h * 64 + j], kf[j], d);
                sc = fmaf(wsc[h], fmaxf(d, 0.f), sc); }
            unsigned u = __float_as_uint(sc); if (u == 0x80000000u) u = 0u;
            sk[p] = (u & 0x80000000u) ? ~u : (u | 0x80000000u);
        }
        __syncthreads();
        unsigned prefix = 0u, himask = 0u; int remaining = 256, cnt_eq = 0;
        for (int pass = 0; pass < 4; ++pass) {
            const int shift = 24 - 8 * pass;
            hist[tid] = 0u;
            __syncthreads();
            for (int p = tid; p < nk; p += NTHREADS) { const unsigned u = sk[p]; if ((u & himask) == prefix) atomicAdd(&hist[(u >> shift) & 255u], 1u); }
            __syncthreads();
            if (tid < 64) {
                const int l = tid;
                const unsigned c0 = hist[255 - 4 * l], c1 = hist[254 - 4 * l], c2 = hist[253 - 4 * l], c3 = hist[252 - 4 * l];
                const unsigned s = c0 + c1 + c2 + c3; unsigned incl = s;
#pragma unroll
                for (int o = 1; o < 64; o <<= 1) { const unsigned v = __shfl_up(incl, o); if (l >= o) incl += v; }
                const unsigned excl = incl - s, rem = (unsigned)remaining;
                if (excl < rem && rem <= incl) {
                    unsigned cum = excl; int sel; unsigned c;
                    if (cum + c0 >= rem) { sel = 255 - 4 * l; c = c0; }
                    else { cum += c0; if (cum + c1 >= rem) { sel = 254 - 4 * l; c = c1; }
                        else { cum += c1; if (cum + c2 >= rem) { sel = 253 - 4 * l; c = c2; } else { cum += c2; sel = 252 - 4 * l; c = c3; } } }
                    misc[0] = sel; misc[1] = (int)(rem - cum); misc[2] = (int)c;
                }
            }
            __syncthreads();
            prefix |= (unsigned)misc[0] << shift; himask |= 0xFFu << shift; remaining = misc[1]; cnt_eq = misc[2];
            __syncthreads();
        }
        if (tid == 0) { int cut = nk;
            if (cnt_eq > remaining) { int c = 0; for (int p = 0; p < nk; ++p) if (sk[p] == prefix) { if (++c == remaining) { cut = p; break; } } }
            misc[3] = cut; }
        __syncthreads();
        const int cut = misc[3];
        if (tid < MASK_W64) { unsigned long long bits = 0ull;
            for (int j = 0; j < 64; ++j) { const int p = (tid == 0) ? j : NMETA + (tid - 1) * 64 + j; const bool ok = (tid == 0 ? j < NMETA : true) && p < nk;
                if (ok) { const unsigned u = sk[p]; if (u > prefix || (u == prefix && p <= cut)) bits |= 1ull << j; } }
            mrow[tid] = bits; }
        __syncthreads();
    }
}

DEVFN int t5_bucket(int d) {
    if (d < 16) return d;
    const int bd[15] = {19, 21, 24, 27, 31, 35, 40, 46, 52, 59, 67, 77, 87, 99, 113};
    int b = 16;
#pragma unroll
    for (int i = 0; i < 15; ++i) b += (d >= bd[i]) ? 1 : 0;
    return b;
}
DEVFN void phase_attn(const Params& P, char* lds, int bid, int nb) {
    float* tb = (float*)lds;
    const int tid = threadIdx.x, head = tid >> 4;
    for (int i = tid; i < 129 * 16; i += NTHREADS) tb[i] = P.rel_bias[t5_bucket(i >> 4) * 16 + (i & 15)];
    __syncthreads();
    const half_t* proj = (const half_t*)(P.ws + OFF_BIG); half_t* AO = (half_t*)(P.ws + OFF_HA);
    for (int r = bid; r < MV; r += nb) {
        const unsigned long long* mrow = (const unsigned long long*)(P.ws + OFF_MASK) + (size_t)r * MASK_W64;
        int b, t; if (r < MX) { b = r >> 11; t = (r & 2047) + NMETA; } else { b = 0; t = r - MX; }
        float q[4]; { const f16x4 qv = *(const f16x4*)(proj + (size_t)r * NPROJ + tid * 4); q[0] = (float)qv[0]; q[1] = (float)qv[1]; q[2] = (float)qv[2]; q[3] = (float)qv[3]; }
        float m = -INFINITY, l = 0.f, o[4] = {0.f, 0.f, 0.f, 0.f};
        for (int w = 0; w < MASK_W64; ++w) {
            unsigned long long bits = mrow[w];
            while (bits) {
                const int j = __builtin_ctzll(bits); bits &= bits - 1ull;
                const int p = (w == 0) ? j : NMETA + (w - 1) * 64 + j;
                const half_t* kr = proj + (size_t)key_row(b, p) * NPROJ + tid * 4;
                const f16x4 kv = *(const f16x4*)(kr + COL_K), vv = *(const f16x4*)(kr + COL_V);
                float d = q[0] * (float)kv[0] + q[1] * (float)kv[1] + q[2] * (float)kv[2] + q[3] * (float)kv[3];
                d += __shfl_xor(d, 1); d += __shfl_xor(d, 2); d += __shfl_xor(d, 4); d += __shfl_xor(d, 8);
                int dist = t - p; dist = dist > 128 ? 128 : dist;
                const float s = d * 0.125f + tb[dist * 16 + head];
                const float mn = fmaxf(m, s), corr = __expf(m - mn), pe = __expf(s - mn);
                l = l * corr + pe;
#pragma unroll
                for (int c = 0; c < 4; ++c) o[c] = o[c] * corr + pe * (float)vv[c];
                m = mn;
            }
        }
        const float il = 1.0f / l; f16x4 h; h[0] = (half_t)(o[0] * il); h[1] = (half_t)(o[1] * il); h[2] = (half_t)(o[2] * il); h[3] = (half_t)(o[3] * il);
        *(f16x4*)(AO + (size_t)r * D + tid * 4) = h;
    }
}

DEVFN void phase_conv(const Params& P, int bid, int nb) {
    const half_t* U = (const half_t*)(P.ws + OFF_BIG); half_t* C = (half_t*)(P.ws + OFF_C);
    const int lane = threadIdx.x & 63, gw = bid * (NTHREADS / 64) + (threadIdx.x >> 6), ngw = nb * (NTHREADS / 64);
    for (int r = gw; r < MV; r += ngw) {
        int b, t; if (r < MX) { b = r >> 11; t = (r & 2047) + NMETA; } else { b = 0; t = r - MX; }
        float a[2][8];
#pragma unroll
        for (int h = 0; h < 2; ++h)
#pragma unroll
            for (int j = 0; j < 8; ++j) a[h][j] = P.b_dw[h * 512 + lane * 8 + j];
        for (int k = 0; k < 31; ++k) {
            const int p = t - 30 + k; if (p < 0) continue;
            const half_t* ur = U + (size_t)key_row(b, p) * D;
#pragma unroll
            for (int h = 0; h < 2; ++h) { const int c = h * 512 + lane * 8; const f16x8 uv = *(const f16x8*)(ur + c);
                const f32x4 w0 = *(const f32x4*)(P.w_dw + (size_t)k * D + c), w1 = *(const f32x4*)(P.w_dw + (size_t)k * D + c + 4);
#pragma unroll
                for (int j = 0; j < 4; ++j) { a[h][j] = fmaf(w0[j], (float)uv[j], a[h][j]); a[h][4 + j] = fmaf(w1[j], (float)uv[4 + j], a[h][4 + j]); } }
        }
        float s = 0.f;
#pragma unroll
        for (int h = 0; h < 2; ++h)
#pragma unroll
            for (int j = 0; j < 8; ++j) s += a[h][j];
        const float mean = wave_sum(s) * (1.f / D); float q = 0.f;
#pragma unroll
        for (int h = 0; h < 2; ++h)
#pragma unroll
            for (int j = 0; j < 8; ++j) { a[h][j] -= mean; q += a[h][j] * a[h][j]; }
        const float rstd = 1.0f / sqrtf(wave_sum(q) * (1.f / D) + LN_EPS);
#pragma unroll
        for (int h = 0; h < 2; ++h) { const int c = h * 512 + lane * 8; f16x8 o;
#pragma unroll
            for (int j = 0; j < 8; ++j) { const float y = a[h][j] * rstd * P.cln_g[c + j] + P.cln_b[c + j]; o[j] = (half_t)(y * sigmoidf_(y)); }
            *(f16x8*)(C + (size_t)r * D + c) = o; }
    }
}

constexpr int N_PHASES = 16;
constexpr int LDS_BYTES = 2 * 128 * G_LDS_STRIDE * 2;
static_assert(LDS_BYTES >= 2048 + 64 + 2080 * 4 + 256 * 4 + 64 && LDS_BYTES >= 129 * 16 * 4 && LDS_BYTES >= 32 * 33 * 4, "LDS");

DEVFN void run_phase(const Params& P, int ph, char* lds, int bid, int nb) {
    unsigned char* ws = P.ws;
    half_t* HA = (half_t*)(ws + OFF_HA); half_t* BIG = (half_t*)(ws + OFF_BIG); half_t* CB = (half_t*)(ws + OFF_C); float* R = (float*)(ws + OFF_R);
    switch (ph) {
    case 0: phase_prep(P, lds, bid, nb); break;
    case 1: gemm_phase(HA, (const half_t*)(ws + OFF_W_IN), MP, NPROJ, D, EpiStoreF16{BIG, NPROJ}, lds, bid, nb); break;
    case 2: phase_indexer(P, lds, bid, nb); break;
    case 3: phase_attn(P, lds, bid, nb); break;
    case 4: gemm_phase(HA, (const half_t*)(ws + OFF_W_O), MP, D, D, EpiResid{R, nullptr}, lds, bid, nb); break;
    case 5: phase_ln(P, P.ln1_g, P.ln1_b, nullptr, bid, nb); break;
    case 6: gemm_phase(HA, (const half_t*)(ws + OFF_W_GU0), MP, 2 * DFF, D, EpiSwiGLU{BIG, DFF}, lds, bid, nb); break;
    case 7: gemm_phase(BIG, (const half_t*)(ws + OFF_W_D0), MP, D, DFF, EpiResid{R, nullptr}, lds, bid, nb); break;
    case 8: phase_ln(P, P.ln2_g, P.ln2_b, nullptr, bid, nb); break;
    case 9: gemm_phase(HA, (const half_t*)(ws + OFF_W_PW1), MP, 2 * D, D, EpiGLU{BIG, D, P.b_pw1}, lds, bid, nb); break;
    case 10: phase_conv(P, bid, nb); break;
    case 11: gemm_phase(CB, (const half_t*)(ws + OFF_W_PW2), MP, D, D, EpiResid{R, P.b_pw2}, lds, bid, nb); break;
    case 12: phase_ln(P, P.ln1_g + D, P.ln1_b + D, nullptr, bid, nb); break;
    case 13: gemm_phase(HA, (const half_t*)(ws + OFF_W_GU1), MP, 2 * DFF, D, EpiSwiGLU{BIG, DFF}, lds, bid, nb); break;
    case 14: gemm_phase(BIG, (const half_t*)(ws + OFF_W_D1), MP, D, DFF, EpiResid{R, nullptr}, lds, bid, nb); break;
    case 15: phase_ln(P, P.ln2_g + D, P.ln2_b + D, P.out, bid, nb); break;
    default: break;
    }
}

#if MODE_COOP
__global__ void __launch_bounds__(NTHREADS) fwd_mega(Params P) {
    __shared__ __attribute__((aligned(16))) char lds[LDS_BYTES];
    cg::grid_group grid = cg::this_grid();
    for (int ph = 0; ph < N_PHASES; ++ph) {
        run_phase(P, ph, lds, blockIdx.x, gridDim.x);
        if (ph + 1 < N_PHASES) grid.sync();
    }
}
#else
template <int PH> __global__ void __launch_bounds__(NTHREADS) fwd_phase(Params P) {
    __shared__ __attribute__((aligned(16))) char lds[LDS_BYTES];
    run_phase(P, PH, lds, blockIdx.x, gridDim.x);
}
template <int PH> static void launch_phases(const Params& p, hipStream_t stream) {
    hipLaunchKernelGGL(fwd_phase<PH>, dim3(2048), dim3(NTHREADS), 0, stream, p);
    if constexpr (PH + 1 < N_PHASES) launch_phases<PH + 1>(p, stream);
}
#endif

extern "C" void kernel_launch(void* const* d_in, const int* in_sizes, int n_in, void* d_out, int out_size, void* d_ws, size_t ws_size, hipStream_t stream) {
    if (n_in != 20 || ws_size < WS_END || out_size != MX * D) { fprintf(stderr, "kernel_launch: unexpected sizes n_in %d ws %zu out %d\n", n_in, ws_size, out_size); return; }
    Params p{};
    const float** pp = (const float**)&p;
    for (int i = 0; i < 20; ++i) pp[i] = (const float*)d_in[i];
    p.out = (float*)d_out; p.ws = (unsigned char*)d_ws;
#if MODE_COOP
    static int grid_blocks = 0;
    if (!grid_blocks) {
        int dev = 0, cus = 0, per_cu = 0;
        hipGetDevice(&dev); hipDeviceGetAttribute(&cus, hipDeviceAttributeMultiprocessorCount, dev);
        hipOccupancyMaxActiveBlocksPerMultiprocessor(&per_cu, fwd_mega, NTHREADS, 0);
        if (per_cu < 1) per_cu = 1;
        grid_blocks = cus * per_cu;
    }
    void* args[] = {&p};
    hipError_t e = hipLaunchCooperativeKernel((void*)fwd_mega, dim3(grid_blocks), dim3(NTHREADS), args, 0, stream);
    if (e != hipSuccess) fprintf(stderr, "cooperative launch failed: %s (grid %d)\n", hipGetErrorString(e), grid_blocks);
#else
    launch_phases<0>(p, stream);
#endif
}
```

```cpp
#include <hip/hip_runtime.h>
#include <hip/hip_cooperative_groups.h>
#include <cstdio>
#include <cstdint>
namespace cg = cooperative_groups;

#ifndef MODE_COOP
#define MODE_COOP 1
#endif

#define DEVFN __device__ __forceinline__
typedef _Float16 half_t;
typedef _Float16 f16x8 __attribute__((ext_vector_type(8)));
typedef _Float16 f16x4 __attribute__((ext_vector_type(4)));
typedef _Float16 f16x2 __attribute__((ext_vector_type(2)));
typedef float f32x4 __attribute__((ext_vector_type(4)));

constexpr int D = 1024, NBATCH = 16, SEQ = 2048, NMETA = 16;
constexpr int MX = NBATCH * SEQ;
constexpr int MV = MX + NMETA;
constexpr int MP = 33024;
constexpr int NPROJ = 3840, NPROJ_VALID = 3656;
constexpr int DFF = 2816;
constexpr int COL_K = 1024, COL_V = 2048, COL_QI = 3072, COL_KI = 3584, COL_WI = 3648;
constexpr int MASK_W64 = 33;
constexpr float ALPHA = 1.41421356237309515f;
constexpr float LN_EPS = 1e-5f;
constexpr int NTHREADS = 256;

constexpr size_t MiB = 1u << 20;
constexpr size_t OFF_W_IN = 0, OFF_W_O = 8 * MiB, OFF_W_GU0 = 10 * MiB, OFF_W_GU1 = 21 * MiB, OFF_W_D0 = 32 * MiB, OFF_W_D1 = 38 * MiB,
                 OFF_W_PW1 = 44 * MiB, OFF_W_PW2 = 48 * MiB, OFF_MASK = 50 * MiB, OFF_R = 60 * MiB, OFF_HA = 190 * MiB, OFF_BIG = 256 * MiB,
                 OFF_C = OFF_BIG + 65 * MiB, WS_END = OFF_BIG + 242 * MiB;
static_assert((size_t)NPROJ * D * 2 <= 8 * MiB && (size_t)2 * DFF * D * 2 <= 11 * MiB && (size_t)DFF * D * 2 <= 6 * MiB, "weights");
static_assert((size_t)MP * MASK_W64 * 8 <= 10 * MiB && (size_t)MP * D * 4 <= 130 * MiB && (size_t)MP * D * 2 <= 65 * MiB && (size_t)MP * NPROJ * 2 <= 242 * MiB, "acts");

struct Params {
    const float *x, *meta, *rel_bias, *w_in, *w_o, *w_pw1, *b_pw1, *w_dw, *b_dw, *cln_g, *cln_b, *w_pw2, *b_pw2, *ln1_g, *ln1_b, *wg, *wu, *wd, *ln2_g, *ln2_b;
    float* out; unsigned char* ws;
};

DEVFN float wave_sum(float v) {
#pragma unroll
    for (int o = 1; o < 64; o <<= 1) v += __shfl_xor(v, o);
    return v;
}
DEVFN float sigmoidf_(float x) { return 1.0f / (1.0f + __expf(-x)); }

DEVFN void prep_tile(const float* srcA, const float* srcB, int ld, int K, int Nsrc, int mode, half_t* dst, int tile, float* scr  ) {
    const int nkt = K / 32, tn = tile / nkt, tk = tile % nkt, n0 = tn * 32, k0 = tk * 32;
    const int tx = threadIdx.x & 31, ty = threadIdx.x >> 5;
#pragma unroll
    for (int i = 0; i < 4; ++i) {
        const int k = k0 + ty + 8 * i, n = n0 + tx; float v = 0.f;
        if (mode == 0) { if (n < Nsrc) v = srcA[(size_t)k * ld + n]; }
        else { const float* s = (n & 1) ? srcB : srcA; v = s[(size_t)k * ld + (n >> 1)]; }
        scr[(ty + 8 * i) * 33 + tx] = v;
    }
    __syncthreads();
#pragma unroll
    for (int i = 0; i < 4; ++i) {
        const int n = n0 + ty + 8 * i, k = k0 + tx;
        dst[(size_t)n * K + k] = (half_t)scr[tx * 33 + ty + 8 * i];
    }
    __syncthreads();
}

DEVFN void phase_prep(const Params& P, char* lds, int bid, int nb) {
    float* scr = (float*)lds;
    unsigned char* ws = P.ws;
    constexpr int T_IN = (NPROJ / 32) * (D / 32), T_SQ = (D / 32) * (D / 32), T_GU = (2 * DFF / 32) * (D / 32), T_DN = (D / 32) * (DFF / 32), T_PW1 = (2 * D / 32) * (D / 32);
    constexpr int TOTAL = T_IN + T_SQ + 2 * T_GU + 2 * T_DN + T_PW1 + T_SQ;
    for (int it = bid; it < TOTAL; it += nb) {
        int r = it;
        if (r < T_IN) { prep_tile(P.w_in, nullptr, NPROJ_VALID, D, NPROJ_VALID, 0, (half_t*)(ws + OFF_W_IN), r, scr); continue; } r -= T_IN;
        if (r < T_SQ) { prep_tile(P.w_o, nullptr, D, D, D, 0, (half_t*)(ws + OFF_W_O), r, scr); continue; } r -= T_SQ;
        if (r < T_GU) { prep_tile(P.wg, P.wu, DFF, D, DFF, 1, (half_t*)(ws + OFF_W_GU0), r, scr); continue; } r -= T_GU;
        if (r < T_GU) { prep_tile(P.wg + (size_t)D * DFF, P.wu + (size_t)D * DFF, DFF, D, DFF, 1, (half_t*)(ws + OFF_W_GU1), r, scr); continue; } r -= T_GU;
        if (r < T_DN) { prep_tile(P.wd, nullptr, D, DFF, D, 0, (half_t*)(ws + OFF_W_D0), r, scr); continue; } r -= T_DN;
        if (r < T_DN) { prep_tile(P.wd + (size_t)DFF * D, nullptr, D, DFF, D, 0, (half_t*)(ws + OFF_W_D1), r, scr); continue; } r -= T_DN;
        if (r < T_PW1) { prep_tile(P.w_pw1, P.w_pw1 + D, 2 * D, D, D, 1, (half_t*)(ws + OFF_W_PW1), r, scr); continue; } r -= T_PW1;
        prep_tile(P.w_pw2, nullptr, D, D, D, 0, (half_t*)(ws + OFF_W_PW2), r, scr);
    }
    float* R = (float*)(ws + OFF_R); half_t* HA = (half_t*)(ws + OFF_HA);
    const int lane = threadIdx.x & 63, gw = bid * (NTHREADS / 64) + (threadIdx.x >> 6), ngw = nb * (NTHREADS / 64);
    for (int r = gw; r < MP; r += ngw) {
        const float* src = r < MX ? P.x + (size_t)r * D : (r < MV ? P.meta + (size_t)(r - MX) * D : nullptr);
#pragma unroll
        for (int j = 0; j < 4; ++j) {
            const int c = lane * 4 + 256 * j;
            f32x4 v = src ? *(const f32x4*)(src + c) : (f32x4){0.f, 0.f, 0.f, 0.f};
            *(f32x4*)(R + (size_t)r * D + c) = v;
            f16x4 h; h[0] = (half_t)v[0]; h[1] = (half_t)v[1]; h[2] = (half_t)v[2]; h[3] = (half_t)v[3];
            *(f16x4*)(HA + (size_t)r * D + c) = h;
        }
    }
}

struct EpiStoreF16 { half_t* O; int ld;
    DEVFN void operator()(int row, int col, f32x4 v) const { f16x4 h; h[0] = (half_t)v[0]; h[1] = (half_t)v[1]; h[2] = (half_t)v[2]; h[3] = (half_t)v[3]; *(f16x4*)(O + (size_t)row * ld + col) = h; } };
struct EpiSwiGLU { half_t* O; int ld;
    DEVFN void operator()(int row, int col, f32x4 v) const { f16x2 h; h[0] = (half_t)(v[0] * sigmoidf_(v[0]) * v[1]); h[1] = (half_t)(v[2] * sigmoidf_(v[2]) * v[3]); *(f16x2*)(O + (size_t)row * ld + (col >> 1)) = h; } };
struct EpiGLU { half_t* O; int ld; const float* bias;
    DEVFN void operator()(int row, int col, f32x4 v) const { const int j = col >> 1; f16x2 h;
        h[0] = (half_t)((v[0] + bias[j]) * sigmoidf_(v[1] + bias[D + j])); h[1] = (half_t)((v[2] + bias[j + 1]) * sigmoidf_(v[3] + bias[D + j + 1])); *(f16x2*)(O + (size_t)row * ld + j) = h; } };
struct EpiResid { float* R; const float* bias;
    DEVFN void operator()(int row, int col, f32x4 v) const { float* p = R + (size_t)row * D + col; f32x4 r = *(f32x4*)p; f32x4 b = bias ? *(const f32x4*)(bias + col) : (f32x4){0.f, 0.f, 0.f, 0.f};
        *(f32x4*)p = r * ALPHA + v + b; } };

constexpr int G_LDS_STRIDE = 40;
template <class Epi>
DEVFN void gemm_phase(const half_t* A, const half_t* Bt, int M, int N, int K, const Epi& epi, char* lds, int bid, int nb) {
    half_t* sA = (half_t*)lds; half_t* sB = sA + 128 * G_LDS_STRIDE;
    const int tid = threadIdx.x, lane = tid & 63, wid = tid >> 6, wr = wid >> 1, wc = wid & 1, fr = lane & 15, fq = lane >> 4;
    const int nTn = N / 128, nT = (M / 128) * nTn;
    for (int tile = bid; tile < nT; tile += nb) {
        const int tm = tile / nTn, tn = tile % nTn;
        f32x4 acc[4][4];
#pragma unroll
        for (int m = 0; m < 4; ++m)
#pragma unroll
            for (int n = 0; n < 4; ++n) acc[m][n] = (f32x4){0.f, 0.f, 0.f, 0.f};
        const half_t* Ab = A + (size_t)tm * 128 * K; const half_t* Bb = Bt + (size_t)tn * 128 * K;
        for (int k0 = 0; k0 < K; k0 += 32) {
#pragma unroll
            for (int i = 0; i < 2; ++i) { const int idx = tid + 256 * i, row = idx >> 2, ch = idx & 3;
                *(f16x8*)(sA + row * G_LDS_STRIDE + ch * 8) = *(const f16x8*)(Ab + (size_t)row * K + k0 + ch * 8);
                *(f16x8*)(sB + row * G_LDS_STRIDE + ch * 8) = *(const f16x8*)(Bb + (size_t)row * K + k0 + ch * 8); }
            __syncthreads();
            f16x8 af[4], bf[4];
#pragma unroll
            for (int m = 0; m < 4; ++m) af[m] = *(const f16x8*)(sA + (wr * 64 + m * 16 + fr) * G_LDS_STRIDE + fq * 8);
#pragma unroll
            for (int n = 0; n < 4; ++n) bf[n] = *(const f16x8*)(sB + (wc * 64 + n * 16 + fr) * G_LDS_STRIDE + fq * 8);
#pragma unroll
            for (int m = 0; m < 4; ++m)
#pragma unroll
                for (int n = 0; n < 4; ++n) acc[m][n] = __builtin_amdgcn_mfma_f32_16x16x32_f16(bf[n], af[m], acc[m][n], 0, 0, 0);
            __syncthreads();
        }
#pragma unroll
        for (int m = 0; m < 4; ++m)
#pragma unroll
            for (int n = 0; n < 4; ++n) epi(tm * 128 + wr * 64 + m * 16 + fr, tn * 128 + wc * 64 + n * 16 + fq * 4, acc[m][n]);
    }
}

DEVFN void phase_ln(const Params& P, const float* g, const float* b, float* out, int bid, int nb) {
    float* R = (float*)(P.ws + OFF_R); half_t* HA = (half_t*)(P.ws + OFF_HA);
    const int lane = threadIdx.x & 63, gw = bid * (NTHREADS / 64) + (threadIdx.x >> 6), ngw = nb * (NTHREADS / 64);
    for (int r = gw; r < MP; r += ngw) {
        f32x4 v[4]; float s = 0.f;
#pragma unroll
        for (int j = 0; j < 4; ++j) { v[j] = *(const f32x4*)(R + (size_t)r * D + lane * 4 + 256 * j); s += (v[j][0] + v[j][1]) + (v[j][2] + v[j][3]); }
        const float mean = wave_sum(s) * (1.f / D); float q = 0.f;
#pragma unroll
        for (int j = 0; j < 4; ++j) { v[j] = v[j] - mean; q += (v[j][0] * v[j][0] + v[j][1] * v[j][1]) + (v[j][2] * v[j][2] + v[j][3] * v[j][3]); }
        const float rstd = 1.0f / sqrtf(wave_sum(q) * (1.f / D) + LN_EPS);
#pragma unroll
        for (int j = 0; j < 4; ++j) { const int c = lane * 4 + 256 * j;
            const f32x4 o = v[j] * rstd * *(const f32x4*)(g + c) + *(const f32x4*)(b + c);
            *(f32x4*)(R + (size_t)r * D + c) = o;
            f16x4 h; h[0] = (half_t)o[0]; h[1] = (half_t)o[1]; h[2] = (half_t)o[2]; h[3] = (half_t)o[3];
            *(f16x4*)(HA + (size_t)r * D + c) = h;
            if (out && r < MX) *(f32x4*)(out + (size_t)r * D + c) = o; }
    }
}

DEVFN int key_row(int b, int p) { return p < NMETA ? MX + p : b * SEQ + p - NMETA; }
DEVFN void phase_indexer(const Params& P, char* lds, int bid, int nb) {
    float* qs = (float*)lds;
    float* wsc = qs + 512;
    unsigned* sk = (unsigned*)(lds + 2048 + 64);
    unsigned* hist = sk + 2080;
    volatile int* misc = (volatile int*)(hist + 256);
    const half_t* proj = (const half_t*)(P.ws + OFF_BIG);
    const int tid = threadIdx.x;
    for (int r = bid; r < MV; r += nb) {
        unsigned long long* mrow = (unsigned long long*)(P.ws + OFF_MASK) + (size_t)r * MASK_W64;
        int b, t; if (r < MX) { b = r >> 11; t = (r & 2047) + NMETA; } else { b = 0; t = r - MX; }
        const int nk = t + 1;
        if (nk <= 256) {
            if (tid < MASK_W64) { unsigned long long bits = 0ull;
                for (int j = 0; j < 64; ++j) { const bool ok = (tid == 0) ? (j < NMETA && j < nk) : (NMETA + (tid - 1) * 64 + j < nk); if (ok) bits |= 1ull << j; }
                mrow[tid] = bits; }
            continue;
        }
        const half_t* prow = proj + (size_t)r * NPROJ;
        for (int i = tid; i < 512; i += NTHREADS) qs[i] = (float)prow[COL_QI + i];
        if (tid < 8) wsc[tid] = (float)prow[COL_WI + tid] * 0.04419417382415922f;
        __syncthreads();
        for (int p = tid; p < nk; p += NTHREADS) {
            const f16x8* kp = (const f16x8*)(proj + (size_t)key_row(b, p) * NPROJ + COL_KI);
            float kf[64];
#pragma unroll
            for (int c = 0; c < 8; ++c) { const f16x8 kv = kp[c];
#pragma unroll
                for (int j = 0; j < 8; ++j) kf[c * 8 + j] = (float)kv[j]; }
            float sc = 0.f;
#pragma unroll 1
            for (int h = 0; h < 8; ++h) { float d = 0.f;
                asm volatile("" ::: "memory");
#pragma unroll
                for (int j = 0; j < 64; ++j) d = fmaf(qs[h * 64 + j], kf[j], d);
                sc = fmaf(wsc[h], fmaxf(d, 0.f), sc); }
            unsigned u = __float_as_uint(sc); if (u == 0x80000000u) u = 0u;
            sk[p] = (u & 0x80000000u) ? ~u : (u | 0x80000000u);
        }
        __syncthreads();
        unsigned prefix = 0u, himask = 0u; int remaining = 256, cnt_eq = 0;
        for (int pass = 0; pass < 4; ++pass) {
            const int shift = 24 - 8 * pass;
            hist[tid] = 0u;
            __syncthreads();
            for (int p = tid; p < nk; p += NTHREADS) { const unsigned u = sk[p]; if ((u & himask) == prefix) atomicAdd(&hist[(u >> shift) & 255u], 1u); }
            __syncthreads();
            if (tid < 64) {
                const int l = tid;
                const unsigned c0 = hist[255 - 4 * l], c1 = hist[254 - 4 * l], c2 = hist[253 - 4 * l], c3 = hist[252 - 4 * l];
                const unsigned s = c0 + c1 + c2 + c3; unsigned incl = s;
#pragma unroll
                for (int o = 1; o < 64; o <<= 1) { const unsigned v = __shfl_up(incl, o); if (l >= o) incl += v; }
                const unsigned excl = incl - s, rem = (unsigned)remaining;
                if (excl < rem && rem <= incl) {
                    unsigned cum = excl; int sel; unsigned c;
                    if (cum + c0 >= rem) { sel = 255 - 4 * l; c = c0; }
                    else { cum += c0; if (cum + c1 >= rem) { sel = 254 - 4 * l; c = c1; }
                        else { cum += c1; if (cum + c2 >= rem) { sel = 253 - 4 * l; c = c2; } else { cum += c2; sel = 252 - 4 * l; c = c3; } } }
                    misc[0] = sel; misc[1] = (int)(rem - cum); misc[2] = (int)c;
                }
            }
            __syncthreads();
            prefix |= (unsigned)misc[0] << shift; himask |= 0xFFu << shift; remaining = misc[1]; cnt_eq = misc[2];
            __syncthreads();
        }
        if (tid == 0) { int cut = nk;
            if (cnt_eq > remaining) { int c = 0; for (int p = 0; p < nk; ++p) if (sk[p] == prefix) { if (++c == remaining) { cut = p; break; } } }
            misc[3] = cut; }
        __syncthreads();
        const int cut = misc[3];
        if (tid < MASK_W64) { unsigned long long bits = 0ull;
            for (int j = 0; j < 64; ++j) { const int p = (tid == 0) ? j : NMETA + (tid - 1) * 64 + j; const bool ok = (tid == 0 ? j < NMETA : true) && p < nk;
                if (ok) { const unsigned u = sk[p]; if (u > prefix || (u == prefix && p <= cut)) bits |= 1ull << j; } }
            mrow[tid] = bits; }
        __syncthreads();
    }
}

DEVFN int t5_bucket(int d) {
    if (d < 16) return d;
    const int bd[15] = {19, 21, 24, 27, 31, 35, 40, 46, 52, 59, 67, 77, 87, 99, 113};
    int b = 16;
#pragma unroll
    for (int i = 0; i < 15; ++i) b += (d >= bd[i]) ? 1 : 0;
    return b;
}
DEVFN void phase_attn(const Params& P, char* lds, int bid, int nb) {
    float* tb = (float*)lds;
    const int tid = threadIdx.x, head = tid >> 4;
    for (int i = tid; i < 129 * 16; i += NTHREADS) tb[i] = P.rel_bias[t5_bucket(i >> 4) * 16 + (i & 15)];
    __syncthreads();
    const half_t* proj = (const half_t*)(P.ws + OFF_BIG); half_t* AO = (half_t*)(P.ws + OFF_HA);
    for (int r = bid; r < MV; r += nb) {
        const unsigned long long* mrow = (const unsigned long long*)(P.ws + OFF_MASK) + (size_t)r * MASK_W64;
        int b, t; if (r < MX) { b = r >> 11; t = (r & 2047) + NMETA; } else { b = 0; t = r - MX; }
        float q[4]; { const f16x4 qv = *(const f16x4*)(proj + (size_t)r * NPROJ + tid * 4); q[0] = (float)qv[0]; q[1] = (float)qv[1]; q[2] = (float)qv[2]; q[3] = (float)qv[3]; }
        float m = -INFINITY, l = 0.f, o[4] = {0.f, 0.f, 0.f, 0.f};
        for (int w = 0; w < MASK_W64; ++w) {
            unsigned long long bits = mrow[w];
            while (bits) {
                const int j = __builtin_ctzll(bits); bits &= bits - 1ull;
                const int p = (w == 0) ? j : NMETA + (w - 1) * 64 + j;
                const half_t* kr = proj + (size_t)key_row(b, p) * NPROJ + tid * 4;
                const f16x4 kv = *(const f16x4*)(kr + COL_K), vv = *(const f16x4*)(kr + COL_V);
                float d = q[0] * (float)kv[0] + q[1] * (float)kv[1] + q[2] * (float)kv[2] + q[3] * (float)kv[3];
                d += __shfl_xor(d, 1); d += __shfl_xor(d, 2); d += __shfl_xor(d, 4); d += __shfl_xor(d, 8);
                int dist = t - p; dist = dist > 128 ? 128 : dist;
                const float s = d * 0.125f + tb[dist * 16 + head];
                const float mn = fmaxf(m, s), corr = __expf(m - mn), pe = __expf(s - mn);
                l = l * corr + pe;
#pragma unroll
                for (int c = 0; c < 4; ++c) o[c] = o[c] * corr + pe * (float)vv[c];
                m = mn;
            }
        }
        const float il = 1.0f / l; f16x4 h; h[0] = (half_t)(o[0] * il); h[1] = (half_t)(o[1] * il); h[2] = (half_t)(o[2] * il); h[3] = (half_t)(o[3] * il);
        *(f16x4*)(AO + (size_t)r * D + tid * 4) = h;
    }
}

DEVFN void phase_conv(const Params& P, int bid, int nb) {
    const half_t* U = (const half_t*)(P.ws + OFF_BIG); half_t* C = (half_t*)(P.ws + OFF_C);
    const int lane = threadIdx.x & 63, gw = bid * (NTHREADS / 64) + (threadIdx.x >> 6), ngw = nb * (NTHREADS / 64);
    for (int r = gw; r < MV; r += ngw) {
        int b, t; if (r < MX) { b = r >> 11; t = (r & 2047) + NMETA; } else { b = 0; t = r - MX; }
        float a[2][8];
#pragma unroll
        for (int h = 0; h < 2; ++h)
#pragma unroll
            for (int j = 0; j < 8; ++j) a[h][j] = P.b_dw[h * 512 + lane * 8 + j];
        for (int k = 0; k < 31; ++k) {
            const int p = t - 30 + k; if (p < 0) continue;
            const half_t* ur = U + (size_t)key_row(b, p) * D;
#pragma unroll
            for (int h = 0; h < 2; ++h) { const int c = h * 512 + lane * 8; const f16x8 uv = *(const f16x8*)(ur + c);
                const f32x4 w0 = *(const f32x4*)(P.w_dw + (size_t)k * D + c), w1 = *(const f32x4*)(P.w_dw + (size_t)k * D + c + 4);
#pragma unroll
                for (int j = 0; j < 4; ++j) { a[h][j] = fmaf(w0[j], (float)uv[j], a[h][j]); a[h][4 + j] = fmaf(w1[j], (float)uv[4 + j], a[h][4 + j]); } }
        }
        float s = 0.f;
#pragma unroll
        for (int h = 0; h < 2; ++h)
#pragma unroll
            for (int j = 0; j < 8; ++j) s += a[h][j];
        const float mean = wave_sum(s) * (1.f / D); float q = 0.f;
#pragma unroll
        for (int h = 0; h < 2; ++h)
#pragma unroll
            for (int j = 0; j < 8; ++j) { a[h][j] -= mean; q += a[h][j] * a[h][j]; }
        const float rstd = 1.0f / sqrtf(wave_sum(q) * (1.f / D) + LN_EPS);
#pragma unroll
        for (int h = 0; h < 2; ++h) { const int c = h * 512 + lane * 8; f16x8 o;
#pragma unroll
            for (int j = 0; j < 8; ++j) { const float y = a[h][j] * rstd * P.cln_g[c + j] + P.cln_b[c + j]; o[j] = (half_t)(y * sigmoidf_(y)); }
            *(f16x8*)(C + (size_t)r * D + c) = o; }
    }
}

constexpr int N_PHASES = 16;
constexpr int LDS_BYTES = 2 * 128 * G_LDS_STRIDE * 2;
static_assert(LDS_BYTES >= 2048 + 64 + 2080 * 4 + 256 * 4 + 64 && LDS_BYTES >= 129 * 16 * 4 && LDS_BYTES >= 32 * 33 * 4, "LDS");

DEVFN void run_phase(const Params& P, int ph, char* lds, int bid, int nb) {
    unsigned char* ws = P.ws;
    half_t* HA = (half_t*)(ws + OFF_HA); half_t* BIG = (half_t*)(ws + OFF_BIG); half_t* CB = (half_t*)(ws + OFF_C); float* R = (float*)(ws + OFF_R);
    switch (ph) {
    case 0: phase_prep(P, lds, bid, nb); break;
    case 1: gemm_phase(HA, (const half_t*)(ws + OFF_W_IN), MP, NPROJ, D, EpiStoreF16{BIG, NPROJ}, lds, bid, nb); break;
    case 2: phase_indexer(P, lds, bid, nb); break;
    case 3: phase_attn(P, lds, bid, nb); break;
    case 4: gemm_phase(HA, (const half_t*)(ws + OFF_W_O), MP, D, D, EpiResid{R, nullptr}, lds, bid, nb); break;
    case 5: phase_ln(P, P.ln1_g, P.ln1_b, nullptr, bid, nb); break;
    case 6: gemm_phase(HA, (const half_t*)(ws + OFF_W_GU0), MP, 2 * DFF, D, EpiSwiGLU{BIG, DFF}, lds, bid, nb); break;
    case 7: gemm_phase(BIG, (const half_t*)(ws + OFF_W_D0), MP, D, DFF, EpiResid{R, nullptr}, lds, bid, nb); break;
    case 8: phase_ln(P, P.ln2_g, P.ln2_b, nullptr, bid, nb); break;
    case 9: gemm_phase(HA, (const half_t*)(ws + OFF_W_PW1), MP, 2 * D, D, EpiGLU{BIG, D, P.b_pw1}, lds, bid, nb); break;
    case 10: phase_conv(P, bid, nb); break;
    case 11: gemm_phase(CB, (const half_t*)(ws + OFF_W_PW2), MP, D, D, EpiResid{R, P.b_pw2}, lds, bid, nb); break;
    case 12: phase_ln(P, P.ln1_g + D, P.ln1_b + D, nullptr, bid, nb); break;
    case 13: gemm_phase(HA, (const half_t*)(ws + OFF_W_GU1), MP, 2 * DFF, D, EpiSwiGLU{BIG, DFF}, lds, bid, nb); break;
    case 14: gemm_phase(BIG, (const half_t*)(ws + OFF_W_D1), MP, D, DFF, EpiResid{R, nullptr}, lds, bid, nb); break;
    case 15: phase_ln(P, P.ln2_g + D, P.ln2_b + D, P.out, bid, nb); break;
    default: break;
    }
}

#if MODE_COOP
__global__ void __launch_bounds__(NTHREADS, 2) fwd_mega(Params P) {
    __shared__ __attribute__((aligned(16))) char lds[LDS_BYTES];
    cg::grid_group grid = cg::this_grid();
    for (int ph = 0; ph < N_PHASES; ++ph) {
        run_phase(P, ph, lds, blockIdx.x, gridDim.x);
        if (ph + 1 < N_PHASES) grid.sync();
    }
}
#else
template <int PH> __global__ void __launch_bounds__(NTHREADS) fwd_phase(Params P) {
    __shared__ __attribute__((aligned(16))) char lds[LDS_BYTES];
    run_phase(P, PH, lds, blockIdx.x, gridDim.x);
}
template <int PH> static void launch_phases(const Params& p, hipStream_t stream) {
    hipLaunchKernelGGL(fwd_phase<PH>, dim3(2048), dim3(NTHREADS), 0, stream, p);
    if constexpr (PH + 1 < N_PHASES) launch_phases<PH + 1>(p, stream);
}
#endif

extern "C" void kernel_launch(void* const* d_in, const int* in_sizes, int n_in, void* d_out, int out_size, void* d_ws, size_t ws_size, hipStream_t stream) {
    if (n_in != 20 || ws_size < WS_END || out_size != MX * D) { fprintf(stderr, "kernel_launch: unexpected sizes n_in %d ws %zu out %d\n", n_in, ws_size, out_size); return; }
    Params p{};
    const float** pp = (const float**)&p;
    for (int i = 0; i < 20; ++i) pp[i] = (const float*)d_in[i];
    p.out = (float*)d_out; p.ws = (unsigned char*)d_ws;
#if MODE_COOP
    static int grid_blocks = 0;
    if (!grid_blocks) {
        int dev = 0, cus = 0, per_cu = 0;
        hipGetDevice(&dev); hipDeviceGetAttribute(&cus, hipDeviceAttributeMultiprocessorCount, dev);
        hipOccupancyMaxActiveBlocksPerMultiprocessor(&per_cu, fwd_mega, NTHREADS, 0);
        if (per_cu < 1) per_cu = 1;
        grid_blocks = cus * per_cu;
    }
    void* args[] = {&p};
    hipError_t e = hipLaunchCooperativeKernel((void*)fwd_mega, dim3(grid_blocks), dim3(NTHREADS), args, 0, stream);
    if (e != hipSuccess) fprintf(stderr, "cooperative launch failed: %s (grid %d)\n", hipGetErrorString(e), grid_blocks);
#else
    launch_phases<0>(p, stream);
#endif
}
```

```cpp
#include <hip/hip_runtime.h>
#include <hip/hip_cooperative_groups.h>
#include <cstdio>
#include <cstdint>
namespace cg = cooperative_groups;

#ifndef MODE_COOP
#define MODE_COOP 1
#endif

#define DEVFN __device__ __forceinline__
typedef _Float16 half_t;
typedef _Float16 f16x8 __attribute__((ext_vector_type(8)));
typedef _Float16 f16x4 __attribute__((ext_vector_type(4)));
typedef _Float16 f16x2 __attribute__((ext_vector_type(2)));
typedef float f32x4 __attribute__((ext_vector_type(4)));

constexpr int D = 1024, NBATCH = 16, SEQ = 2048, NMETA = 16;
constexpr int MX = NBATCH * SEQ;
constexpr int MV = MX + NMETA;
constexpr int MP = 33024;
constexpr int NPROJ = 3840, NPROJ_VALID = 3656;
constexpr int DFF = 2816;
constexpr int COL_K = 1024, COL_V = 2048, COL_QI = 3072, COL_KI = 3584, COL_WI = 3648;
constexpr int MASK_W64 = 33;
constexpr float ALPHA = 1.41421356237309515f;
constexpr float LN_EPS = 1e-5f;
constexpr int NTHREADS = 512;

constexpr size_t MiB = 1u << 20;
constexpr size_t OFF_W_IN = 0, OFF_W_O = 8 * MiB, OFF_W_GU0 = 10 * MiB, OFF_W_GU1 = 21 * MiB, OFF_W_D0 = 32 * MiB, OFF_W_D1 = 38 * MiB,
                 OFF_W_PW1 = 44 * MiB, OFF_W_PW2 = 48 * MiB, OFF_MASK = 50 * MiB, OFF_R = 60 * MiB, OFF_HA = 190 * MiB, OFF_BIG = 256 * MiB,
                 OFF_C = OFF_BIG + 65 * MiB, WS_END = OFF_BIG + 242 * MiB;
static_assert((size_t)NPROJ * D * 2 <= 8 * MiB && (size_t)2 * DFF * D * 2 <= 11 * MiB && (size_t)DFF * D * 2 <= 6 * MiB, "weights");
static_assert((size_t)MP * MASK_W64 * 8 <= 10 * MiB && (size_t)MP * D * 4 <= 130 * MiB && (size_t)MP * D * 2 <= 65 * MiB && (size_t)MP * NPROJ * 2 <= 242 * MiB, "acts");

struct Params {
    const float *x, *meta, *rel_bias, *w_in, *w_o, *w_pw1, *b_pw1, *w_dw, *b_dw, *cln_g, *cln_b, *w_pw2, *b_pw2, *ln1_g, *ln1_b, *wg, *wu, *wd, *ln2_g, *ln2_b;
    float* out; unsigned char* ws;
};

DEVFN float wave_sum(float v) {
#pragma unroll
    for (int o = 1; o < 64; o <<= 1) v += __shfl_xor(v, o);
    return v;
}
DEVFN float sigmoidf_(float x) { return 1.0f / (1.0f + __expf(-x)); }

DEVFN void prep_tile(const float* srcA, const float* srcB, int ld, int K, int Nsrc, int mode, half_t* dst, int tile, float* scr  ) {
    const int nkt = K / 32, tn = tile / nkt, tk = tile % nkt, n0 = tn * 32, k0 = tk * 32;
    const int tx = threadIdx.x & 31, ty = threadIdx.x >> 5;
#pragma unroll
    for (int i = 0; i < 2; ++i) {
        const int k = k0 + ty + 16 * i, n = n0 + tx; float v = 0.f;
        if (mode == 0) { if (n < Nsrc) v = srcA[(size_t)k * ld + n]; }
        else { const float* s = ((n >> 7) & 1) ? srcB : srcA; v = s[(size_t)k * ld + ((n >> 8) * 128 + (n & 127))]; }
        scr[(ty + 16 * i) * 33 + tx] = v;
    }
    __syncthreads();
#pragma unroll
    for (int i = 0; i < 2; ++i) {
        const int n = n0 + ty + 16 * i, k = k0 + tx;
        dst[(size_t)n * K + k] = (half_t)scr[tx * 33 + ty + 16 * i];
    }
    __syncthreads();
}

DEVFN void phase_prep(const Params& P, char* lds, int bid, int nb) {
    float* scr = (float*)lds;
    unsigned char* ws = P.ws;
    constexpr int T_IN = (NPROJ / 32) * (D / 32), T_SQ = (D / 32) * (D / 32), T_GU = (2 * DFF / 32) * (D / 32), T_DN = (D / 32) * (DFF / 32), T_PW1 = (2 * D / 32) * (D / 32);
    constexpr int TOTAL = T_IN + T_SQ + 2 * T_GU + 2 * T_DN + T_PW1 + T_SQ;
    for (int it = bid; it < TOTAL; it += nb) {
        int r = it;
        if (r < T_IN) { prep_tile(P.w_in, nullptr, NPROJ_VALID, D, NPROJ_VALID, 0, (half_t*)(ws + OFF_W_IN), r, scr); continue; } r -= T_IN;
        if (r < T_SQ) { prep_tile(P.w_o, nullptr, D, D, D, 0, (half_t*)(ws + OFF_W_O), r, scr); continue; } r -= T_SQ;
        if (r < T_GU) { prep_tile(P.wg, P.wu, DFF, D, DFF, 1, (half_t*)(ws + OFF_W_GU0), r, scr); continue; } r -= T_GU;
        if (r < T_GU) { prep_tile(P.wg + (size_t)D * DFF, P.wu + (size_t)D * DFF, DFF, D, DFF, 1, (half_t*)(ws + OFF_W_GU1), r, scr); continue; } r -= T_GU;
        if (r < T_DN) { prep_tile(P.wd, nullptr, D, DFF, D, 0, (half_t*)(ws + OFF_W_D0), r, scr); continue; } r -= T_DN;
        if (r < T_DN) { prep_tile(P.wd + (size_t)DFF * D, nullptr, D, DFF, D, 0, (half_t*)(ws + OFF_W_D1), r, scr); continue; } r -= T_DN;
        if (r < T_PW1) { prep_tile(P.w_pw1, P.w_pw1 + D, 2 * D, D, D, 1, (half_t*)(ws + OFF_W_PW1), r, scr); continue; } r -= T_PW1;
        prep_tile(P.w_pw2, nullptr, D, D, D, 0, (half_t*)(ws + OFF_W_PW2), r, scr);
    }
    float* R = (float*)(ws + OFF_R); half_t* HA = (half_t*)(ws + OFF_HA);
    const int lane = threadIdx.x & 63, gw = bid * (NTHREADS / 64) + (threadIdx.x >> 6), ngw = nb * (NTHREADS / 64);
    for (int r = gw; r < MP; r += ngw) {
        const float* src = r < MX ? P.x + (size_t)r * D : (r < MV ? P.meta + (size_t)(r - MX) * D : nullptr);
#pragma unroll
        for (int j = 0; j < 4; ++j) {
            const int c = lane * 4 + 256 * j;
            f32x4 v = src ? *(const f32x4*)(src + c) : (f32x4){0.f, 0.f, 0.f, 0.f};
            *(f32x4*)(R + (size_t)r * D + c) = v;
            f16x4 h; h[0] = (half_t)v[0]; h[1] = (half_t)v[1]; h[2] = (half_t)v[2]; h[3] = (half_t)v[3];
            *(f16x4*)(HA + (size_t)r * D + c) = h;
        }
    }
}

namespace pg8 {
#define PG8_LAS __attribute__((address_space(3)))
constexpr int BM = 256, BK = 64, HALF = 128, HTB = HALF * BK * 2  , STAGE_BYTES = 8 * HTB, NXCD = 8, WGM = 8;
__host__ __device__ __forceinline__ int lds_byte(int r, int c) { const int st = (r >> 4) * 2 + (c >> 5), rr = r & 15, cc = c & 31, ob = rr * 64 + cc * 2; return st * 1024 + (ob ^ (((ob >> 9) & 1) << 5)); }
__host__ __device__ __forceinline__ void stage_rc(int b, int& R, int& C) { const int st = b / 1024, sb = b % 1024, swz = sb ^ (((sb >> 9) & 1) << 5); R = (st >> 1) * 16 + swz / 64; C = (st & 1) * 32 + (swz % 64) / 2; }
__host__ __device__ __forceinline__ int perm32(int rho) { const int n = rho >> 4, i = rho & 15; return 8 * (i >> 2) + 4 * n + (i & 3); }
struct Unit { int pm, pn; };
struct Gemm { const half_t* A; const half_t* Bt; int M, N, K; };
struct StaticOrder {
    int nM, nN, nwg, G, c;
    __host__ __device__ void init(int M, int N, int G_, int c_) { nM = M / BM; nN = N / BM; nwg = nM * nN; G = G_; c = c_; }
    __host__ __device__ bool next(int i, Unit& u) const {
        const long L = (long)i * G + c; if (L >= nwg) return false;
        int wgid = (int)L; { const int q = nwg / NXCD, r = nwg % NXCD, xcd = wgid % NXCD, off = wgid / NXCD; wgid = (xcd < r ? xcd * (q + 1) : r * (q + 1) + (xcd - r) * q) + off; }
        const int nig = WGM * nN, gid = wgid / nig, fm = gid * WGM, gsz = (nM - fm) < WGM ? (nM - fm) : WGM;
        u.pm = fm + ((wgid % nig) % gsz); u.pn = (wgid % nig) / gsz; return true;
    }
};
template <class Epi, bool ALIGN_EPI = true>
__device__ __forceinline__ void gemm_phase(PG8_LAS unsigned char* lds, const Gemm g, const StaticOrder& S, const Epi& E) {
    const int tid = threadIdx.x, wid = __builtin_amdgcn_readfirstlane(tid >> 6), lane = tid & 63, wr = wid >> 2, wc = wid & 3, fr = lane & 15, fq = lane >> 4;
    const int K = g.K, nt = K / BK;
    unsigned voffA[2], voffB[2];
#pragma unroll
    for (int i = 0; i < 2; ++i) { int R, C; stage_rc(tid * 16 + i * 8192, R, C); const int Rb = (R & ~31) + perm32(R & 31);
        voffA[i] = (unsigned)(R * K + C) * 2u; voffB[i] = (unsigned)(Rb * K + C) * 2u; }
    const size_t kstep = (size_t)(BK * 2);
    const size_t hstep = (size_t)HALF * K * 2;
    const size_t tstep = 2 * hstep;
    const unsigned ldsw = (unsigned)wid * 1024u;
    const int aoff = lds_byte(wr * 64 + fr, fq * 8), boff = lds_byte(wc * 32 + fr, fq * 8);
#define PG8_SA(b, h) (((b) * 2 + (h)) * HTB)
#define PG8_SB(b, h) ((4 + (b) * 2 + (h)) * HTB)
#define PG8_STAGE(bufoff, gbase, voff) do { _Pragma("unroll") for (int _i = 0; _i < 2; ++_i) \
        __builtin_amdgcn_global_load_lds((const unsigned*)((const char*)(gbase) + (voff)[_i]), (PG8_LAS unsigned*)(lds + (bufoff) + ldsw + _i * 8192), 16, 0, 0); } while (0)
#define PG8_LDA(dst, b, h) do { _Pragma("unroll") for (int m = 0; m < 4; ++m) _Pragma("unroll") for (int k = 0; k < 2; ++k) dst[m][k] = *(const PG8_LAS f16x8*)(lds + PG8_SA(b, h) + aoff + m * 2048 + k * 1024); } while (0)
#define PG8_LDB(dst, b, h) do { _Pragma("unroll") for (int n = 0; n < 2; ++n) _Pragma("unroll") for (int k = 0; k < 2; ++k) dst[n][k] = *(const PG8_LAS f16x8*)(lds + PG8_SB(b, h) + boff + n * 2048 + k * 1024); } while (0)
#define PG8_MMA(ai, bj, At, Bt) do { __builtin_amdgcn_s_setprio(1); _Pragma("unroll") for (int m = 0; m < 4; ++m) _Pragma("unroll") for (int n = 0; n < 2; ++n) _Pragma("unroll") for (int k = 0; k < 2; ++k) \
        acc[ai][bj][m][n] = __builtin_amdgcn_mfma_f32_16x16x32_f16(Bt[n][k], At[m][k], acc[ai][bj][m][n], 0, 0, 0); __builtin_amdgcn_s_setprio(0); } while (0)
#define PG8_WAIT_V(n) asm volatile("s_waitcnt vmcnt(" #n ")" ::: "memory")
#define PG8_WAIT_L(n) asm volatile("s_waitcnt lgkmcnt(" #n ")" ::: "memory")
#define PG8_BAR __builtin_amdgcn_s_barrier()
#define PG8_SCHED __builtin_amdgcn_sched_barrier(0)
    Unit cur, nxt; int ui = 0;
    if (!S.next(0, cur)) return;
    f32x4 acc[2][2][4][2];
#pragma unroll
    for (int a = 0; a < 2; ++a)
#pragma unroll
        for (int b = 0; b < 2; ++b)
#pragma unroll
            for (int m = 0; m < 4; ++m)
#pragma unroll
                for (int n = 0; n < 2; ++n) acc[a][b][m][n] = (f32x4){0.f, 0.f, 0.f, 0.f};
    f16x8 At[4][2], B0[2][2], B1[2][2];
    const char* cA = (const char*)g.A + (size_t)cur.pm * tstep; const char* cB = (const char*)g.Bt + (size_t)cur.pn * tstep;
    E.prepare(cur, 0);
    PG8_STAGE(PG8_SB(0, 0), cB, voffB); PG8_STAGE(PG8_SB(0, 1), cB + hstep, voffB); PG8_STAGE(PG8_SA(0, 0), cA, voffA); PG8_STAGE(PG8_SA(0, 1), cA + hstep, voffA);
    if (wr == 1) PG8_BAR;
    PG8_WAIT_V(2); PG8_BAR;
    PG8_STAGE(PG8_SB(1, 0), cB + kstep, voffB); PG8_STAGE(PG8_SA(1, 0), cA + kstep, voffA); PG8_STAGE(PG8_SB(1, 1), cB + hstep + kstep, voffB);
    PG8_WAIT_V(6); PG8_BAR;
    for (;;) {
        const bool has_next = S.next(ui + 1, nxt);
        const char* nA = has_next ? (const char*)g.A + (size_t)nxt.pm * tstep : cA; const char* nB = has_next ? (const char*)g.Bt + (size_t)nxt.pn * tstep : cB;
        for (int t = 0; t < nt; t += 2) {
            const bool last = (t == nt - 2);
            const char* a1 = cA + (size_t)(t + 1) * kstep;
            const char* a2 = last ? nA : cA + (size_t)(t + 2) * kstep; const char* b2 = last ? nB : cB + (size_t)(t + 2) * kstep;
            const char* a3 = a2 + kstep; const char* b3 = b2 + kstep;
            if (last && has_next) E.prepare(nxt, (ui + 1) & 1);
            PG8_LDB(B0, 0, 0); PG8_LDB(B1, 0, 1); PG8_SCHED; PG8_LDA(At, 0, 0); PG8_STAGE(PG8_SA(1, 1), a1 + hstep, voffA);
            PG8_WAIT_V(8); PG8_WAIT_L(0); PG8_BAR; PG8_MMA(0, 0, At, B0); PG8_MMA(0, 1, At, B1); PG8_BAR; PG8_SCHED;
            PG8_LDA(At, 0, 1); PG8_STAGE(PG8_SB(0, 0), b2, voffB); PG8_STAGE(PG8_SB(0, 1), b2 + hstep, voffB); PG8_STAGE(PG8_SA(0, 0), a2, voffA);
            PG8_WAIT_V(8); PG8_WAIT_L(0); PG8_BAR; PG8_MMA(1, 0, At, B0); PG8_MMA(1, 1, At, B1); PG8_BAR; PG8_SCHED;
            PG8_LDB(B0, 1, 0); PG8_LDB(B1, 1, 1); PG8_SCHED; PG8_LDA(At, 1, 0); PG8_STAGE(PG8_SA(0, 1), a2 + hstep, voffA);
            PG8_WAIT_V(8); PG8_WAIT_L(0); PG8_BAR; PG8_MMA(0, 0, At, B0); PG8_MMA(0, 1, At, B1); PG8_BAR; PG8_SCHED;
            PG8_LDA(At, 1, 1); PG8_STAGE(PG8_SB(1, 0), b3, voffB); PG8_STAGE(PG8_SB(1, 1), b3 + hstep, voffB); PG8_STAGE(PG8_SA(1, 0), a3, voffA);
            PG8_WAIT_V(8); PG8_WAIT_L(0); PG8_BAR; PG8_MMA(1, 0, At, B0); PG8_MMA(1, 1, At, B1); PG8_BAR; PG8_SCHED;
        }
        if constexpr (ALIGN_EPI) { if (wr == 0) PG8_BAR; }
        E(acc, cur, ui & 1, wr, wc, fr, fq);
        if (!has_next) break;
#pragma unroll
        for (int a = 0; a < 2; ++a)
#pragma unroll
            for (int b = 0; b < 2; ++b)
#pragma unroll
                for (int m = 0; m < 4; ++m)
#pragma unroll
                    for (int n = 0; n < 2; ++n) acc[a][b][m][n] = (f32x4){0.f, 0.f, 0.f, 0.f};
        cur = nxt; cA = nA; cB = nB; ++ui;
        if constexpr (ALIGN_EPI) { if (wr == 1) PG8_BAR; }
    }
    PG8_WAIT_V(0);
    if constexpr (!ALIGN_EPI) { if (wr == 0) PG8_BAR; }
    PG8_BAR;
#undef PG8_SA
#undef PG8_SB
#undef PG8_STAGE
#undef PG8_LDA
#undef PG8_LDB
#undef PG8_MMA
#undef PG8_WAIT_V
#undef PG8_WAIT_L
#undef PG8_BAR
#undef PG8_SCHED
}
}

typedef f32x4 acc_t[2][2][4][2];
DEVFN f16x8 pack8(f32x4 a, f32x4 b) { f16x8 h; h[0] = (half_t)a[0]; h[1] = (half_t)a[1]; h[2] = (half_t)a[2]; h[3] = (half_t)a[3]; h[4] = (half_t)b[0]; h[5] = (half_t)b[1]; h[6] = (half_t)b[2]; h[7] = (half_t)b[3]; return h; }
DEVFN f32x4 silu4(f32x4 g) { f32x4 o; o[0] = g[0] * sigmoidf_(g[0]); o[1] = g[1] * sigmoidf_(g[1]); o[2] = g[2] * sigmoidf_(g[2]); o[3] = g[3] * sigmoidf_(g[3]); return o; }
DEVFN f32x4 sigm4(f32x4 g) { f32x4 o; o[0] = sigmoidf_(g[0]); o[1] = sigmoidf_(g[1]); o[2] = sigmoidf_(g[2]); o[3] = sigmoidf_(g[3]); return o; }
struct EpiStoreF16 { half_t* O; int ld;
    DEVFN void prepare(const pg8::Unit&, int) const {}
    DEVFN void operator()(const acc_t& acc, const pg8::Unit& u, int, int wr, int wc, int fr, int fq) const {
        const int row0 = u.pm * 256 + wr * 64 + fr, col0 = u.pn * 256 + wc * 32 + 8 * fq;
#pragma unroll
        for (int ai = 0; ai < 2; ++ai)
#pragma unroll
            for (int m = 0; m < 4; ++m) { half_t* rowp = O + (size_t)(row0 + ai * 128 + m * 16) * ld + col0;
#pragma unroll
                for (int bj = 0; bj < 2; ++bj) *(f16x8*)(rowp + bj * 128) = pack8(acc[ai][bj][m][0], acc[ai][bj][m][1]); }
    } };
struct EpiSwiGLU { half_t* O; int ld;
    DEVFN void prepare(const pg8::Unit&, int) const {}
    DEVFN void operator()(const acc_t& acc, const pg8::Unit& u, int, int wr, int wc, int fr, int fq) const {
        const int row0 = u.pm * 256 + wr * 64 + fr, col0 = u.pn * 128 + wc * 32 + 8 * fq;
#pragma unroll
        for (int ai = 0; ai < 2; ++ai)
#pragma unroll
            for (int m = 0; m < 4; ++m)
                *(f16x8*)(O + (size_t)(row0 + ai * 128 + m * 16) * ld + col0) = pack8(silu4(acc[ai][0][m][0]) * acc[ai][1][m][0], silu4(acc[ai][0][m][1]) * acc[ai][1][m][1]);
    } };
struct EpiGLU { half_t* O; int ld; const float* bias;
    DEVFN void prepare(const pg8::Unit&, int) const {}
    DEVFN void operator()(const acc_t& acc, const pg8::Unit& u, int, int wr, int wc, int fr, int fq) const {
        const int row0 = u.pm * 256 + wr * 64 + fr, col0 = u.pn * 128 + wc * 32 + 8 * fq;
        const f32x4 ba0 = *(const f32x4*)(bias + col0), ba1 = *(const f32x4*)(bias + col0 + 4), bs0 = *(const f32x4*)(bias + D + col0), bs1 = *(const f32x4*)(bias + D + col0 + 4);
#pragma unroll
        for (int ai = 0; ai < 2; ++ai)
#pragma unroll
            for (int m = 0; m < 4; ++m)
                *(f16x8*)(O + (size_t)(row0 + ai * 128 + m * 16) * ld + col0) = pack8((acc[ai][0][m][0] + ba0) * sigm4(acc[ai][1][m][0] + bs0), (acc[ai][0][m][1] + ba1) * sigm4(acc[ai][1][m][1] + bs1));
    } };
struct EpiResid { float* R; const float* bias;
    DEVFN void prepare(const pg8::Unit&, int) const {}
    DEVFN void operator()(const acc_t& acc, const pg8::Unit& u, int, int wr, int wc, int fr, int fq) const {
        const int row0 = u.pm * 256 + wr * 64 + fr, col0 = u.pn * 256 + wc * 32 + 8 * fq;
#pragma unroll
        for (int ai = 0; ai < 2; ++ai)
#pragma unroll
            for (int m = 0; m < 4; ++m)
#pragma unroll
                for (int bj = 0; bj < 2; ++bj) { float* p = R + (size_t)(row0 + ai * 128 + m * 16) * D + col0 + bj * 128;
#pragma unroll
                    for (int n = 0; n < 2; ++n) { const f32x4 b = bias ? *(const f32x4*)(bias + col0 + bj * 128 + 4 * n) : (f32x4){0.f, 0.f, 0.f, 0.f};
                        *(f32x4*)(p + 4 * n) = *(const f32x4*)(p + 4 * n) * ALPHA + acc[ai][bj][m][n] + b; } }
    } };
template <class Epi>
DEVFN void gemm_phase(const half_t* A, const half_t* Bt, int M, int N, int K, const Epi& epi, char* lds, int bid, int nb) {
    pg8::Gemm g{A, Bt, M, N, K}; pg8::StaticOrder S; S.init(M, N, nb, bid);
    pg8::gemm_phase<Epi, true>((PG8_LAS unsigned char*)lds, g, S, epi);
}

DEVFN void phase_ln(const Params& P, const float* g, const float* b, float* out, int bid, int nb) {
    float* R = (float*)(P.ws + OFF_R); half_t* HA = (half_t*)(P.ws + OFF_HA);
    const int lane = threadIdx.x & 63, gw = bid * (NTHREADS / 64) + (threadIdx.x >> 6), ngw = nb * (NTHREADS / 64);
    for (int r = gw; r < MP; r += ngw) {
        f32x4 v[4]; float s = 0.f;
#pragma unroll
        for (int j = 0; j < 4; ++j) { v[j] = *(const f32x4*)(R + (size_t)r * D + lane * 4 + 256 * j); s += (v[j][0] + v[j][1]) + (v[j][2] + v[j][3]); }
        const float mean = wave_sum(s) * (1.f / D); float q = 0.f;
#pragma unroll
        for (int j = 0; j < 4; ++j) { v[j] = v[j] - mean; q += (v[j][0] * v[j][0] + v[j][1] * v[j][1]) + (v[j][2] * v[j][2] + v[j][3] * v[j][3]); }
        const float rstd = 1.0f / sqrtf(wave_sum(q) * (1.f / D) + LN_EPS);
#pragma unroll
        for (int j = 0; j < 4; ++j) { const int c = lane * 4 + 256 * j;
            const f32x4 o = v[j] * rstd * *(const f32x4*)(g + c) + *(const f32x4*)(b + c);
            *(f32x4*)(R + (size_t)r * D + c) = o;
            f16x4 h; h[0] = (half_t)o[0]; h[1] = (half_t)o[1]; h[2] = (half_t)o[2]; h[3] = (half_t)o[3];
            *(f16x4*)(HA + (size_t)r * D + c) = h;
            if (out && r < MX) *(f32x4*)(out + (size_t)r * D + c) = o; }
    }
}

DEVFN int key_row(int b, int p) { return p < NMETA ? MX + p : b * SEQ + p - NMETA; }
DEVFN void phase_indexer(const Params& P, char* lds, int bid, int nb) {
    float* qs = (float*)lds;
    float* wsc = qs + 512;
    unsigned* sk = (unsigned*)(lds + 2048 + 64);
    unsigned* hist = sk + 2080;
    volatile int* misc = (volatile int*)(hist + 256);
    const half_t* proj = (const half_t*)(P.ws + OFF_BIG);
    const int tid = threadIdx.x;
    for (int r = bid; r < MV; r += nb) {
        unsigned long long* mrow = (unsigned long long*)(P.ws + OFF_MASK) + (size_t)r * MASK_W64;
        int b, t; if (r < MX) { b = r >> 11; t = (r & 2047) + NMETA; } else { b = 0; t = r - MX; }
        const int nk = t + 1;
        if (nk <= 256) {
            if (tid < MASK_W64) { unsigned long long bits = 0ull;
                for (int j = 0; j < 64; ++j) { const bool ok = (tid == 0) ? (j < NMETA && j < nk) : (NMETA + (tid - 1) * 64 + j < nk); if (ok) bits |= 1ull << j; }
                mrow[tid] = bits; }
            continue;
        }
        const half_t* prow = proj + (size_t)r * NPROJ;
        for (int i = tid; i < 512; i += NTHREADS) qs[i] = (float)prow[COL_QI + i];
        if (tid < 8) wsc[tid] = (float)prow[COL_WI + tid] * 0.04419417382415922f;
        __syncthreads();
        for (int p = tid; p < nk; p += NTHREADS) {
            const f16x8* kp = (const f16x8*)(proj + (size_t)key_row(b, p) * NPROJ + COL_KI);
            float kf[64];
#pragma unroll
            for (int c = 0; c < 8; ++c) { const f16x8 kv = kp[c];
#pragma unroll
                for (int j = 0; j < 8; ++j) kf[c * 8 + j] = (float)kv[j]; }
            float sc = 0.f;
#pragma unroll 1
            for (int h = 0; h < 8; ++h) { float d = 0.f;
                asm volatile("" ::: "memory");
#pragma unroll
                for (int j = 0; j < 64; ++j) d = fmaf(qs[h * 64 + j], kf[j], d);
                sc = fmaf(wsc[h], fmaxf(d, 0.f), sc); }
            unsigned u = __float_as_uint(sc); if (u == 0x80000000u) u = 0u;
            sk[p] = (u & 0x80000000u) ? ~u : (u | 0x80000000u);
        }
        __syncthreads();
        unsigned prefix = 0u, himask = 0u; int remaining = 256, cnt_eq = 0;
        for (int pass = 0; pass < 4; ++pass) {
            const int shift = 24 - 8 * pass;
            if (tid < 256) hist[tid] = 0u;
            __syncthreads();
            for (int p = tid; p < nk; p += NTHREADS) { const unsigned u = sk[p]; if ((u & himask) == prefix) atomicAdd(&hist[(u >> shift) & 255u], 1u); }
            __syncthreads();
            if (tid < 64) {
                const int l = tid;
                const unsigned c0 = hist[255 - 4 * l], c1 = hist[254 - 4 * l], c2 = hist[253 - 4 * l], c3 = hist[252 - 4 * l];
                const unsigned s = c0 + c1 + c2 + c3; unsigned incl = s;
#pragma unroll
                for (int o = 1; o < 64; o <<= 1) { const unsigned v = __shfl_up(incl, o); if (l >= o) incl += v; }
                const unsigned excl = incl - s, rem = (unsigned)remaining;
                if (excl < rem && rem <= incl) {
                    unsigned cum = excl; int sel; unsigned c;
                    if (cum + c0 >= rem) { sel = 255 - 4 * l; c = c0; }
                    else { cum += c0; if (cum + c1 >= rem) { sel = 254 - 4 * l; c = c1; }
                        else { cum += c1; if (cum + c2 >= rem) { sel = 253 - 4 * l; c = c2; } else { cum += c2; sel = 252 - 4 * l; c = c3; } } }
                    misc[0] = sel; misc[1] = (int)(rem - cum); misc[2] = (int)c;
                }
            }
            __syncthreads();
            prefix |= (unsigned)misc[0] << shift; himask |= 0xFFu << shift; remaining = misc[1]; cnt_eq = misc[2];
            __syncthreads();
        }
        if (tid == 0) { int cut = nk;
            if (cnt_eq > remaining) { int c = 0; for (int p = 0; p < nk; ++p) if (sk[p] == prefix) { if (++c == remaining) { cut = p; break; } } }
            misc[3] = cut; }
        __syncthreads();
        const int cut = misc[3];
        if (tid < MASK_W64) { unsigned long long bits = 0ull;
            for (int j = 0; j < 64; ++j) { const int p = (tid == 0) ? j : NMETA + (tid - 1) * 64 + j; const bool ok = (tid == 0 ? j < NMETA : true) && p < nk;
                if (ok) { const unsigned u = sk[p]; if (u > prefix || (u == prefix && p <= cut)) bits |= 1ull << j; } }
            mrow[tid] = bits; }
        __syncthreads();
    }
}

DEVFN int t5_bucket(int d) {
    if (d < 16) return d;
    const int bd[15] = {19, 21, 24, 27, 31, 35, 40, 46, 52, 59, 67, 77, 87, 99, 113};
    int b = 16;
#pragma unroll
    for (int i = 0; i < 15; ++i) b += (d >= bd[i]) ? 1 : 0;
    return b;
}
DEVFN void phase_attn(const Params& P, char* lds, int bid, int nb) {
    float* tb = (float*)lds;
    const int tid = threadIdx.x & 255, sub = threadIdx.x >> 8, head = tid >> 4;
    for (int i = threadIdx.x; i < 129 * 16; i += NTHREADS) tb[i] = P.rel_bias[t5_bucket(i >> 4) * 16 + (i & 15)];
    __syncthreads();
    const half_t* proj = (const half_t*)(P.ws + OFF_BIG); half_t* AO = (half_t*)(P.ws + OFF_HA);
    for (int r = 2 * bid + sub; r < MV; r += 2 * nb) {
        const unsigned long long* mrow = (const unsigned long long*)(P.ws + OFF_MASK) + (size_t)r * MASK_W64;
        int b, t; if (r < MX) { b = r >> 11; t = (r & 2047) + NMETA; } else { b = 0; t = r - MX; }
        float q[4]; { const f16x4 qv = *(const f16x4*)(proj + (size_t)r * NPROJ + tid * 4); q[0] = (float)qv[0]; q[1] = (float)qv[1]; q[2] = (float)qv[2]; q[3] = (float)qv[3]; }
        float m = -INFINITY, l = 0.f, o[4] = {0.f, 0.f, 0.f, 0.f};
        for (int w = 0; w < MASK_W64; ++w) {
            unsigned long long bits = mrow[w];
            while (bits) {
                const int j = __builtin_ctzll(bits); bits &= bits - 1ull;
                const int p = (w == 0) ? j : NMETA + (w - 1) * 64 + j;
                const half_t* kr = proj + (size_t)key_row(b, p) * NPROJ + tid * 4;
                const f16x4 kv = *(const f16x4*)(kr + COL_K), vv = *(const f16x4*)(kr + COL_V);
                float d = q[0] * (float)kv[0] + q[1] * (float)kv[1] + q[2] * (float)kv[2] + q[3] * (float)kv[3];
                d += __shfl_xor(d, 1); d += __shfl_xor(d, 2); d += __shfl_xor(d, 4); d += __shfl_xor(d, 8);
                int dist = t - p; dist = dist > 128 ? 128 : dist;
                const float s = d * 0.125f + tb[dist * 16 + head];
                const float mn = fmaxf(m, s), corr = __expf(m - mn), pe = __expf(s - mn);
                l = l * corr + pe;
#pragma unroll
                for (int c = 0; c < 4; ++c) o[c] = o[c] * corr + pe * (float)vv[c];
                m = mn;
            }
        }
        const float il = 1.0f / l; f16x4 h; h[0] = (half_t)(o[0] * il); h[1] = (half_t)(o[1] * il); h[2] = (half_t)(o[2] * il); h[3] = (half_t)(o[3] * il);
        *(f16x4*)(AO + (size_t)r * D + tid * 4) = h;
    }
}

DEVFN void phase_conv(const Params& P, int bid, int nb) {
    const half_t* U = (const half_t*)(P.ws + OFF_BIG); half_t* C = (half_t*)(P.ws + OFF_C);
    const int lane = threadIdx.x & 63, gw = bid * (NTHREADS / 64) + (threadIdx.x >> 6), ngw = nb * (NTHREADS / 64);
    for (int r = gw; r < MV; r += ngw) {
        int b, t; if (r < MX) { b = r >> 11; t = (r & 2047) + NMETA; } else { b = 0; t = r - MX; }
        float a[2][8];
#pragma unroll
        for (int h = 0; h < 2; ++h)
#pragma unroll
            for (int j = 0; j < 8; ++j) a[h][j] = P.b_dw[h * 512 + lane * 8 + j];
        for (int k = 0; k < 31; ++k) {
            const int p = t - 30 + k; if (p < 0) continue;
            const half_t* ur = U + (size_t)key_row(b, p) * D;
#pragma unroll
            for (int h = 0; h < 2; ++h) { const int c = h * 512 + lane * 8; const f16x8 uv = *(const f16x8*)(ur + c);
                const f32x4 w0 = *(const f32x4*)(P.w_dw + (size_t)k * D + c), w1 = *(const f32x4*)(P.w_dw + (size_t)k * D + c + 4);
#pragma unroll
                for (int j = 0; j < 4; ++j) { a[h][j] = fmaf(w0[j], (float)uv[j], a[h][j]); a[h][4 + j] = fmaf(w1[j], (float)uv[4 + j], a[h][4 + j]); } }
        }
        float s = 0.f;
#pragma unroll
        for (int h = 0; h < 2; ++h)
#pragma unroll
            for (int j = 0; j < 8; ++j) s += a[h][j];
        const float mean = wave_sum(s) * (1.f / D); float q = 0.f;
#pragma unroll
        for (int h = 0; h < 2; ++h)
#pragma unroll
            for (int j = 0; j < 8; ++j) { a[h][j] -= mean; q += a[h][j] * a[h][j]; }
        const float rstd = 1.0f / sqrtf(wave_sum(q) * (1.f / D) + LN_EPS);
#pragma unroll
        for (int h = 0; h < 2; ++h) { const int c = h * 512 + lane * 8; f16x8 o;
#pragma unroll
            for (int j = 0; j < 8; ++j) { const float y = a[h][j] * rstd * P.cln_g[c + j] + P.cln_b[c + j]; o[j] = (half_t)(y * sigmoidf_(y)); }
            *(f16x8*)(C + (size_t)r * D + c) = o; }
    }
}

constexpr int N_PHASES = 16;
constexpr int LDS_BYTES = 147456;
static_assert(pg8::STAGE_BYTES == 131072, "LDS");

DEVFN void run_phase(const Params& P, int ph, char* lds, int bid, int nb) {
    unsigned char* ws = P.ws;
    half_t* HA = (half_t*)(ws + OFF_HA); half_t* BIG = (half_t*)(ws + OFF_BIG); half_t* CB = (half_t*)(ws + OFF_C); float* R = (float*)(ws + OFF_R);
    switch (ph) {
    case 0: phase_prep(P, lds, bid, nb); break;
    case 1: gemm_phase(HA, (const half_t*)(ws + OFF_W_IN), MP, NPROJ, D, EpiStoreF16{BIG, NPROJ}, lds, bid, nb); break;
    case 2: phase_indexer(P, lds, bid, nb); break;
    case 3: phase_attn(P, lds, bid, nb); break;
    case 4: gemm_phase(HA, (const half_t*)(ws + OFF_W_O), MP, D, D, EpiResid{R, nullptr}, lds, bid, nb); break;
    case 5: phase_ln(P, P.ln1_g, P.ln1_b, nullptr, bid, nb); break;
    case 6: gemm_phase(HA, (const half_t*)(ws + OFF_W_GU0), MP, 2 * DFF, D, EpiSwiGLU{BIG, DFF}, lds, bid, nb); break;
    case 7: gemm_phase(BIG, (const half_t*)(ws + OFF_W_D0), MP, D, DFF, EpiResid{R, nullptr}, lds, bid, nb); break;
    case 8: phase_ln(P, P.ln2_g, P.ln2_b, nullptr, bid, nb); break;
    case 9: gemm_phase(HA, (const half_t*)(ws + OFF_W_PW1), MP, 2 * D, D, EpiGLU{BIG, D, P.b_pw1}, lds, bid, nb); break;
    case 10: phase_conv(P, bid, nb); break;
    case 11: gemm_phase(CB, (const half_t*)(ws + OFF_W_PW2), MP, D, D, EpiResid{R, P.b_pw2}, lds, bid, nb); break;
    case 12: phase_ln(P, P.ln1_g + D, P.ln1_b + D, nullptr, bid, nb); break;
    case 13: gemm_phase(HA, (const half_t*)(ws + OFF_W_GU1), MP, 2 * DFF, D, EpiSwiGLU{BIG, DFF}, lds, bid, nb); break;
    case 14: gemm_phase(BIG, (const half_t*)(ws + OFF_W_D1), MP, D, DFF, EpiResid{R, nullptr}, lds, bid, nb); break;
    case 15: phase_ln(P, P.ln2_g + D, P.ln2_b + D, P.out, bid, nb); break;
    default: break;
    }
}

#if MODE_COOP
__global__ void __launch_bounds__(NTHREADS, 2) fwd_mega(Params P) {
    extern __shared__ __attribute__((aligned(16))) char lds[];
    cg::grid_group grid = cg::this_grid();
#define PHASE(k) run_phase(P, k, lds, blockIdx.x, gridDim.x)
#define SEAM() grid.sync()
    PHASE(0); SEAM(); PHASE(1); SEAM(); PHASE(2); SEAM(); PHASE(3); SEAM(); PHASE(4); SEAM(); PHASE(5); SEAM(); PHASE(6); SEAM(); PHASE(7); SEAM();
    PHASE(8); SEAM(); PHASE(9); SEAM(); PHASE(10); SEAM(); PHASE(11); SEAM(); PHASE(12); SEAM(); PHASE(13); SEAM(); PHASE(14); SEAM(); PHASE(15);
#undef PHASE
#undef SEAM
}
#else
template <int PH> __global__ void __launch_bounds__(NTHREADS, 2) fwd_phase(Params P) {
    extern __shared__ __attribute__((aligned(16))) char lds[];
    run_phase(P, PH, lds, blockIdx.x, gridDim.x);
}
template <int PH> static void launch_phases(const Params& p, hipStream_t stream) {
    hipFuncSetAttribute((const void*)fwd_phase<PH>, hipFuncAttributeMaxDynamicSharedMemorySize, LDS_BYTES);
    hipLaunchKernelGGL(fwd_phase<PH>, dim3(256), dim3(NTHREADS), LDS_BYTES, stream, p);
    if constexpr (PH + 1 < N_PHASES) launch_phases<PH + 1>(p, stream);
}
#endif

extern "C" void kernel_launch(void* const* d_in, const int* in_sizes, int n_in, void* d_out, int out_size, void* d_ws, size_t ws_size, hipStream_t stream) {
    if (n_in != 20 || ws_size < WS_END || out_size != MX * D) { fprintf(stderr, "kernel_launch: unexpected sizes n_in %d ws %zu out %d\n", n_in, ws_size, out_size); return; }
    Params p{};
    const float** pp = (const float**)&p;
    for (int i = 0; i < 20; ++i) pp[i] = (const float*)d_in[i];
    p.out = (float*)d_out; p.ws = (unsigned char*)d_ws;
#if MODE_COOP
    static int grid_blocks = 0;
    if (!grid_blocks) {
        int dev = 0, cus = 0, per_cu = 0;
        hipGetDevice(&dev); hipDeviceGetAttribute(&cus, hipDeviceAttributeMultiprocessorCount, dev);
        hipFuncSetAttribute((const void*)fwd_mega, hipFuncAttributeMaxDynamicSharedMemorySize, LDS_BYTES);
        hipOccupancyMaxActiveBlocksPerMultiprocessor(&per_cu, fwd_mega, NTHREADS, LDS_BYTES);
        if (per_cu < 1) per_cu = 1;
        grid_blocks = cus * per_cu;
    }
    void* args[] = {&p};
    hipError_t e = hipLaunchCooperativeKernel((void*)fwd_mega, dim3(grid_blocks), dim3(NTHREADS), args, LDS_BYTES, stream);
    if (e != hipSuccess) fprintf(stderr, "cooperative launch failed: %s (grid %d)\n", hipGetErrorString(e), grid_blocks);
#else
    launch_phases<0>(p, stream);
#endif
}
```

```cpp
#include <hip/hip_runtime.h>
#include <hip/hip_cooperative_groups.h>
#include <cstdio>
#include <cstdint>
namespace cg = cooperative_groups;

#ifndef MODE_COOP
#define MODE_COOP 1
#endif

#define DEVFN __device__ __forceinline__
typedef _Float16 half_t;
typedef _Float16 f16x8 __attribute__((ext_vector_type(8)));
typedef _Float16 f16x4 __attribute__((ext_vector_type(4)));
typedef _Float16 f16x2 __attribute__((ext_vector_type(2)));
typedef float f32x4 __attribute__((ext_vector_type(4)));

constexpr int D = 1024, NBATCH = 16, SEQ = 2048, NMETA = 16;
constexpr int MX = NBATCH * SEQ;
constexpr int MV = MX + NMETA;
constexpr int MP = 33024;
constexpr int NPROJ = 3840, NPROJ_VALID = 3656;
constexpr int DFF = 2816;
constexpr int COL_K = 1024, COL_V = 2048, COL_QI = 3072, COL_KI = 3584, COL_WI = 3648;
constexpr int MASK_W64 = 33;
constexpr float ALPHA = 1.41421356237309515f;
constexpr float LN_EPS = 1e-5f;
constexpr int NTHREADS = 512;
constexpr size_t VT_ELEMS = (size_t)NBATCH * 16 * 64 * SEQ;

constexpr size_t MiB = 1u << 20;
constexpr size_t OFF_W_IN = 0, OFF_W_O = 8 * MiB, OFF_W_GU0 = 10 * MiB, OFF_W_GU1 = 21 * MiB, OFF_W_D0 = 32 * MiB, OFF_W_D1 = 38 * MiB,
                 OFF_W_PW1 = 44 * MiB, OFF_W_PW2 = 48 * MiB, OFF_MASK = 50 * MiB, OFF_R = 60 * MiB, OFF_HA = 190 * MiB, OFF_BIG = 256 * MiB,
                 OFF_C = OFF_BIG + 65 * MiB, WS_END = OFF_BIG + 242 * MiB;
static_assert((size_t)NPROJ * D * 2 <= 8 * MiB && (size_t)2 * DFF * D * 2 <= 11 * MiB && (size_t)DFF * D * 2 <= 6 * MiB, "weights");
static_assert((size_t)MP * MASK_W64 * 8 <= 10 * MiB && (size_t)MP * D * 4 <= 130 * MiB && (size_t)MP * D * 2 <= 65 * MiB && (size_t)MP * NPROJ * 2 <= 242 * MiB, "acts");

struct Params {
    const float *x, *meta, *rel_bias, *w_in, *w_o, *w_pw1, *b_pw1, *w_dw, *b_dw, *cln_g, *cln_b, *w_pw2, *b_pw2, *ln1_g, *ln1_b, *wg, *wu, *wd, *ln2_g, *ln2_b;
    float* out; unsigned char* ws;
};

DEVFN float wave_sum(float v) {
#pragma unroll
    for (int o = 1; o < 64; o <<= 1) v += __shfl_xor(v, o);
    return v;
}
DEVFN float sigmoidf_(float x) { return 1.0f / (1.0f + __expf(-x)); }

DEVFN void prep_tile(const float* srcA, const float* srcB, int ld, int K, int Nsrc, int mode, half_t* dst, int tile, float* scr  , int qrows = 0) {
    const int nkt = K / 32, tn = tile / nkt, tk = tile % nkt, n0 = tn * 32, k0 = tk * 32;
    const int tx = threadIdx.x & 31, ty = threadIdx.x >> 5;
#pragma unroll
    for (int i = 0; i < 2; ++i) {
        const int k = k0 + ty + 16 * i, n = n0 + tx; float v = 0.f;
        if (mode == 0) { if (n < Nsrc) v = srcA[(size_t)k * ld + n]; if (n < qrows) v *= 0.18033688011112042f; }
        else { const float* s = ((n >> 7) & 1) ? srcB : srcA; v = s[(size_t)k * ld + ((n >> 8) * 128 + (n & 127))]; }
        scr[(ty + 16 * i) * 33 + tx] = v;
    }
    __syncthreads();
#pragma unroll
    for (int i = 0; i < 2; ++i) {
        const int n = n0 + ty + 16 * i, k = k0 + tx;
        dst[(size_t)n * K + k] = (half_t)scr[tx * 33 + ty + 16 * i];
    }
    __syncthreads();
}

DEVFN void phase_prep(const Params& P, char* lds, int bid, int nb) {
    float* scr = (float*)lds;
    unsigned char* ws = P.ws;
    constexpr int T_IN = (NPROJ / 32) * (D / 32), T_SQ = (D / 32) * (D / 32), T_GU = (2 * DFF / 32) * (D / 32), T_DN = (D / 32) * (DFF / 32), T_PW1 = (2 * D / 32) * (D / 32);
    constexpr int TOTAL = T_IN + T_SQ + 2 * T_GU + 2 * T_DN + T_PW1 + T_SQ;
    for (int it = bid; it < TOTAL; it += nb) {
        int r = it;
        if (r < T_IN) { prep_tile(P.w_in, nullptr, NPROJ_VALID, D, NPROJ_VALID, 0, (half_t*)(ws + OFF_W_IN), r, scr, D); continue; } r -= T_IN;
        if (r < T_SQ) { prep_tile(P.w_o, nullptr, D, D, D, 0, (half_t*)(ws + OFF_W_O), r, scr); continue; } r -= T_SQ;
        if (r < T_GU) { prep_tile(P.wg, P.wu, DFF, D, DFF, 1, (half_t*)(ws + OFF_W_GU0), r, scr); continue; } r -= T_GU;
        if (r < T_GU) { prep_tile(P.wg + (size_t)D * DFF, P.wu + (size_t)D * DFF, DFF, D, DFF, 1, (half_t*)(ws + OFF_W_GU1), r, scr); continue; } r -= T_GU;
        if (r < T_DN) { prep_tile(P.wd, nullptr, D, DFF, D, 0, (half_t*)(ws + OFF_W_D0), r, scr); continue; } r -= T_DN;
        if (r < T_DN) { prep_tile(P.wd + (size_t)DFF * D, nullptr, D, DFF, D, 0, (half_t*)(ws + OFF_W_D1), r, scr); continue; } r -= T_DN;
        if (r < T_PW1) { prep_tile(P.w_pw1, P.w_pw1 + D, 2 * D, D, D, 1, (half_t*)(ws + OFF_W_PW1), r, scr); continue; } r -= T_PW1;
        prep_tile(P.w_pw2, nullptr, D, D, D, 0, (half_t*)(ws + OFF_W_PW2), r, scr);
    }
    float* R = (float*)(ws + OFF_R); half_t* HA = (half_t*)(ws + OFF_HA);
    const int lane = threadIdx.x & 63, gw = bid * (NTHREADS / 64) + (threadIdx.x >> 6), ngw = nb * (NTHREADS / 64);
    for (int r = gw; r < MP; r += ngw) {
        const float* src = r < MX ? P.x + (size_t)r * D : (r < MV ? P.meta + (size_t)(r - MX) * D : nullptr);
#pragma unroll
        for (int j = 0; j < 4; ++j) {
            const int c = lane * 4 + 256 * j;
            f32x4 v = src ? *(const f32x4*)(src + c) : (f32x4){0.f, 0.f, 0.f, 0.f};
            *(f32x4*)(R + (size_t)r * D + c) = v;
            f16x4 h; h[0] = (half_t)v[0]; h[1] = (half_t)v[1]; h[2] = (half_t)v[2]; h[3] = (half_t)v[3];
            *(f16x4*)(HA + (size_t)r * D + c) = h;
        }
    }
}

namespace pg8 {
#define PG8_LAS __attribute__((address_space(3)))
constexpr int BM = 256, BK = 64, HALF = 128, HTB = HALF * BK * 2  , STAGE_BYTES = 8 * HTB, NXCD = 8, WGM = 8;
__host__ __device__ __forceinline__ int lds_byte(int r, int c) { const int st = (r >> 4) * 2 + (c >> 5), rr = r & 15, cc = c & 31, ob = rr * 64 + cc * 2; return st * 1024 + (ob ^ (((ob >> 9) & 1) << 5)); }
__host__ __device__ __forceinline__ void stage_rc(int b, int& R, int& C) { const int st = b / 1024, sb = b % 1024, swz = sb ^ (((sb >> 9) & 1) << 5); R = (st >> 1) * 16 + swz / 64; C = (st & 1) * 32 + (swz % 64) / 2; }
__host__ __device__ __forceinline__ int perm32(int rho) { const int n = rho >> 4, i = rho & 15; return 8 * (i >> 2) + 4 * n + (i & 3); }
struct Unit { int pm, pn; };
struct Gemm { const half_t* A; const half_t* Bt; int M, N, K; };
struct StaticOrder {
    int nM, nN, nwg, G, c;
    __host__ __device__ void init(int M, int N, int G_, int c_) { nM = M / BM; nN = N / BM; nwg = nM * nN; G = G_; c = c_; }
    __host__ __device__ bool next(int i, Unit& u) const {
        const long L = (long)i * G + c; if (L >= nwg) return false;
        int wgid = (int)L; { const int q = nwg / NXCD, r = nwg % NXCD, xcd = wgid % NXCD, off = wgid / NXCD; wgid = (xcd < r ? xcd * (q + 1) : r * (q + 1) + (xcd - r) * q) + off; }
        const int nig = WGM * nN, gid = wgid / nig, fm = gid * WGM, gsz = (nM - fm) < WGM ? (nM - fm) : WGM;
        u.pm = fm + ((wgid % nig) % gsz); u.pn = (wgid % nig) / gsz; return true;
    }
};
template <class Epi, bool ALIGN_EPI = true>
__device__ __forceinline__ void gemm_phase(PG8_LAS unsigned char* lds, const Gemm g, const StaticOrder& S, const Epi& E) {
    const int tid = threadIdx.x, wid = __builtin_amdgcn_readfirstlane(tid >> 6), lane = tid & 63, wr = wid >> 2, wc = wid & 3, fr = lane & 15, fq = lane >> 4;
    const int K = g.K, nt = K / BK;
    unsigned voffA[2], voffB[2];
#pragma unroll
    for (int i = 0; i < 2; ++i) { int R, C; stage_rc(tid * 16 + i * 8192, R, C); const int Rb = (R & ~31) + perm32(R & 31);
        voffA[i] = (unsigned)(R * K + C) * 2u; voffB[i] = (unsigned)(Rb * K + C) * 2u; }
    const size_t kstep = (size_t)(BK * 2);
    const size_t hstep = (size_t)HALF * K * 2;
    const size_t tstep = 2 * hstep;
    const unsigned ldsw = (unsigned)wid * 1024u;
    const int aoff = lds_byte(wr * 64 + fr, fq * 8), boff = lds_byte(wc * 32 + fr, fq * 8);
#define PG8_SA(b, h) (((b) * 2 + (h)) * HTB)
#define PG8_SB(b, h) ((4 + (b) * 2 + (h)) * HTB)
#define PG8_STAGE(bufoff, gbase, voff) do { _Pragma("unroll") for (int _i = 0; _i < 2; ++_i) \
        __builtin_amdgcn_global_load_lds((const unsigned*)((const char*)(gbase) + (voff)[_i]), (PG8_LAS unsigned*)(lds + (bufoff) + ldsw + _i * 8192), 16, 0, 0); } while (0)
#define PG8_LDA(dst, b, h) do { _Pragma("unroll") for (int m = 0; m < 4; ++m) _Pragma("unroll") for (int k = 0; k < 2; ++k) dst[m][k] = *(const PG8_LAS f16x8*)(lds + PG8_SA(b, h) + aoff + m * 2048 + k * 1024); } while (0)
#define PG8_LDB(dst, b, h) do { _Pragma("unroll") for (int n = 0; n < 2; ++n) _Pragma("unroll") for (int k = 0; k < 2; ++k) dst[n][k] = *(const PG8_LAS f16x8*)(lds + PG8_SB(b, h) + boff + n * 2048 + k * 1024); } while (0)
#define PG8_MMA(ai, bj, At, Bt) do { __builtin_amdgcn_s_setprio(1); _Pragma("unroll") for (int m = 0; m < 4; ++m) _Pragma("unroll") for (int n = 0; n < 2; ++n) _Pragma("unroll") for (int k = 0; k < 2; ++k) \
        acc[ai][bj][m][n] = __builtin_amdgcn_mfma_f32_16x16x32_f16(Bt[n][k], At[m][k], acc[ai][bj][m][n], 0, 0, 0); __builtin_amdgcn_s_setprio(0); } while (0)
#define PG8_WAIT_V(n) asm volatile("s_waitcnt vmcnt(" #n ")" ::: "memory")
#define PG8_WAIT_L(n) asm volatile("s_waitcnt lgkmcnt(" #n ")" ::: "memory")
#define PG8_BAR __builtin_amdgcn_s_barrier()
#define PG8_SCHED __builtin_amdgcn_sched_barrier(0)
    Unit cur, nxt; int ui = 0;
    if (!S.next(0, cur)) return;
    f32x4 acc[2][2][4][2];
#pragma unroll
    for (int a = 0; a < 2; ++a)
#pragma unroll
        for (int b = 0; b < 2; ++b)
#pragma unroll
            for (int m = 0; m < 4; ++m)
#pragma unroll
                for (int n = 0; n < 2; ++n) acc[a][b][m][n] = (f32x4){0.f, 0.f, 0.f, 0.f};
    f16x8 At[4][2], B0[2][2], B1[2][2];
    const char* cA = (const char*)g.A + (size_t)cur.pm * tstep; const char* cB = (const char*)g.Bt + (size_t)cur.pn * tstep;
    E.prepare(cur, 0);
    PG8_STAGE(PG8_SB(0, 0), cB, voffB); PG8_STAGE(PG8_SB(0, 1), cB + hstep, voffB); PG8_STAGE(PG8_SA(0, 0), cA, voffA); PG8_STAGE(PG8_SA(0, 1), cA + hstep, voffA);
    if (wr == 1) PG8_BAR;
    PG8_WAIT_V(2); PG8_BAR;
    PG8_STAGE(PG8_SB(1, 0), cB + kstep, voffB); PG8_STAGE(PG8_SA(1, 0), cA + kstep, voffA); PG8_STAGE(PG8_SB(1, 1), cB + hstep + kstep, voffB);
    PG8_WAIT_V(6); PG8_BAR;
    for (;;) {
        const bool has_next = S.next(ui + 1, nxt);
        const char* nA = has_next ? (const char*)g.A + (size_t)nxt.pm * tstep : cA; const char* nB = has_next ? (const char*)g.Bt + (size_t)nxt.pn * tstep : cB;
        for (int t = 0; t < nt; t += 2) {
            const bool last = (t == nt - 2);
            const char* a1 = cA + (size_t)(t + 1) * kstep;
            const char* a2 = last ? nA : cA + (size_t)(t + 2) * kstep; const char* b2 = last ? nB : cB + (size_t)(t + 2) * kstep;
            const char* a3 = a2 + kstep; const char* b3 = b2 + kstep;
            if (last && has_next) E.prepare(nxt, (ui + 1) & 1);
            PG8_LDB(B0, 0, 0); PG8_LDB(B1, 0, 1); PG8_SCHED; PG8_LDA(At, 0, 0); PG8_STAGE(PG8_SA(1, 1), a1 + hstep, voffA);
            PG8_WAIT_V(8); PG8_WAIT_L(0); PG8_BAR; PG8_MMA(0, 0, At, B0); PG8_MMA(0, 1, At, B1); PG8_BAR; PG8_SCHED;
            PG8_LDA(At, 0, 1); PG8_STAGE(PG8_SB(0, 0), b2, voffB); PG8_STAGE(PG8_SB(0, 1), b2 + hstep, voffB); PG8_STAGE(PG8_SA(0, 0), a2, voffA);
            PG8_WAIT_V(8); PG8_WAIT_L(0); PG8_BAR; PG8_MMA(1, 0, At, B0); PG8_MMA(1, 1, At, B1); PG8_BAR; PG8_SCHED;
            PG8_LDB(B0, 1, 0); PG8_LDB(B1, 1, 1); PG8_SCHED; PG8_LDA(At, 1, 0); PG8_STAGE(PG8_SA(0, 1), a2 + hstep, voffA);
            PG8_WAIT_V(8); PG8_WAIT_L(0); PG8_BAR; PG8_MMA(0, 0, At, B0); PG8_MMA(0, 1, At, B1); PG8_BAR; PG8_SCHED;
            PG8_LDA(At, 1, 1); PG8_STAGE(PG8_SB(1, 0), b3, voffB); PG8_STAGE(PG8_SB(1, 1), b3 + hstep, voffB); PG8_STAGE(PG8_SA(1, 0), a3, voffA);
            PG8_WAIT_V(8); PG8_WAIT_L(0); PG8_BAR; PG8_MMA(1, 0, At, B0); PG8_MMA(1, 1, At, B1); PG8_BAR; PG8_SCHED;
        }
        if constexpr (ALIGN_EPI) { if (wr == 0) PG8_BAR; }
        E(acc, cur, ui & 1, wr, wc, fr, fq);
        if (!has_next) break;
#pragma unroll
        for (int a = 0; a < 2; ++a)
#pragma unroll
            for (int b = 0; b < 2; ++b)
#pragma unroll
                for (int m = 0; m < 4; ++m)
#pragma unroll
                    for (int n = 0; n < 2; ++n) acc[a][b][m][n] = (f32x4){0.f, 0.f, 0.f, 0.f};
        cur = nxt; cA = nA; cB = nB; ++ui;
        if constexpr (ALIGN_EPI) { if (wr == 1) PG8_BAR; }
    }
    PG8_WAIT_V(0);
    if constexpr (!ALIGN_EPI) { if (wr == 0) PG8_BAR; }
    PG8_BAR;
#undef PG8_SA
#undef PG8_SB
#undef PG8_STAGE
#undef PG8_LDA
#undef PG8_LDB
#undef PG8_MMA
#undef PG8_WAIT_V
#undef PG8_WAIT_L
#undef PG8_BAR
#undef PG8_SCHED
}
}

typedef f32x4 acc_t[2][2][4][2];
DEVFN f16x8 pack8(f32x4 a, f32x4 b) { f16x8 h; h[0] = (half_t)a[0]; h[1] = (half_t)a[1]; h[2] = (half_t)a[2]; h[3] = (half_t)a[3]; h[4] = (half_t)b[0]; h[5] = (half_t)b[1]; h[6] = (half_t)b[2]; h[7] = (half_t)b[3]; return h; }
DEVFN f32x4 silu4(f32x4 g) { f32x4 o; o[0] = g[0] * sigmoidf_(g[0]); o[1] = g[1] * sigmoidf_(g[1]); o[2] = g[2] * sigmoidf_(g[2]); o[3] = g[3] * sigmoidf_(g[3]); return o; }
DEVFN f32x4 sigm4(f32x4 g) { f32x4 o; o[0] = sigmoidf_(g[0]); o[1] = sigmoidf_(g[1]); o[2] = sigmoidf_(g[2]); o[3] = sigmoidf_(g[3]); return o; }
struct EpiStoreF16 { half_t* O; int ld;
    DEVFN void prepare(const pg8::Unit&, int) const {}
    DEVFN void operator()(const acc_t& acc, const pg8::Unit& u, int, int wr, int wc, int fr, int fq) const {
        const int row0 = u.pm * 256 + wr * 64 + fr, col0 = u.pn * 256 + wc * 32 + 8 * fq;
#pragma unroll
        for (int ai = 0; ai < 2; ++ai)
#pragma unroll
            for (int m = 0; m < 4; ++m) { half_t* rowp = O + (size_t)(row0 + ai * 128 + m * 16) * ld + col0;
#pragma unroll
                for (int bj = 0; bj < 2; ++bj) *(f16x8*)(rowp + bj * 128) = pack8(acc[ai][bj][m][0], acc[ai][bj][m][1]); }
    } };
struct EpiProj { half_t* O; int ld; half_t* VT; half_t* VTM;
    DEVFN void prepare(const pg8::Unit&, int) const {}
    DEVFN void operator()(const acc_t& acc, const pg8::Unit& u, int, int wr, int wc, int fr, int fq) const {
        const int row0 = u.pm * 256 + wr * 64 + fr, col0 = u.pn * 256 + wc * 32 + 8 * fq;
#pragma unroll
        for (int ai = 0; ai < 2; ++ai)
#pragma unroll
            for (int m = 0; m < 4; ++m) { half_t* rowp = O + (size_t)(row0 + ai * 128 + m * 16) * ld + col0;
#pragma unroll
                for (int bj = 0; bj < 2; ++bj) *(f16x8*)(rowp + bj * 128) = pack8(acc[ai][bj][m][0], acc[ai][bj][m][1]); }
        if (u.pn >= 8 && u.pn < 12) {
            const int sw = (fr & 3) | ((fr & 4) << 1) | ((fr & 8) >> 1);
#pragma unroll
            for (int ai = 0; ai < 2; ++ai)
#pragma unroll
                for (int m = 0; m < 4; ++m) { const int row = row0 + ai * 128 + m * 16;
                    half_t* base; size_t dstride;
                    if (row < MX) { base = VT + (size_t)(row >> 11) * 1024 * SEQ + (((row & 2047) & ~15) | sw); dstride = SEQ; }
                    else { base = VTM + (((row - MX) & ~15) | sw); dstride = 256; }
#pragma unroll
                    for (int bj = 0; bj < 2; ++bj)
#pragma unroll
                        for (int n = 0; n < 2; ++n)
#pragma unroll
                            for (int e = 0; e < 4; ++e) base[(size_t)(col0 - COL_V + bj * 128 + 4 * n + e) * dstride] = (half_t)acc[ai][bj][m][n][e]; }
        }
    } };
struct EpiSwiGLU { half_t* O; int ld;
    DEVFN void prepare(const pg8::Unit&, int) const {}
    DEVFN void operator()(const acc_t& acc, const pg8::Unit& u, int, int wr, int wc, int fr, int fq) const {
        const int row0 = u.pm * 256 + wr * 64 + fr, col0 = u.pn * 128 + wc * 32 + 8 * fq;
#pragma unroll
        for (int ai = 0; ai < 2; ++ai)
#pragma unroll
            for (int m = 0; m < 4; ++m)
                *(f16x8*)(O + (size_t)(row0 + ai * 128 + m * 16) * ld + col0) = pack8(silu4(acc[ai][0][m][0]) * acc[ai][1][m][0], silu4(acc[ai][0][m][1]) * acc[ai][1][m][1]);
    } };
struct EpiGLU { half_t* O; int ld; const float* bias;
    DEVFN void prepare(const pg8::Unit&, int) const {}
    DEVFN void operator()(const acc_t& acc, const pg8::Unit& u, int, int wr, int wc, int fr, int fq) const {
        const int row0 = u.pm * 256 + wr * 64 + fr, col0 = u.pn * 128 + wc * 32 + 8 * fq;
        const f32x4 ba0 = *(const f32x4*)(bias + col0), ba1 = *(const f32x4*)(bias + col0 + 4), bs0 = *(const f32x4*)(bias + D + col0), bs1 = *(const f32x4*)(bias + D + col0 + 4);
#pragma unroll
        for (int ai = 0; ai < 2; ++ai)
#pragma unroll
            for (int m = 0; m < 4; ++m)
                *(f16x8*)(O + (size_t)(row0 + ai * 128 + m * 16) * ld + col0) = pack8((acc[ai][0][m][0] + ba0) * sigm4(acc[ai][1][m][0] + bs0), (acc[ai][0][m][1] + ba1) * sigm4(acc[ai][1][m][1] + bs1));
    } };
struct EpiResid { float* R; const float* bias;
    DEVFN void prepare(const pg8::Unit&, int) const {}
    DEVFN void operator()(const acc_t& acc, const pg8::Unit& u, int, int wr, int wc, int fr, int fq) const {
        const int row0 = u.pm * 256 + wr * 64 + fr, col0 = u.pn * 256 + wc * 32 + 8 * fq;
#pragma unroll
        for (int ai = 0; ai < 2; ++ai)
#pragma unroll
            for (int m = 0; m < 4; ++m)
#pragma unroll
                for (int bj = 0; bj < 2; ++bj) { float* p = R + (size_t)(row0 + ai * 128 + m * 16) * D + col0 + bj * 128;
#pragma unroll
                    for (int n = 0; n < 2; ++n) { const f32x4 b = bias ? *(const f32x4*)(bias + col0 + bj * 128 + 4 * n) : (f32x4){0.f, 0.f, 0.f, 0.f};
                        *(f32x4*)(p + 4 * n) = *(const f32x4*)(p + 4 * n) * ALPHA + acc[ai][bj][m][n] + b; } }
    } };
template <class Epi>
DEVFN void gemm_phase(const half_t* A, const half_t* Bt, int M, int N, int K, const Epi& epi, char* lds, int bid, int nb) {
    pg8::Gemm g{A, Bt, M, N, K}; pg8::StaticOrder S; S.init(M, N, nb, bid);
    pg8::gemm_phase<Epi, true>((PG8_LAS unsigned char*)lds, g, S, epi);
}

DEVFN void phase_ln(const Params& P, const float* g, const float* b, float* out, int bid, int nb) {
    float* R = (float*)(P.ws + OFF_R); half_t* HA = (half_t*)(P.ws + OFF_HA);
    const int lane = threadIdx.x & 63, gw = bid * (NTHREADS / 64) + (threadIdx.x >> 6), ngw = nb * (NTHREADS / 64);
    for (int r = gw; r < MP; r += ngw) {
        f32x4 v[4]; float s = 0.f;
#pragma unroll
        for (int j = 0; j < 4; ++j) { v[j] = *(const f32x4*)(R + (size_t)r * D + lane * 4 + 256 * j); s += (v[j][0] + v[j][1]) + (v[j][2] + v[j][3]); }
        const float mean = wave_sum(s) * (1.f / D); float q = 0.f;
#pragma unroll
        for (int j = 0; j < 4; ++j) { v[j] = v[j] - mean; q += (v[j][0] * v[j][0] + v[j][1] * v[j][1]) + (v[j][2] * v[j][2] + v[j][3] * v[j][3]); }
        const float rstd = 1.0f / sqrtf(wave_sum(q) * (1.f / D) + LN_EPS);
#pragma unroll
        for (int j = 0; j < 4; ++j) { const int c = lane * 4 + 256 * j;
            const f32x4 o = v[j] * rstd * *(const f32x4*)(g + c) + *(const f32x4*)(b + c);
            *(f32x4*)(R + (size_t)r * D + c) = o;
            f16x4 h; h[0] = (half_t)o[0]; h[1] = (half_t)o[1]; h[2] = (half_t)o[2]; h[3] = (half_t)o[3];
            *(f16x4*)(HA + (size_t)r * D + c) = h;
            if (out && r < MX) *(f32x4*)(out + (size_t)r * D + c) = o; }
    }
}

DEVFN int key_row(int b, int p) { return p < NMETA ? MX + p : b * SEQ + p - NMETA; }
constexpr int IDX_ROW = 2116;
DEVFN int half_sum_i(int v) {
#pragma unroll
    for (int o = 1; o < 32; o <<= 1) v += __shfl_xor(v, o);
    return v;
}
DEVFN void phase_indexer(const Params& P, char* lds, int bid, int nb) {
    float* sc = (float*)lds;
    const half_t* proj = (const half_t*)(P.ws + OFF_BIG);
    unsigned long long* maskt = (unsigned long long*)(P.ws + OFF_MASK);
    const int tid = threadIdx.x, lane = tid & 63, wid = __builtin_amdgcn_readfirstlane(tid >> 6), fr = lane & 15, quad = lane >> 4;
    for (int L = bid; L < NBATCH * (SEQ / 16); L += nb) {
        const int i = (SEQ / 16 - 1) - (L >> 4), b = L & 15, s0 = 16 * i;
        if (s0 + 32 <= 256) {
            const int q = tid >> 5, s = s0 + q;
            for (int k = tid & 31; k < 33; k += 32) {
                unsigned long long bits;
                if (k == 0) bits = 0xFFFFull;
                else { const int base = 64 * (k - 1); bits = (s >= base + 63) ? ~0ull : (s < base ? 0ull : ((2ull << (s - base)) - 1ull)); }
                maskt[((size_t)b * 33 + k) * SEQ + s] = bits;
            }
            continue;
        }
        {
            const half_t* qrow = proj + (size_t)(b * SEQ + s0 + fr) * NPROJ;
            f16x8 bq[8][2];
#pragma unroll
            for (int h = 0; h < 8; ++h)
#pragma unroll
                for (int kh = 0; kh < 2; ++kh) bq[h][kh] = *(const f16x8*)(qrow + COL_QI + h * 64 + kh * 32 + quad * 8);
            float w[8]; { const f16x8 wv = *(const f16x8*)(qrow + COL_WI);
#pragma unroll
                for (int h = 0; h < 8; ++h) w[h] = (float)wv[h] * 0.04419417382415922f; }
            const int nblk = i + 2;
            int j = wid;
            const half_t* kp = proj + (size_t)(j == 0 ? MX + fr : b * SEQ + 16 * (j - 1) + fr) * NPROJ + COL_KI + quad * 8;
            f16x8 a0 = *(const f16x8*)kp, a1 = *(const f16x8*)(kp + 32);
            for (; j < nblk; j += 8) {
                const int jn = (j + 8 < nblk) ? j + 8 : j;
                const half_t* kn = proj + (size_t)(jn == 0 ? MX + fr : b * SEQ + 16 * (jn - 1) + fr) * NPROJ + COL_KI + quad * 8;
                const f16x8 n0 = *(const f16x8*)kn, n1 = *(const f16x8*)(kn + 32);
                f32x4 s4 = (f32x4){0.f, 0.f, 0.f, 0.f};
#pragma unroll
                for (int h = 0; h < 8; ++h) {
                    f32x4 acc = __builtin_amdgcn_mfma_f32_16x16x32_f16(a0, bq[h][0], (f32x4){0.f, 0.f, 0.f, 0.f}, 0, 0, 0);
                    acc = __builtin_amdgcn_mfma_f32_16x16x32_f16(a1, bq[h][1], acc, 0, 0, 0);
#pragma unroll
                    for (int e = 0; e < 4; ++e) s4[e] = fmaf(w[h], fmaxf(acc[e], 0.f), s4[e]);
                }
                s4 = s4 + 0.0f;
                const int slot = (j == 0 ? 0 : 64 + 16 * (j - 1)) + 4 * quad;
                *(f32x4*)(sc + fr * IDX_ROW + slot) = s4;
                a0 = n0; a1 = n1;
            }
        }
        __syncthreads();
        {
            const int qq = 2 * wid + (lane >> 5), li = lane & 31, sq = s0 + qq;
            const float* row = sc + qq * IDX_ROW;
            float v[66]; float vmin = INFINITY, vmax = -INFINITY;
#pragma unroll
            for (int j = 0; j < 66; ++j) { const int slot = 32 * j + li; const bool valid = slot < 16 || (slot >= 64 && slot - 64 <= sq);
                const float x = valid ? row[slot] : -INFINITY; v[j] = x; vmax = fmaxf(vmax, x); vmin = fminf(vmin, valid ? x : INFINITY); }
#pragma unroll
            for (int o = 1; o < 32; o <<= 1) { vmin = fminf(vmin, __shfl_xor(vmin, o)); vmax = fmaxf(vmax, __shfl_xor(vmax, o)); }
            float lo = vmin - (fabsf(vmin) * 1e-6f + 1e-30f), hi = vmax; int clo = sq + 17, chi = 0;
            float thr = 0.f, tiev = 0.f; int need = 0; bool done = false;
            for (int it = 0; it < 256; ++it) {
                float mid = 0.5f * (lo + hi);
                if (!done) {
                    if (clo == 256) { thr = lo; need = 0; done = true; }
                    else {
                        if (!(it & 1)) { const float mi = lo + (hi - lo) * (((float)(clo - 256) + 0.5f) / (float)(clo - chi)); if (mi > lo && mi < hi) mid = mi; }
                        if (!(mid > lo && mid < hi)) { thr = hi; tiev = hi; need = 256 - chi; done = true; }
                    }
                }
                if (!__any(!done)) break;
                int c = 0;
#pragma unroll
                for (int j = 0; j < 66; ++j) c += (v[j] > mid) ? 1 : 0;
                c = half_sum_i(c);
                if (!done) { if (c >= 256) { lo = mid; clo = c; } else { hi = mid; chi = c; } }
            }
            int eqbase = 0; unsigned long long wA = 0ull, wB = 0ull, prev = 0ull;
            unsigned long long* mbase = maskt + (size_t)b * 33 * SEQ + s0 + 2 * wid;
#pragma unroll
            for (int j = 0; j < 66; ++j) {
                const bool eq = need > 0 && v[j] == tiev;
                const unsigned long long eb = __ballot(eq);
                const unsigned e32 = (lane >> 5) ? (unsigned)(eb >> 32) : (unsigned)eb;
                const int rank = eqbase + __popc(e32 & ((1u << li) - 1u));
                eqbase += __popc(e32);
                const bool sel = v[j] > thr || (eq && rank < need);
                const unsigned long long sb = __ballot(sel);
                if (j & 1) { wA = (prev & 0xFFFFFFFFull) | (sb << 32); wB = (prev >> 32) | (sb & 0xFFFFFFFF00000000ull);
                    if (lane == 0) { unsigned long long* mp = mbase + (size_t)(j >> 1) * SEQ; mp[0] = wA; mp[1] = wB; } }
                else prev = sb;
            }
        }
        __syncthreads();
    }
}

DEVFN int t5_bucket(int d) {
    if (d < 16) return d;
    const int bd[15] = {19, 21, 24, 27, 31, 35, 40, 46, 52, 59, 67, 77, 87, 99, 113};
    int b = 16;
#pragma unroll
    for (int i = 0; i < 15; ++i) b += (d >= bd[i]) ? 1 : 0;
    return b;
}
constexpr float LOG2E = 1.4426950408889634f;
constexpr float QSCALE = 0.125f * LOG2E;
typedef float f32x16 __attribute__((ext_vector_type(16)));
#define ATT_LAS __attribute__((address_space(3)))
constexpr int ATT_K = 0, ATT_V = 16384, ATT_DL = 32768, ATT_LDS = 32768 + 1024;
DEVFN void attn_unit(const Params& P, char* lds, int b, int h, int qb) {
    const int tid = threadIdx.x, lane = tid & 63, wid = __builtin_amdgcn_readfirstlane(tid >> 6), r32 = lane & 31, hi = lane >> 5;
    const half_t* proj = (const half_t*)(P.ws + OFF_BIG);
    const half_t* VT = (const half_t*)P.out; const half_t* VTM = VT + VT_ELEMS;
    const unsigned long long* maskt = (const unsigned long long*)(P.ws + OFF_MASK) + (size_t)b * 33 * SEQ;
    ATT_LAS char* L = (ATT_LAS char*)lds;
    float* dl = (float*)(lds + ATT_DL);
    const int sq = 256 * qb + 32 * wid + r32;
    const int NT = 4 * qb + 5;
    if (tid < 129) dl[tid] = tid < 128 ? (P.rel_bias[t5_bucket(tid) * 16 + h] - P.rel_bias[31 * 16 + h]) * LOG2E : 0.f;
    f16x8 qf[4];
#pragma unroll
    for (int d0 = 0; d0 < 4; ++d0) qf[d0] = *(const f16x8*)(proj + ((size_t)b * SEQ + sq) * NPROJ + h * 64 + 16 * d0 + 8 * hi);
    const int drow = wid * 8 + (lane >> 3), dch = (lane & 7) ^ ((lane >> 3) & 7);
    const half_t* ksrc_m = proj + (size_t)(MX + drow) * NPROJ + COL_K + h * 64 + dch * 8;
    const half_t* ksrc_x = proj + ((size_t)b * SEQ + drow) * NPROJ + COL_K + h * 64 + dch * 8;
    const half_t* vsrc_m = VTM + (size_t)(h * 64 + drow) * 256 + dch * 8;
    const half_t* vsrc_x = VT + ((size_t)(b * 16 + h) * 64 + drow) * SEQ + dch * 8;
#define ATT_DMA(tt, slot) do { const half_t* ks_ = (tt) == 0 ? ksrc_m : ksrc_x + (size_t)((tt) - 1) * 64 * NPROJ; const half_t* vs_ = (tt) == 0 ? vsrc_m : vsrc_x + ((tt) - 1) * 64; \
        __builtin_amdgcn_global_load_lds((const unsigned*)ks_, (ATT_LAS unsigned*)(L + ATT_K + (slot) * 8192 + wid * 1024), 16, 0, 0); \
        __builtin_amdgcn_global_load_lds((const unsigned*)vs_, (ATT_LAS unsigned*)(L + ATT_V + (slot) * 8192 + wid * 1024), 16, 0, 0); } while (0)
    int foff[8];
#pragma unroll
    for (int c = 0; c < 8; ++c) foff[c] = r32 * 128 + (((c) ^ (r32 & 7)) * 16);
    float m = -1e30f, l = 0.f;
    f32x16 o0, o1;
#pragma unroll
    for (int r = 0; r < 16; ++r) { o0[r] = 0.f; o1[r] = 0.f; }
    ATT_DMA(0, 0);
    unsigned long long mw_next = maskt[sq];
    asm volatile("s_waitcnt vmcnt(0)" ::: "memory");
    __syncthreads();
    for (int tt = 0; tt < NT; ++tt) {
        const int cur = tt & 1;
        const unsigned long long mw = mw_next;
        if (tt + 1 < NT) { ATT_DMA(tt + 1, cur ^ 1); mw_next = maskt[(size_t)(tt + 1) * SEQ + sq]; }
        const int kbase = tt == 0 ? 0 : 64 * (tt - 1);
        const bool active = tt == 0 || kbase <= 256 * qb + 32 * wid + 31;
        if (active) {
            f32x16 c0, c1;
#pragma unroll
            for (int r = 0; r < 16; ++r) { c0[r] = 0.f; c1[r] = 0.f; }
            const ATT_LAS char* kb = L + ATT_K + cur * 8192;
#pragma unroll
            for (int d0 = 0; d0 < 4; ++d0) {
                const f16x8 k0 = *(const ATT_LAS f16x8*)(kb + foff[2 * d0 + hi]);
                const f16x8 k1 = *(const ATT_LAS f16x8*)(kb + 4096 + foff[2 * d0 + hi]);
                c0 = __builtin_amdgcn_mfma_f32_32x32x16_f16(k0, qf[d0], c0, 0, 0, 0);
                c1 = __builtin_amdgcn_mfma_f32_32x32x16_f16(k1, qf[d0], c1, 0, 0, 0);
            }
            const int dist0 = tt == 0 ? sq + 16 - 4 * hi : sq - kbase - 4 * hi;
            const bool nearb = tt == 0 ? (256 * qb + 32 * wid + 16 - 15 < 128) : (256 * qb + 32 * wid - (kbase + 63) < 128);
            if (nearb) {
#pragma unroll
                for (int r = 0; r < 16; ++r) { const int kk = (r & 3) + 8 * (r >> 2);
                    int d0_ = dist0 - kk, d1_ = dist0 - kk - 32; d0_ = d0_ < 0 ? 0 : (d0_ > 128 ? 128 : d0_); d1_ = d1_ < 0 ? 0 : (d1_ > 128 ? 128 : d1_);
                    c0[r] += dl[d0_]; c1[r] += dl[d1_]; }
            }
            const unsigned mlo = (unsigned)mw >> (4 * hi), mhi = (unsigned)(mw >> 32) >> (4 * hi);
            float tmax = -INFINITY;
#pragma unroll
            for (int r = 0; r < 16; ++r) { const int cb = (r & 3) + 8 * (r >> 2);
                c0[r] = ((mlo >> cb) & 1u) ? c0[r] : -INFINITY; c1[r] = ((mhi >> cb) & 1u) ? c1[r] : -INFINITY;
                tmax = fmaxf(tmax, fmaxf(c0[r], c1[r])); }
            tmax = fmaxf(tmax, __shfl_xor(tmax, 32));
            const float mn = fmaxf(m, tmax), alpha = __builtin_amdgcn_exp2f(m - mn);
            m = mn;
            float ls = 0.f;
#pragma unroll
            for (int r = 0; r < 16; ++r) { c0[r] = __builtin_amdgcn_exp2f(c0[r] - mn); c1[r] = __builtin_amdgcn_exp2f(c1[r] - mn); ls += c0[r] + c1[r]; }
            l = l * alpha + ls;
            if (!__all(alpha == 1.0f)) {
#pragma unroll
                for (int r = 0; r < 16; ++r) { o0[r] *= alpha; o1[r] *= alpha; }
            }
            const ATT_LAS char* vb = L + ATT_V + cur * 8192;
#pragma unroll
            for (int s = 0; s < 4; ++s) {
                f16x8 pf;
#pragma unroll
                for (int jj = 0; jj < 8; ++jj) pf[jj] = (half_t)((s < 2) ? c0[8 * (s & 1) + jj] : c1[8 * (s & 1) + jj]);
                const f16x8 v0 = *(const ATT_LAS f16x8*)(vb + foff[2 * s + hi]);
                const f16x8 v1 = *(const ATT_LAS f16x8*)(vb + 4096 + foff[2 * s + hi]);
                o0 = __builtin_amdgcn_mfma_f32_32x32x16_f16(v0, pf, o0, 0, 0, 0);
                o1 = __builtin_amdgcn_mfma_f32_32x32x16_f16(v1, pf, o1, 0, 0, 0);
            }
        }
        asm volatile("s_waitcnt vmcnt(0)" ::: "memory");
        __syncthreads();
    }
#undef ATT_DMA
    l += __shfl_xor(l, 32);
    const float il = 1.0f / l;
    half_t* orow = (half_t*)(P.ws + OFF_HA) + ((size_t)b * SEQ + sq) * D + h * 64;
#pragma unroll
    for (int g = 0; g < 4; ++g) { f16x4 a, c;
#pragma unroll
        for (int e = 0; e < 4; ++e) { a[e] = (half_t)(o0[4 * g + e] * il); c[e] = (half_t)(o1[4 * g + e] * il); }
        *(f16x4*)(orow + 8 * g + 4 * hi) = a; *(f16x4*)(orow + 32 + 8 * g + 4 * hi) = c; }
}
DEVFN void attn_meta_rows(const Params& P, int bid, int nb) {
    const half_t* proj = (const half_t*)(P.ws + OFF_BIG); half_t* AO = (half_t*)(P.ws + OFF_HA);
    const int tid = threadIdx.x & 255, sub = threadIdx.x >> 8, head = tid >> 4;
    for (int mrow = 2 * bid + sub; mrow < NMETA; mrow += 2 * nb) {
        const int r = MX + mrow;
        float q[4]; { const f16x4 qv = *(const f16x4*)(proj + (size_t)r * NPROJ + tid * 4); q[0] = (float)qv[0]; q[1] = (float)qv[1]; q[2] = (float)qv[2]; q[3] = (float)qv[3]; }
        float m = -1e30f, l = 0.f, o[4] = {0.f, 0.f, 0.f, 0.f};
        for (int p = 0; p <= mrow; ++p) {
            const half_t* kr = proj + (size_t)(MX + p) * NPROJ + tid * 4;
            const f16x4 kv = *(const f16x4*)(kr + COL_K), vv = *(const f16x4*)(kr + COL_V);
            float d = q[0] * (float)kv[0] + q[1] * (float)kv[1] + q[2] * (float)kv[2] + q[3] * (float)kv[3];
            d += __shfl_xor(d, 1); d += __shfl_xor(d, 2); d += __shfl_xor(d, 4); d += __shfl_xor(d, 8);
            const float s = d + P.rel_bias[t5_bucket(mrow - p) * 16 + head] * LOG2E;
            const float mn = fmaxf(m, s), corr = __builtin_amdgcn_exp2f(m - mn), pe = __builtin_amdgcn_exp2f(s - mn);
            l = l * corr + pe;
#pragma unroll
            for (int c = 0; c < 4; ++c) o[c] = o[c] * corr + pe * (float)vv[c];
            m = mn;
        }
        const float il = 1.0f / l; f16x4 hh; hh[0] = (half_t)(o[0] * il); hh[1] = (half_t)(o[1] * il); hh[2] = (half_t)(o[2] * il); hh[3] = (half_t)(o[3] * il);
        *(f16x4*)(AO + (size_t)r * D + tid * 4) = hh;
    }
}
DEVFN void phase_attn(const Params& P, char* lds, int bid, int nb) {
    attn_meta_rows(P, bid, nb);
    for (int bh = bid; bh < NBATCH * 16; bh += nb)
        for (int qb = 7; qb >= 0; --qb) attn_unit(P, lds, bh >> 4, bh & 15, qb);
}

DEVFN void phase_conv(const Params& P, int bid, int nb) {
    const half_t* U = (const half_t*)(P.ws + OFF_BIG); half_t* C = (half_t*)(P.ws + OFF_C);
    const int lane = threadIdx.x & 63, gw = bid * (NTHREADS / 64) + (threadIdx.x >> 6), ngw = nb * (NTHREADS / 64);
    for (int r = gw; r < MV; r += ngw) {
        int b, t; if (r < MX) { b = r >> 11; t = (r & 2047) + NMETA; } else { b = 0; t = r - MX; }
        float a[2][8];
#pragma unroll
        for (int h = 0; h < 2; ++h)
#pragma unroll
            for (int j = 0; j < 8; ++j) a[h][j] = P.b_dw[h * 512 + lane * 8 + j];
        for (int k = 0; k < 31; ++k) {
            const int p = t - 30 + k; if (p < 0) continue;
            const half_t* ur = U + (size_t)key_row(b, p) * D;
#pragma unroll
            for (int h = 0; h < 2; ++h) { const int c = h * 512 + lane * 8; const f16x8 uv = *(const f16x8*)(ur + c);
                const f32x4 w0 = *(const f32x4*)(P.w_dw + (size_t)k * D + c), w1 = *(const f32x4*)(P.w_dw + (size_t)k * D + c + 4);
#pragma unroll
                for (int j = 0; j < 4; ++j) { a[h][j] = fmaf(w0[j], (float)uv[j], a[h][j]); a[h][4 + j] = fmaf(w1[j], (float)uv[4 + j], a[h][4 + j]); } }
        }
        float s = 0.f;
#pragma unroll
        for (int h = 0; h < 2; ++h)
#pragma unroll
            for (int j = 0; j < 8; ++j) s += a[h][j];
        const float mean = wave_sum(s) * (1.f / D); float q = 0.f;
#pragma unroll
        for (int h = 0; h < 2; ++h)
#pragma unroll
            for (int j = 0; j < 8; ++j) { a[h][j] -= mean; q += a[h][j] * a[h][j]; }
        const float rstd = 1.0f / sqrtf(wave_sum(q) * (1.f / D) + LN_EPS);
#pragma unroll
        for (int h = 0; h < 2; ++h) { const int c = h * 512 + lane * 8; f16x8 o;
#pragma unroll
            for (int j = 0; j < 8; ++j) { const float y = a[h][j] * rstd * P.cln_g[c + j] + P.cln_b[c + j]; o[j] = (half_t)(y * sigmoidf_(y)); }
            *(f16x8*)(C + (size_t)r * D + c) = o; }
    }
}

constexpr int N_PHASES = 16;
constexpr int LDS_BYTES = 147456;
static_assert(pg8::STAGE_BYTES == 131072, "LDS");

DEVFN void run_phase(const Params& P, int ph, char* lds, int bid, int nb) {
    unsigned char* ws = P.ws;
    half_t* HA = (half_t*)(ws + OFF_HA); half_t* BIG = (half_t*)(ws + OFF_BIG); half_t* CB = (half_t*)(ws + OFF_C); float* R = (float*)(ws + OFF_R);
    switch (ph) {
    case 0: phase_prep(P, lds, bid, nb); break;
    case 1: gemm_phase(HA, (const half_t*)(ws + OFF_W_IN), MP, NPROJ, D, EpiProj{BIG, NPROJ, (half_t*)P.out, (half_t*)P.out + VT_ELEMS}, lds, bid, nb); break;
    case 2: phase_indexer(P, lds, bid, nb); break;
    case 3: phase_attn(P, lds, bid, nb); break;
    case 4: gemm_phase(HA, (const half_t*)(ws + OFF_W_O), MP, D, D, EpiResid{R, nullptr}, lds, bid, nb); break;
    case 5: phase_ln(P, P.ln1_g, P.ln1_b, nullptr, bid, nb); break;
    case 6: gemm_phase(HA, (const half_t*)(ws + OFF_W_GU0), MP, 2 * DFF, D, EpiSwiGLU{BIG, DFF}, lds, bid, nb); break;
    case 7: gemm_phase(BIG, (const half_t*)(ws + OFF_W_D0), MP, D, DFF, EpiResid{R, nullptr}, lds, bid, nb); break;
    case 8: phase_ln(P, P.ln2_g, P.ln2_b, nullptr, bid, nb); break;
    case 9: gemm_phase(HA, (const half_t*)(ws + OFF_W_PW1), MP, 2 * D, D, EpiGLU{BIG, D, P.b_pw1}, lds, bid, nb); break;
    case 10: phase_conv(P, bid, nb); break;
    case 11: gemm_phase(CB, (const half_t*)(ws + OFF_W_PW2), MP, D, D, EpiResid{R, P.b_pw2}, lds, bid, nb); break;
    case 12: phase_ln(P, P.ln1_g + D, P.ln1_b + D, nullptr, bid, nb); break;
    case 13: gemm_phase(HA, (const half_t*)(ws + OFF_W_GU1), MP, 2 * DFF, D, EpiSwiGLU{BIG, DFF}, lds, bid, nb); break;
    case 14: gemm_phase(BIG, (const half_t*)(ws + OFF_W_D1), MP, D, DFF, EpiResid{R, nullptr}, lds, bid, nb); break;
    case 15: phase_ln(P, P.ln2_g + D, P.ln2_b + D, P.out, bid, nb); break;
    default: break;
    }
}

#if MODE_COOP
__global__ void __launch_bounds__(NTHREADS, 2) fwd_mega(Params P) {
    extern __shared__ __attribute__((aligned(16))) char lds[];
    cg::grid_group grid = cg::this_grid();
#define PHASE(k) run_phase(P, k, lds, blockIdx.x, gridDim.x)
#define SEAM() grid.sync()
    PHASE(0); SEAM(); PHASE(1); SEAM(); PHASE(2); SEAM(); PHASE(3); SEAM(); PHASE(4); SEAM(); PHASE(5); SEAM(); PHASE(6); SEAM(); PHASE(7); SEAM();
    PHASE(8); SEAM(); PHASE(9); SEAM(); PHASE(10); SEAM(); PHASE(11); SEAM(); PHASE(12); SEAM(); PHASE(13); SEAM(); PHASE(14); SEAM(); PHASE(15);
#undef PHASE
#undef SEAM
}
#else
template <int PH> __global__ void __launch_bounds__(NTHREADS, 2) fwd_phase(Params P) {
    extern __shared__ __attribute__((aligned(16))) char lds[];
    run_phase(P, PH, lds, blockIdx.x, gridDim.x);
}
template <int PH> static void launch_phases(const Params& p, hipStream_t stream) {
    hipFuncSetAttribute((const void*)fwd_phase<PH>, hipFuncAttributeMaxDynamicSharedMemorySize, LDS_BYTES);
    hipLaunchKernelGGL(fwd_phase<PH>, dim3(256), dim3(NTHREADS), LDS_BYTES, stream, p);
    if constexpr (PH + 1 < N_PHASES) launch_phases<PH + 1>(p, stream);
}
#endif

extern "C" void kernel_launch(void* const* d_in, const int* in_sizes, int n_in, void* d_out, int out_size, void* d_ws, size_t ws_size, hipStream_t stream) {
    if (n_in != 20 || ws_size < WS_END || out_size != MX * D) { fprintf(stderr, "kernel_launch: unexpected sizes n_in %d ws %zu out %d\n", n_in, ws_size, out_size); return; }
    Params p{};
    const float** pp = (const float**)&p;
    for (int i = 0; i < 20; ++i) pp[i] = (const float*)d_in[i];
    p.out = (float*)d_out; p.ws = (unsigned char*)d_ws;
#if MODE_COOP
    static int grid_blocks = 0;
    if (!grid_blocks) {
        int dev = 0, cus = 0, per_cu = 0;
        hipGetDevice(&dev); hipDeviceGetAttribute(&cus, hipDeviceAttributeMultiprocessorCount, dev);
        hipFuncSetAttribute((const void*)fwd_mega, hipFuncAttributeMaxDynamicSharedMemorySize, LDS_BYTES);
        hipOccupancyMaxActiveBlocksPerMultiprocessor(&per_cu, fwd_mega, NTHREADS, LDS_BYTES);
        if (per_cu < 1) per_cu = 1;
        grid_blocks = cus * per_cu;
    }
    void* args[] = {&p};
    hipError_t e = hipLaunchCooperativeKernel((void*)fwd_mega, dim3(grid_blocks), dim3(NTHREADS), args, LDS_BYTES, stream);
    if (e != hipSuccess) fprintf(stderr, "cooperative launch failed: %s (grid %d)\n", hipGetErrorString(e), grid_blocks);
#else
    launch_phases<0>(p, stream);
#endif
}
```

```cpp
#include <hip/hip_runtime.h>
#include <hip/hip_cooperative_groups.h>
#include <cstdio>
#include <cstdint>
namespace cg = cooperative_groups;

#ifndef MODE_COOP
#define MODE_COOP 1
#endif

#define DEVFN __device__ __forceinline__
typedef _Float16 half_t;
typedef _Float16 f16x8 __attribute__((ext_vector_type(8)));
typedef _Float16 f16x4 __attribute__((ext_vector_type(4)));
typedef _Float16 f16x2 __attribute__((ext_vector_type(2)));
typedef float f32x4 __attribute__((ext_vector_type(4)));

constexpr int D = 1024, NBATCH = 16, SEQ = 2048, NMETA = 16;
constexpr int MX = NBATCH * SEQ;
constexpr int MV = MX + NMETA;
constexpr int MP = 33024;
constexpr int NPROJ = 3840, NPROJ_VALID = 3656;
constexpr int DFF = 2816;
constexpr int COL_K = 1024, COL_V = 2048, COL_QI = 3072, COL_KI = 3584, COL_WI = 3648;
constexpr int MASK_W64 = 33;
constexpr float ALPHA = 1.41421356237309515f;
constexpr float LN_EPS = 1e-5f;
constexpr int NTHREADS = 512;
constexpr size_t VT_ELEMS = (size_t)NBATCH * 16 * 64 * SEQ;

constexpr size_t MiB = 1u << 20;
constexpr size_t OFF_W_IN = 0, OFF_W_O = 8 * MiB, OFF_W_GU0 = 10 * MiB, OFF_W_GU1 = 21 * MiB, OFF_W_D0 = 32 * MiB, OFF_W_D1 = 38 * MiB,
                 OFF_W_PW1 = 44 * MiB, OFF_W_PW2 = 48 * MiB, OFF_MASK = 50 * MiB, OFF_Y = 60 * MiB, OFF_ST0 = 126 * MiB, OFF_ST1 = 131 * MiB,
                 OFF_CP1 = 136 * MiB, OFF_CP2 = 138 * MiB, OFF_C1 = 140 * MiB, OFF_C2 = 140 * MiB + 65536, OFF_HA = 190 * MiB, OFF_BIG = 256 * MiB,
                 OFF_C = OFF_BIG + 65 * MiB, WS_END = OFF_BIG + 242 * MiB;
constexpr int NC_GU0 = 0, NC_GU1 = 2 * DFF, NC_PW1 = 4 * DFF, NC_TOTAL = 4 * DFF + 2 * D;
static_assert((size_t)MP * 16 * 8 <= 5 * MiB && (size_t)32 * NC_TOTAL * 4 <= 2 * MiB && (size_t)NC_TOTAL * 4 <= 65536, "stats");
static_assert((size_t)NPROJ * D * 2 <= 8 * MiB && (size_t)2 * DFF * D * 2 <= 11 * MiB && (size_t)DFF * D * 2 <= 6 * MiB, "weights");
static_assert((size_t)MP * MASK_W64 * 8 <= 10 * MiB && (size_t)MP * D * 2 <= 65 * MiB && (size_t)MP * NPROJ * 2 <= 242 * MiB, "acts");

struct Params {
    const float *x, *meta, *rel_bias, *w_in, *w_o, *w_pw1, *b_pw1, *w_dw, *b_dw, *cln_g, *cln_b, *w_pw2, *b_pw2, *ln1_g, *ln1_b, *wg, *wu, *wd, *ln2_g, *ln2_b;
    float* out; unsigned char* ws;
};

DEVFN float wave_sum(float v) {
#pragma unroll
    for (int o = 1; o < 64; o <<= 1) v += __shfl_xor(v, o);
    return v;
}
DEVFN float sigmoidf_(float x) { return 1.0f / (1.0f + __expf(-x)); }

DEVFN void prep_tile(const float* srcA, const float* srcB, int ld, int K, int Nsrc, int mode, half_t* dst, int tile, float* scr  , int qrows,
                     const float* lng, const float* lnb, float* cp1, float* cp2) {
    const int nkt = K / 32, tn = tile / nkt, tk = tile % nkt, n0 = tn * 32, k0 = tk * 32;
    const int tx = threadIdx.x & 31, ty = threadIdx.x >> 5;
    float* scr2 = scr + 32 * 33 + 32;
#pragma unroll
    for (int i = 0; i < 2; ++i) {
        const int k = k0 + ty + 16 * i, n = n0 + tx; float v = 0.f;
        if (mode == 0) { if (n < Nsrc) v = srcA[(size_t)k * ld + n]; if (n < qrows) v *= 0.18033688011112042f; }
        else { const float* s = ((n >> 7) & 1) ? srcB : srcA; v = s[(size_t)k * ld + ((n >> 8) * 128 + (n & 127))]; }
        if (lng) { scr2[(ty + 16 * i) * 33 + tx] = v * lnb[k]; v *= lng[k]; }
        scr[(ty + 16 * i) * 33 + tx] = v;
    }
    __syncthreads();
#pragma unroll
    for (int i = 0; i < 2; ++i) {
        const int n = n0 + ty + 16 * i, k = k0 + tx;
        dst[(size_t)n * K + k] = (half_t)scr[tx * 33 + ty + 16 * i];
    }
    if (lng && ty == 0) { float s1 = 0.f, s2 = 0.f;
#pragma unroll 8
        for (int k = 0; k < 32; ++k) { s1 += (float)(half_t)scr[k * 33 + tx]; s2 += scr2[k * 33 + tx]; }
        cp1[(size_t)tk * NC_TOTAL + n0 + tx] = s1; cp2[(size_t)tk * NC_TOTAL + n0 + tx] = s2; }
    __syncthreads();
}

DEVFN void phase_prep(const Params& P, char* lds, int bid, int nb) {
    float* scr = (float*)lds;
    unsigned char* ws = P.ws;
    float* cp1 = (float*)(ws + OFF_CP1); float* cp2 = (float*)(ws + OFF_CP2);
    constexpr int T_IN = (NPROJ / 32) * (D / 32), T_SQ = (D / 32) * (D / 32), T_GU = (2 * DFF / 32) * (D / 32), T_DN = (D / 32) * (DFF / 32), T_PW1 = (2 * D / 32) * (D / 32);
    constexpr int TOTAL = T_IN + T_SQ + 2 * T_GU + 2 * T_DN + T_PW1 + T_SQ;
    for (int it = bid; it < TOTAL; it += nb) {
        int r = it;
        if (r < T_IN) { prep_tile(P.w_in, nullptr, NPROJ_VALID, D, NPROJ_VALID, 0, (half_t*)(ws + OFF_W_IN), r, scr, D, nullptr, nullptr, nullptr, nullptr); continue; } r -= T_IN;
        if (r < T_SQ) { prep_tile(P.w_o, nullptr, D, D, D, 0, (half_t*)(ws + OFF_W_O), r, scr, 0, nullptr, nullptr, nullptr, nullptr); continue; } r -= T_SQ;
        if (r < T_GU) { prep_tile(P.wg, P.wu, DFF, D, DFF, 1, (half_t*)(ws + OFF_W_GU0), r, scr, 0, P.ln1_g, P.ln1_b, cp1 + NC_GU0, cp2 + NC_GU0); continue; } r -= T_GU;
        if (r < T_GU) { prep_tile(P.wg + (size_t)D * DFF, P.wu + (size_t)D * DFF, DFF, D, DFF, 1, (half_t*)(ws + OFF_W_GU1), r, scr, 0, P.ln1_g + D, P.ln1_b + D, cp1 + NC_GU1, cp2 + NC_GU1); continue; } r -= T_GU;
        if (r < T_DN) { prep_tile(P.wd, nullptr, D, DFF, D, 0, (half_t*)(ws + OFF_W_D0), r, scr, 0, nullptr, nullptr, nullptr, nullptr); continue; } r -= T_DN;
        if (r < T_DN) { prep_tile(P.wd + (size_t)DFF * D, nullptr, D, DFF, D, 0, (half_t*)(ws + OFF_W_D1), r, scr, 0, nullptr, nullptr, nullptr, nullptr); continue; } r -= T_DN;
        if (r < T_PW1) { prep_tile(P.w_pw1, P.w_pw1 + D, 2 * D, D, D, 1, (half_t*)(ws + OFF_W_PW1), r, scr, 0, P.ln2_g, P.ln2_b, cp1 + NC_PW1, cp2 + NC_PW1); continue; } r -= T_PW1;
        prep_tile(P.w_pw2, nullptr, D, D, D, 0, (half_t*)(ws + OFF_W_PW2), r, scr, 0, nullptr, nullptr, nullptr, nullptr);
    }
    half_t* HA = (half_t*)(ws + OFF_HA);
    const int lane = threadIdx.x & 63, gw = bid * (NTHREADS / 64) + (threadIdx.x >> 6), ngw = nb * (NTHREADS / 64);
    for (int r = gw; r < MP; r += ngw) {
        const float* src = r < MX ? P.x + (size_t)r * D : (r < MV ? P.meta + (size_t)(r - MX) * D : nullptr);
#pragma unroll
        for (int j = 0; j < 4; ++j) {
            const int c = lane * 4 + 256 * j;
            f32x4 v = src ? *(const f32x4*)(src + c) : (f32x4){0.f, 0.f, 0.f, 0.f};
            f16x4 h; h[0] = (half_t)v[0]; h[1] = (half_t)v[1]; h[2] = (half_t)v[2]; h[3] = (half_t)v[3];
            *(f16x4*)(HA + (size_t)r * D + c) = h;
        }
    }
}
DEVFN void finish_colconsts(const Params& P, int bid, int nb) {
    const float* cp1 = (const float*)(P.ws + OFF_CP1); const float* cp2 = (const float*)(P.ws + OFF_CP2);
    float* c1 = (float*)(P.ws + OFF_C1); float* c2 = (float*)(P.ws + OFF_C2);
    for (int idx = bid * NTHREADS + threadIdx.x; idx < NC_TOTAL; idx += nb * NTHREADS) {
        float s1 = 0.f, s2 = 0.f;
        for (int tk = 0; tk < 32; ++tk) { s1 += cp1[(size_t)tk * NC_TOTAL + idx]; s2 += cp2[(size_t)tk * NC_TOTAL + idx]; }
        if (idx >= NC_PW1) { const int n = idx - NC_PW1; s2 += P.b_pw1[((n >> 7) & 1) * D + (n >> 8) * 128 + (n & 127)]; }
        c1[idx] = s1; c2[idx] = s2;
    }
}

namespace pg8 {
#define PG8_LAS __attribute__((address_space(3)))
constexpr int BM = 256, BK = 64, HALF = 128, HTB = HALF * BK * 2  , STAGE_BYTES = 8 * HTB, NXCD = 8, WGM = 8;
__host__ __device__ __forceinline__ int lds_byte(int r, int c) { const int st = (r >> 4) * 2 + (c >> 5), rr = r & 15, cc = c & 31, ob = rr * 64 + cc * 2; return st * 1024 + (ob ^ (((ob >> 9) & 1) << 5)); }
__host__ __device__ __forceinline__ void stage_rc(int b, int& R, int& C) { const int st = b / 1024, sb = b % 1024, swz = sb ^ (((sb >> 9) & 1) << 5); R = (st >> 1) * 16 + swz / 64; C = (st & 1) * 32 + (swz % 64) / 2; }
__host__ __device__ __forceinline__ int perm32(int rho) { const int n = rho >> 4, i = rho & 15; return 8 * (i >> 2) + 4 * n + (i & 3); }
struct Unit { int pm, pn; };
struct Gemm { const half_t* A; const half_t* Bt; int M, N, K; };
struct StaticOrder {
    int nM, nN, nwg, G, c;
    __host__ __device__ void init(int M, int N, int G_, int c_) { nM = M / BM; nN = N / BM; nwg = nM * nN; G = G_; c = c_; }
    __host__ __device__ bool next(int i, Unit& u) const {
        const long L = (long)i * G + c; if (L >= nwg) return false;
        int wgid = (int)L; { const int q = nwg / NXCD, r = nwg % NXCD, xcd = wgid % NXCD, off = wgid / NXCD; wgid = (xcd < r ? xcd * (q + 1) : r * (q + 1) + (xcd - r) * q) + off; }
        const int nig = WGM * nN, gid = wgid / nig, fm = gid * WGM, gsz = (nM - fm) < WGM ? (nM - fm) : WGM;
        u.pm = fm + ((wgid % nig) % gsz); u.pn = (wgid % nig) / gsz; return true;
    }
};
template <class Epi, bool ALIGN_EPI = true>
__device__ __forceinline__ void gemm_phase(PG8_LAS unsigned char* lds, const Gemm g, const StaticOrder& S, const Epi& E) {
    const int tid = threadIdx.x, wid = __builtin_amdgcn_readfirstlane(tid >> 6), lane = tid & 63, wr = wid >> 2, wc = wid & 3, fr = lane & 15, fq = lane >> 4;
    const int K = g.K, nt = K / BK;
    unsigned voffA[2], voffB[2];
#pragma unroll
    for (int i = 0; i < 2; ++i) { int R, C; stage_rc(tid * 16 + i * 8192, R, C); const int Rb = (R & ~31) + perm32(R & 31);
        voffA[i] = (unsigned)(R * K + C) * 2u; voffB[i] = (unsigned)(Rb * K + C) * 2u; }
    const size_t kstep = (size_t)(BK * 2);
    const size_t hstep = (size_t)HALF * K * 2;
    const size_t tstep = 2 * hstep;
    const unsigned ldsw = (unsigned)wid * 1024u;
    const int aoff = lds_byte(wr * 64 + fr, fq * 8), boff = lds_byte(wc * 32 + fr, fq * 8);
#define PG8_SA(b, h) (((b) * 2 + (h)) * HTB)
#define PG8_SB(b, h) ((4 + (b) * 2 + (h)) * HTB)
#define PG8_STAGE(bufoff, gbase, voff) do { _Pragma("unroll") for (int _i = 0; _i < 2; ++_i) \
        __builtin_amdgcn_global_load_lds((const unsigned*)((const char*)(gbase) + (voff)[_i]), (PG8_LAS unsigned*)(lds + (bufoff) + ldsw + _i * 8192), 16, 0, 0); } while (0)
#define PG8_LDA(dst, b, h) do { _Pragma("unroll") for (int m = 0; m < 4; ++m) _Pragma("unroll") for (int k = 0; k < 2; ++k) dst[m][k] = *(const PG8_LAS f16x8*)(lds + PG8_SA(b, h) + aoff + m * 2048 + k * 1024); } while (0)
#define PG8_LDB(dst, b, h) do { _Pragma("unroll") for (int n = 0; n < 2; ++n) _Pragma("unroll") for (int k = 0; k < 2; ++k) dst[n][k] = *(const PG8_LAS f16x8*)(lds + PG8_SB(b, h) + boff + n * 2048 + k * 1024); } while (0)
#define PG8_MMA(ai, bj, At, Bt) do { __builtin_amdgcn_s_setprio(1); _Pragma("unroll") for (int m = 0; m < 4; ++m) _Pragma("unroll") for (int n = 0; n < 2; ++n) _Pragma("unroll") for (int k = 0; k < 2; ++k) \
        acc[ai][bj][m][n] = __builtin_amdgcn_mfma_f32_16x16x32_f16(Bt[n][k], At[m][k], acc[ai][bj][m][n], 0, 0, 0); __builtin_amdgcn_s_setprio(0); } while (0)
#define PG8_WAIT_V(n) asm volatile("s_waitcnt vmcnt(" #n ")" ::: "memory")
#define PG8_WAIT_L(n) asm volatile("s_waitcnt lgkmcnt(" #n ")" ::: "memory")
#define PG8_BAR __builtin_amdgcn_s_barrier()
#define PG8_SCHED __builtin_amdgcn_sched_barrier(0)
    Unit cur, nxt; int ui = 0;
    if (!S.next(0, cur)) return;
    f32x4 acc[2][2][4][2];
#pragma unroll
    for (int a = 0; a < 2; ++a)
#pragma unroll
        for (int b = 0; b < 2; ++b)
#pragma unroll
            for (int m = 0; m < 4; ++m)
#pragma unroll
                for (int n = 0; n < 2; ++n) acc[a][b][m][n] = (f32x4){0.f, 0.f, 0.f, 0.f};
    f16x8 At[4][2], B0[2][2], B1[2][2];
    const char* cA = (const char*)g.A + (size_t)cur.pm * tstep; const char* cB = (const char*)g.Bt + (size_t)cur.pn * tstep;
    E.prepare(cur, 0);
    PG8_STAGE(PG8_SB(0, 0), cB, voffB); PG8_STAGE(PG8_SB(0, 1), cB + hstep, voffB); PG8_STAGE(PG8_SA(0, 0), cA, voffA); PG8_STAGE(PG8_SA(0, 1), cA + hstep, voffA);
    if (wr == 1) PG8_BAR;
    PG8_WAIT_V(2); PG8_BAR;
    PG8_STAGE(PG8_SB(1, 0), cB + kstep, voffB); PG8_STAGE(PG8_SA(1, 0), cA + kstep, voffA); PG8_STAGE(PG8_SB(1, 1), cB + hstep + kstep, voffB);
    PG8_WAIT_V(6); PG8_BAR;
    for (;;) {
        const bool has_next = S.next(ui + 1, nxt);
        const char* nA = has_next ? (const char*)g.A + (size_t)nxt.pm * tstep : cA; const char* nB = has_next ? (const char*)g.Bt + (size_t)nxt.pn * tstep : cB;
        for (int t = 0; t < nt; t += 2) {
            const bool last = (t == nt - 2);
            const char* a1 = cA + (size_t)(t + 1) * kstep;
            const char* a2 = last ? nA : cA + (size_t)(t + 2) * kstep; const char* b2 = last ? nB : cB + (size_t)(t + 2) * kstep;
            const char* a3 = a2 + kstep; const char* b3 = b2 + kstep;
            if (last && has_next) E.prepare(nxt, (ui + 1) & 1);
            PG8_LDB(B0, 0, 0); PG8_LDB(B1, 0, 1); PG8_SCHED; PG8_LDA(At, 0, 0); PG8_STAGE(PG8_SA(1, 1), a1 + hstep, voffA);
            PG8_WAIT_V(8); PG8_WAIT_L(0); PG8_BAR; PG8_MMA(0, 0, At, B0); PG8_MMA(0, 1, At, B1); PG8_BAR; PG8_SCHED;
            PG8_LDA(At, 0, 1); PG8_STAGE(PG8_SB(0, 0), b2, voffB); PG8_STAGE(PG8_SB(0, 1), b2 + hstep, voffB); PG8_STAGE(PG8_SA(0, 0), a2, voffA);
            PG8_WAIT_V(8); PG8_WAIT_L(0); PG8_BAR; PG8_MMA(1, 0, At, B0); PG8_MMA(1, 1, At, B1); PG8_BAR; PG8_SCHED;
            PG8_LDB(B0, 1, 0); PG8_LDB(B1, 1, 1); PG8_SCHED; PG8_LDA(At, 1, 0); PG8_STAGE(PG8_SA(0, 1), a2 + hstep, voffA);
            PG8_WAIT_V(8); PG8_WAIT_L(0); PG8_BAR; PG8_MMA(0, 0, At, B0); PG8_MMA(0, 1, At, B1); PG8_BAR; PG8_SCHED;
            PG8_LDA(At, 1, 1); PG8_STAGE(PG8_SB(1, 0), b3, voffB); PG8_STAGE(PG8_SB(1, 1), b3 + hstep, voffB); PG8_STAGE(PG8_SA(1, 0), a3, voffA);
            PG8_WAIT_V(8); PG8_WAIT_L(0); PG8_BAR; PG8_MMA(1, 0, At, B0); PG8_MMA(1, 1, At, B1); PG8_BAR; PG8_SCHED;
        }
        if constexpr (ALIGN_EPI) { if (wr == 0) PG8_BAR; }
        E(acc, cur, ui & 1, wr, wc, fr, fq);
        if (!has_next) break;
#pragma unroll
        for (int a = 0; a < 2; ++a)
#pragma unroll
            for (int b = 0; b < 2; ++b)
#pragma unroll
                for (int m = 0; m < 4; ++m)
#pragma unroll
                    for (int n = 0; n < 2; ++n) acc[a][b][m][n] = (f32x4){0.f, 0.f, 0.f, 0.f};
        cur = nxt; cA = nA; cB = nB; ++ui;
        if constexpr (ALIGN_EPI) { if (wr == 1) PG8_BAR; }
    }
    PG8_WAIT_V(0);
    if constexpr (!ALIGN_EPI) { if (wr == 0) PG8_BAR; }
    PG8_BAR;
#undef PG8_SA
#undef PG8_SB
#undef PG8_STAGE
#undef PG8_LDA
#undef PG8_LDB
#undef PG8_MMA
#undef PG8_WAIT_V
#undef PG8_WAIT_L
#undef PG8_BAR
#undef PG8_SCHED
}
}

typedef f32x4 acc_t[2][2][4][2];
DEVFN f16x8 pack8(f32x4 a, f32x4 b) { f16x8 h; h[0] = (half_t)a[0]; h[1] = (half_t)a[1]; h[2] = (half_t)a[2]; h[3] = (half_t)a[3]; h[4] = (half_t)b[0]; h[5] = (half_t)b[1]; h[6] = (half_t)b[2]; h[7] = (half_t)b[3]; return h; }
DEVFN f32x4 silu4(f32x4 g) { f32x4 o; o[0] = g[0] * sigmoidf_(g[0]); o[1] = g[1] * sigmoidf_(g[1]); o[2] = g[2] * sigmoidf_(g[2]); o[3] = g[3] * sigmoidf_(g[3]); return o; }
DEVFN f32x4 sigm4(f32x4 g) { f32x4 o; o[0] = sigmoidf_(g[0]); o[1] = sigmoidf_(g[1]); o[2] = sigmoidf_(g[2]); o[3] = sigmoidf_(g[3]); return o; }
struct EpiStoreF16 { half_t* O; int ld;
    DEVFN void prepare(const pg8::Unit&, int) const {}
    DEVFN void operator()(const acc_t& acc, const pg8::Unit& u, int, int wr, int wc, int fr, int fq) const {
        const int row0 = u.pm * 256 + wr * 64 + fr, col0 = u.pn * 256 + wc * 32 + 8 * fq;
#pragma unroll
        for (int ai = 0; ai < 2; ++ai)
#pragma unroll
            for (int m = 0; m < 4; ++m) { half_t* rowp = O + (size_t)(row0 + ai * 128 + m * 16) * ld + col0;
#pragma unroll
                for (int bj = 0; bj < 2; ++bj) *(f16x8*)(rowp + bj * 128) = pack8(acc[ai][bj][m][0], acc[ai][bj][m][1]); }
    } };
struct EpiProj { half_t* O; int ld; half_t* VT; half_t* VTM;
    DEVFN void prepare(const pg8::Unit&, int) const {}
    DEVFN void operator()(const acc_t& acc, const pg8::Unit& u, int, int wr, int wc, int fr, int fq) const {
        const int row0 = u.pm * 256 + wr * 64 + fr, col0 = u.pn * 256 + wc * 32 + 8 * fq;
#pragma unroll
        for (int ai = 0; ai < 2; ++ai)
#pragma unroll
            for (int m = 0; m < 4; ++m) { half_t* rowp = O + (size_t)(row0 + ai * 128 + m * 16) * ld + col0;
#pragma unroll
                for (int bj = 0; bj < 2; ++bj) *(f16x8*)(rowp + bj * 128) = pack8(acc[ai][bj][m][0], acc[ai][bj][m][1]); }
        if (u.pn >= 8 && u.pn < 12) {
            const int sw = (fr & 3) | ((fr & 4) << 1) | ((fr & 8) >> 1);
#pragma unroll
            for (int ai = 0; ai < 2; ++ai)
#pragma unroll
                for (int m = 0; m < 4; ++m) { const int row = row0 + ai * 128 + m * 16;
                    half_t* base; size_t dstride;
                    if (row < MX) { base = VT + (size_t)(row >> 11) * 1024 * SEQ + (((row & 2047) & ~15) | sw); dstride = SEQ; }
                    else { base = VTM + (((row - MX) & ~15) | sw); dstride = 256; }
#pragma unroll
                    for (int bj = 0; bj < 2; ++bj)
#pragma unroll
                        for (int n = 0; n < 2; ++n)
#pragma unroll
                            for (int e = 0; e < 4; ++e) base[(size_t)(col0 - COL_V + bj * 128 + 4 * n + e) * dstride] = (half_t)acc[ai][bj][m][n][e]; }
        }
    } };
constexpr int TAB_OFF = 131072;
DEVFN void rowstat_fill(const float* st, int pm, char* lds, int parity) {
    const int t = threadIdx.x;
    if (t < 256) { const f32x4* p = (const f32x4*)(st + (size_t)(pm * 256 + t) * 32); float s = 0.f, q = 0.f;
#pragma unroll
        for (int i = 0; i < 8; ++i) { const f32x4 v = p[i]; s += v[0] + v[2]; q += v[1] + v[3]; }
        const float mean = s * (1.f / D), var = fmaxf(q * (1.f / D) - mean * mean, 0.f);
        float* tab = (float*)(lds + TAB_OFF) + parity * 512;
        tab[2 * t] = mean; tab[2 * t + 1] = 1.0f / sqrtf(var + LN_EPS); }
}
DEVFN void stat_acc(const f16x8 h, float& s, float& q) {
#pragma unroll
    for (int i = 0; i < 8; ++i) { const float v = (float)h[i]; s += v; q = fmaf(v, v, q); }
}
DEVFN void stat_store(float* st, int row, int slot, float s, float q, int fq) {
    s += __shfl_xor(s, 16); s += __shfl_xor(s, 32); q += __shfl_xor(q, 16); q += __shfl_xor(q, 32);
    if (fq == 0) { float* p = st + (size_t)row * 32 + slot * 2; p[0] = s; p[1] = q; }
}
struct EpiLnSwiGLU { half_t* O; int ld; const float* st; const float* c1; const float* c2; char* lds;
    DEVFN void prepare(const pg8::Unit& u, int parity) const { rowstat_fill(st, u.pm, lds, parity); }
    DEVFN void operator()(const acc_t& acc, const pg8::Unit& u, int parity, int wr, int wc, int fr, int fq) const {
        const int rl0 = wr * 64 + fr, col0 = u.pn * 128 + wc * 32 + 8 * fq, n0 = u.pn * 256 + wc * 32 + 8 * fq;
        const float* tab = (const float*)(lds + TAB_OFF) + parity * 512;
        f32x4 k1[2][2], k2[2][2];
#pragma unroll
        for (int bj = 0; bj < 2; ++bj)
#pragma unroll
            for (int n = 0; n < 2; ++n) { k1[bj][n] = *(const f32x4*)(c1 + n0 + bj * 128 + 4 * n); k2[bj][n] = *(const f32x4*)(c2 + n0 + bj * 128 + 4 * n); }
#pragma unroll
        for (int ai = 0; ai < 2; ++ai)
#pragma unroll
            for (int m = 0; m < 4; ++m) { const int rl = rl0 + ai * 128 + m * 16; const float mean = tab[2 * rl], rstd = tab[2 * rl + 1];
                f32x4 g[2], up[2];
#pragma unroll
                for (int n = 0; n < 2; ++n) { g[n] = (acc[ai][0][m][n] - k1[0][n] * mean) * rstd + k2[0][n]; up[n] = (acc[ai][1][m][n] - k1[1][n] * mean) * rstd + k2[1][n]; }
                *(f16x8*)(O + (size_t)(u.pm * 256 + rl) * ld + col0) = pack8(silu4(g[0]) * up[0], silu4(g[1]) * up[1]); }
    } };
struct EpiLnGLU { half_t* O; int ld; const float* st; const float* c1; const float* c2; char* lds;
    DEVFN void prepare(const pg8::Unit& u, int parity) const { rowstat_fill(st, u.pm, lds, parity); }
    DEVFN void operator()(const acc_t& acc, const pg8::Unit& u, int parity, int wr, int wc, int fr, int fq) const {
        const int rl0 = wr * 64 + fr, col0 = u.pn * 128 + wc * 32 + 8 * fq, n0 = u.pn * 256 + wc * 32 + 8 * fq;
        const float* tab = (const float*)(lds + TAB_OFF) + parity * 512;
        f32x4 k1[2][2], k2[2][2];
#pragma unroll
        for (int bj = 0; bj < 2; ++bj)
#pragma unroll
            for (int n = 0; n < 2; ++n) { k1[bj][n] = *(const f32x4*)(c1 + n0 + bj * 128 + 4 * n); k2[bj][n] = *(const f32x4*)(c2 + n0 + bj * 128 + 4 * n); }
#pragma unroll
        for (int ai = 0; ai < 2; ++ai)
#pragma unroll
            for (int m = 0; m < 4; ++m) { const int rl = rl0 + ai * 128 + m * 16; const float mean = tab[2 * rl], rstd = tab[2 * rl + 1];
                f32x4 a[2], sg[2];
#pragma unroll
                for (int n = 0; n < 2; ++n) { a[n] = (acc[ai][0][m][n] - k1[0][n] * mean) * rstd + k2[0][n]; sg[n] = (acc[ai][1][m][n] - k1[1][n] * mean) * rstd + k2[1][n]; }
                *(f16x8*)(O + (size_t)(u.pm * 256 + rl) * ld + col0) = pack8(a[0] * sigm4(sg[0]), a[1] * sigm4(sg[1])); }
    } };
struct EpiResidX { const float* x; const float* meta; half_t* Y; float* sto;
    DEVFN void prepare(const pg8::Unit&, int) const {}
    DEVFN void operator()(const acc_t& acc, const pg8::Unit& u, int, int wr, int wc, int fr, int fq) const {
        const int row0 = u.pm * 256 + wr * 64 + fr, col0 = u.pn * 256 + wc * 32 + 8 * fq;
#pragma unroll
        for (int ai = 0; ai < 2; ++ai)
#pragma unroll
            for (int m = 0; m < 4; ++m) { const int row = row0 + ai * 128 + m * 16;
                const float* src = row < MX ? x + (size_t)row * D : (row < MV ? meta + (size_t)(row - MX) * D : nullptr);
                float s = 0.f, q = 0.f;
#pragma unroll
                for (int bj = 0; bj < 2; ++bj) { const int col = col0 + bj * 128;
                    const f32x4 r0 = src ? *(const f32x4*)(src + col) : (f32x4){0.f, 0.f, 0.f, 0.f}, r1 = src ? *(const f32x4*)(src + col + 4) : (f32x4){0.f, 0.f, 0.f, 0.f};
                    const f16x8 h = pack8(r0 * ALPHA + acc[ai][bj][m][0], r1 * ALPHA + acc[ai][bj][m][1]);
                    *(f16x8*)(Y + (size_t)row * D + col) = h; stat_acc(h, s, q); }
                stat_store(sto, row, u.pn * 4 + wc, s, q, fq); }
    } };
struct EpiResidLN { half_t* Y; const float* sti; float* sto; const float* g; const float* b; const float* bias; char* lds;
    DEVFN void prepare(const pg8::Unit& u, int parity) const { rowstat_fill(sti, u.pm, lds, parity); }
    DEVFN void operator()(const acc_t& acc, const pg8::Unit& u, int parity, int wr, int wc, int fr, int fq) const {
        const int rl0 = wr * 64 + fr, col0 = u.pn * 256 + wc * 32 + 8 * fq;
        const float* tab = (const float*)(lds + TAB_OFF) + parity * 512;
        f32x4 gg[2][2], bb[2][2];
#pragma unroll
        for (int bj = 0; bj < 2; ++bj)
#pragma unroll
            for (int n = 0; n < 2; ++n) { const int c = col0 + bj * 128 + 4 * n; gg[bj][n] = *(const f32x4*)(g + c) * ALPHA;
                bb[bj][n] = *(const f32x4*)(b + c) * ALPHA; if (bias) bb[bj][n] += *(const f32x4*)(bias + c); }
#pragma unroll
        for (int ai = 0; ai < 2; ++ai)
#pragma unroll
            for (int m = 0; m < 4; ++m) { const int rl = rl0 + ai * 128 + m * 16, row = u.pm * 256 + rl; const float mean = tab[2 * rl], rstd = tab[2 * rl + 1];
                float s = 0.f, q = 0.f;
#pragma unroll
                for (int bj = 0; bj < 2; ++bj) { half_t* yp = Y + (size_t)row * D + col0 + bj * 128; const f16x8 yv = *(const f16x8*)yp;
                    f32x4 y0, y1;
#pragma unroll
                    for (int e = 0; e < 4; ++e) { y0[e] = ((float)yv[e] - mean) * rstd; y1[e] = ((float)yv[4 + e] - mean) * rstd; }
                    const f16x8 h = pack8(y0 * gg[bj][0] + bb[bj][0] + acc[ai][bj][m][0], y1 * gg[bj][1] + bb[bj][1] + acc[ai][bj][m][1]);
                    *(f16x8*)yp = h; stat_acc(h, s, q); }
                stat_store(sto, row, u.pn * 4 + wc, s, q, fq); }
    } };
template <class Epi>
DEVFN void gemm_phase(const half_t* A, const half_t* Bt, int M, int N, int K, const Epi& epi, char* lds, int bid, int nb) {
    pg8::Gemm g{A, Bt, M, N, K}; pg8::StaticOrder S; S.init(M, N, nb, bid);
    pg8::gemm_phase<Epi, true>((PG8_LAS unsigned char*)lds, g, S, epi);
}

DEVFN void phase_final_ln(const Params& P, const float* st, const float* g, const float* b, int bid, int nb) {
    const half_t* Y = (const half_t*)(P.ws + OFF_Y);
    const int lane = threadIdx.x & 63, gw = bid * (NTHREADS / 64) + (threadIdx.x >> 6), ngw = nb * (NTHREADS / 64);
    for (int r = gw; r < MX; r += ngw) {
        float s = st[(size_t)r * 32 + (lane & 15) * 2], q = st[(size_t)r * 32 + (lane & 15) * 2 + 1];
#pragma unroll
        for (int o = 1; o < 16; o <<= 1) { s += __shfl_xor(s, o); q += __shfl_xor(q, o); }
        const float mean = s * (1.f / D), rstd = 1.0f / sqrtf(fmaxf(q * (1.f / D) - mean * mean, 0.f) + LN_EPS);
#pragma unroll
        for (int j = 0; j < 2; ++j) { const int c = lane * 8 + 512 * j; const f16x8 yv = *(const f16x8*)(Y + (size_t)r * D + c);
            f32x4 o0, o1;
#pragma unroll
            for (int e = 0; e < 4; ++e) { o0[e] = ((float)yv[e] - mean) * rstd; o1[e] = ((float)yv[4 + e] - mean) * rstd; }
            *(f32x4*)(P.out + (size_t)r * D + c) = o0 * *(const f32x4*)(g + c) + *(const f32x4*)(b + c);
            *(f32x4*)(P.out + (size_t)r * D + c + 4) = o1 * *(const f32x4*)(g + c + 4) + *(const f32x4*)(b + c + 4); }
    }
}

DEVFN int key_row(int b, int p) { return p < NMETA ? MX + p : b * SEQ + p - NMETA; }
constexpr int IDX_ROW = 2116;
DEVFN int half_sum_i(int v) {
#pragma unroll
    for (int o = 1; o < 32; o <<= 1) v += __shfl_xor(v, o);
    return v;
}
DEVFN void phase_indexer(const Params& P, char* lds, int bid, int nb) {
    float* sc = (float*)lds;
    const half_t* proj = (const half_t*)(P.ws + OFF_BIG);
    unsigned long long* maskt = (unsigned long long*)(P.ws + OFF_MASK);
    const int tid = threadIdx.x, lane = tid & 63, wid = __builtin_amdgcn_readfirstlane(tid >> 6), fr = lane & 15, quad = lane >> 4;
    for (int L = bid; L < NBATCH * (SEQ / 16); L += nb) {
        const int i = (SEQ / 16 - 1) - (L >> 4), b = L & 15, s0 = 16 * i;
        if (s0 + 32 <= 256) {
            const int q = tid >> 5, s = s0 + q;
            for (int k = tid & 31; k < 33; k += 32) {
                unsigned long long bits;
                if (k == 0) bits = 0xFFFFull;
                else { const int base = 64 * (k - 1); bits = (s >= base + 63) ? ~0ull : (s < base ? 0ull : ((2ull << (s - base)) - 1ull)); }
                maskt[((size_t)b * 33 + k) * SEQ + s] = bits;
            }
            continue;
        }
        {
            const half_t* qrow = proj + (size_t)(b * SEQ + s0 + fr) * NPROJ;
            f16x8 bq[8][2];
#pragma unroll
            for (int h = 0; h < 8; ++h)
#pragma unroll
                for (int kh = 0; kh < 2; ++kh) bq[h][kh] = *(const f16x8*)(qrow + COL_QI + h * 64 + kh * 32 + quad * 8);
            float w[8]; { const f16x8 wv = *(const f16x8*)(qrow + COL_WI);
#pragma unroll
                for (int h = 0; h < 8; ++h) w[h] = (float)wv[h] * 0.04419417382415922f; }
            const int nblk = i + 2;
            int j = wid;
            const half_t* kp = proj + (size_t)(j == 0 ? MX + fr : b * SEQ + 16 * (j - 1) + fr) * NPROJ + COL_KI + quad * 8;
            f16x8 a0 = *(const f16x8*)kp, a1 = *(const f16x8*)(kp + 32);
            for (; j < nblk; j += 8) {
                const int jn = (j + 8 < nblk) ? j + 8 : j;
                const half_t* kn = proj + (size_t)(jn == 0 ? MX + fr : b * SEQ + 16 * (jn - 1) + fr) * NPROJ + COL_KI + quad * 8;
                const f16x8 n0 = *(const f16x8*)kn, n1 = *(const f16x8*)(kn + 32);
                f32x4 s4 = (f32x4){0.f, 0.f, 0.f, 0.f};
#pragma unroll
                for (int h = 0; h < 8; ++h) {
                    f32x4 acc = __builtin_amdgcn_mfma_f32_16x16x32_f16(a0, bq[h][0], (f32x4){0.f, 0.f, 0.f, 0.f}, 0, 0, 0);
                    acc = __builtin_amdgcn_mfma_f32_16x16x32_f16(a1, bq[h][1], acc, 0, 0, 0);
#pragma unroll
                    for (int e = 0; e < 4; ++e) s4[e] = fmaf(w[h], fmaxf(acc[e], 0.f), s4[e]);
                }
                s4 = s4 + 0.0f;
                const int slot = (j == 0 ? 0 : 64 + 16 * (j - 1)) + 4 * quad;
                *(f32x4*)(sc + fr * IDX_ROW + slot) = s4;
                a0 = n0; a1 = n1;
            }
        }
        __syncthreads();
        {
            const int qq = 2 * wid + (lane >> 5), li = lane & 31, sq = s0 + qq;
            const float* row = sc + qq * IDX_ROW;
            float v[66]; float vmin = INFINITY, vmax = -INFINITY;
#pragma unroll
            for (int j = 0; j < 66; ++j) { const int slot = 32 * j + li; const bool valid = slot < 16 || (slot >= 64 && slot - 64 <= sq);
                const float x = valid ? row[slot] : -INFINITY; v[j] = x; vmax = fmaxf(vmax, x); vmin = fminf(vmin, valid ? x : INFINITY); }
#pragma unroll
            for (int o = 1; o < 32; o <<= 1) { vmin = fminf(vmin, __shfl_xor(vmin, o)); vmax = fmaxf(vmax, __shfl_xor(vmax, o)); }
            float lo = vmin - (fabsf(vmin) * 1e-6f + 1e-30f), hi = vmax; int clo = sq + 17, chi = 0;
            float thr = 0.f, tiev = 0.f; int need = 0; bool done = false;
            for (int it = 0; it < 256; ++it) {
                float mid = 0.5f * (lo + hi);
                if (!done) {
                    if (clo == 256) { thr = lo; need = 0; done = true; }
                    else {
                        if (!(it & 1)) { const float mi = lo + (hi - lo) * (((float)(clo - 256) + 0.5f) / (float)(clo - chi)); if (mi > lo && mi < hi) mid = mi; }
                        if (!(mid > lo && mid < hi)) { thr = hi; tiev = hi; need = 256 - chi; done = true; }
                    }
                }
                if (!__any(!done)) break;
                int c = 0;
#pragma unroll
                for (int j = 0; j < 66; ++j) c += (v[j] > mid) ? 1 : 0;
                c = half_sum_i(c);
                if (!done) { if (c >= 256) { lo = mid; clo = c; } else { hi = mid; chi = c; } }
            }
            int eqbase = 0; unsigned long long wA = 0ull, wB = 0ull, prev = 0ull;
            unsigned long long* mbase = maskt + (size_t)b * 33 * SEQ + s0 + 2 * wid;
#pragma unroll
            for (int j = 0; j < 66; ++j) {
                const bool eq = need > 0 && v[j] == tiev;
                const unsigned long long eb = __ballot(eq);
                const unsigned e32 = (lane >> 5) ? (unsigned)(eb >> 32) : (unsigned)eb;
                const int rank = eqbase + __popc(e32 & ((1u << li) - 1u));
                eqbase += __popc(e32);
                const bool sel = v[j] > thr || (eq && rank < need);
                const unsigned long long sb = __ballot(sel);
                if (j & 1) { wA = (prev & 0xFFFFFFFFull) | (sb << 32); wB = (prev >> 32) | (sb & 0xFFFFFFFF00000000ull);
                    if (lane == 0) { unsigned long long* mp = mbase + (size_t)(j >> 1) * SEQ; mp[0] = wA; mp[1] = wB; } }
                else prev = sb;
            }
        }
        __syncthreads();
    }
}

DEVFN int t5_bucket(int d) {
    if (d < 16) return d;
    const int bd[15] = {19, 21, 24, 27, 31, 35, 40, 46, 52, 59, 67, 77, 87, 99, 113};
    int b = 16;
#pragma unroll
    for (int i = 0; i < 15; ++i) b += (d >= bd[i]) ? 1 : 0;
    return b;
}
constexpr float LOG2E = 1.4426950408889634f;
constexpr float QSCALE = 0.125f * LOG2E;
typedef float f32x16 __attribute__((ext_vector_type(16)));
#define ATT_LAS __attribute__((address_space(3)))
constexpr int ATT_K = 0, ATT_V = 16384, ATT_DL = 32768, ATT_LDS = 32768 + 1024;
DEVFN void attn_unit(const Params& P, char* lds, int b, int h, int qb) {
    const int tid = threadIdx.x, lane = tid & 63, wid = __builtin_amdgcn_readfirstlane(tid >> 6), r32 = lane & 31, hi = lane >> 5;
    const half_t* proj = (const half_t*)(P.ws + OFF_BIG);
    const half_t* VT = (const half_t*)P.out; const half_t* VTM = VT + VT_ELEMS;
    const unsigned long long* maskt = (const unsigned long long*)(P.ws + OFF_MASK) + (size_t)b * 33 * SEQ;
    ATT_LAS char* L = (ATT_LAS char*)lds;
    float* dl = (float*)(lds + ATT_DL);
    const int sq = 256 * qb + 32 * wid + r32;
    const int NT = 4 * qb + 5;
    if (tid < 129) dl[tid] = tid < 128 ? (P.rel_bias[t5_bucket(tid) * 16 + h] - P.rel_bias[31 * 16 + h]) * LOG2E : 0.f;
    f16x8 qf[4];
#pragma unroll
    for (int d0 = 0; d0 < 4; ++d0) qf[d0] = *(const f16x8*)(proj + ((size_t)b * SEQ + sq) * NPROJ + h * 64 + 16 * d0 + 8 * hi);
    const int drow = wid * 8 + (lane >> 3), dch = (lane & 7) ^ ((lane >> 3) & 7);
    const half_t* ksrc_m = proj + (size_t)(MX + drow) * NPROJ + COL_K + h * 64 + dch * 8;
    const half_t* ksrc_x = proj + ((size_t)b * SEQ + drow) * NPROJ + COL_K + h * 64 + dch * 8;
    const half_t* vsrc_m = VTM + (size_t)(h * 64 + drow) * 256 + dch * 8;
    const half_t* vsrc_x = VT + ((size_t)(b * 16 + h) * 64 + drow) * SEQ + dch * 8;
#define ATT_DMA(tt, slot) do { const half_t* ks_ = (tt) == 0 ? ksrc_m : ksrc_x + (size_t)((tt) - 1) * 64 * NPROJ; const half_t* vs_ = (tt) == 0 ? vsrc_m : vsrc_x + ((tt) - 1) * 64; \
        __builtin_amdgcn_global_load_lds((const unsigned*)ks_, (ATT_LAS unsigned*)(L + ATT_K + (slot) * 8192 + wid * 1024), 16, 0, 0); \
        __builtin_amdgcn_global_load_lds((const unsigned*)vs_, (ATT_LAS unsigned*)(L + ATT_V + (slot) * 8192 + wid * 1024), 16, 0, 0); } while (0)
    int foff[8];
#pragma unroll
    for (int c = 0; c < 8; ++c) foff[c] = r32 * 128 + (((c) ^ (r32 & 7)) * 16);
    float m = -1e30f, l = 0.f;
    f32x16 o0, o1;
#pragma unroll
    for (int r = 0; r < 16; ++r) { o0[r] = 0.f; o1[r] = 0.f; }
    ATT_DMA(0, 0);
    unsigned long long mw_next = maskt[sq];
    asm volatile("s_waitcnt vmcnt(0)" ::: "memory");
    __syncthreads();
    for (int tt = 0; tt < NT; ++tt) {
        const int cur = tt & 1;
        const unsigned long long mw = mw_next;
        if (tt + 1 < NT) { ATT_DMA(tt + 1, cur ^ 1); mw_next = maskt[(size_t)(tt + 1) * SEQ + sq]; }
        const int kbase = tt == 0 ? 0 : 64 * (tt - 1);
        const bool active = tt == 0 || kbase <= 256 * qb + 32 * wid + 31;
        if (active) {
            f32x16 c0, c1;
#pragma unroll
            for (int r = 0; r < 16; ++r) { c0[r] = 0.f; c1[r] = 0.f; }
            const ATT_LAS char* kb = L + ATT_K + cur * 8192;
#pragma unroll
            for (int d0 = 0; d0 < 4; ++d0) {
                const f16x8 k0 = *(const ATT_LAS f16x8*)(kb + foff[2 * d0 + hi]);
                const f16x8 k1 = *(const ATT_LAS f16x8*)(kb + 4096 + foff[2 * d0 + hi]);
                c0 = __builtin_amdgcn_mfma_f32_32x32x16_f16(k0, qf[d0], c0, 0, 0, 0);
                c1 = __builtin_amdgcn_mfma_f32_32x32x16_f16(k1, qf[d0], c1, 0, 0, 0);
            }
            const int dist0 = tt == 0 ? sq + 16 - 4 * hi : sq - kbase - 4 * hi;
            const bool nearb = tt == 0 ? (256 * qb + 32 * wid + 16 - 15 < 128) : (256 * qb + 32 * wid - (kbase + 63) < 128);
            if (nearb) {
#pragma unroll
                for (int r = 0; r < 16; ++r) { const int kk = (r & 3) + 8 * (r >> 2);
                    int d0_ = dist0 - kk, d1_ = dist0 - kk - 32; d0_ = d0_ < 0 ? 0 : (d0_ > 128 ? 128 : d0_); d1_ = d1_ < 0 ? 0 : (d1_ > 128 ? 128 : d1_);
                    c0[r] += dl[d0_]; c1[r] += dl[d1_]; }
            }
            const unsigned mlo = (unsigned)mw >> (4 * hi), mhi = (unsigned)(mw >> 32) >> (4 * hi);
            float tmax = -INFINITY;
#pragma unroll
            for (int r = 0; r < 16; ++r) { const int cb = (r & 3) + 8 * (r >> 2);
                c0[r] = ((mlo >> cb) & 1u) ? c0[r] : -INFINITY; c1[r] = ((mhi >> cb) & 1u) ? c1[r] : -INFINITY;
                tmax = fmaxf(tmax, fmaxf(c0[r], c1[r])); }
            tmax = fmaxf(tmax, __shfl_xor(tmax, 32));
            const float mn = fmaxf(m, tmax), alpha = __builtin_amdgcn_exp2f(m - mn);
            m = mn;
            float ls = 0.f;
#pragma unroll
            for (int r = 0; r < 16; ++r) { c0[r] = __builtin_amdgcn_exp2f(c0[r] - mn); c1[r] = __builtin_amdgcn_exp2f(c1[r] - mn); ls += c0[r] + c1[r]; }
            l = l * alpha + ls;
            if (!__all(alpha == 1.0f)) {
#pragma unroll
                for (int r = 0; r < 16; ++r) { o0[r] *= alpha; o1[r] *= alpha; }
            }
            const ATT_LAS char* vb = L + ATT_V + cur * 8192;
#pragma unroll
            for (int s = 0; s < 4; ++s) {
                f16x8 pf;
#pragma unroll
                for (int jj = 0; jj < 8; ++jj) pf[jj] = (half_t)((s < 2) ? c0[8 * (s & 1) + jj] : c1[8 * (s & 1) + jj]);
                const f16x8 v0 = *(const ATT_LAS f16x8*)(vb + foff[2 * s + hi]);
                const f16x8 v1 = *(const ATT_LAS f16x8*)(vb + 4096 + foff[2 * s + hi]);
                o0 = __builtin_amdgcn_mfma_f32_32x32x16_f16(v0, pf, o0, 0, 0, 0);
                o1 = __builtin_amdgcn_mfma_f32_32x32x16_f16(v1, pf, o1, 0, 0, 0);
            }
        }
        asm volatile("s_waitcnt vmcnt(0)" ::: "memory");
        __syncthreads();
    }
#undef ATT_DMA
    l += __shfl_xor(l, 32);
    const float il = 1.0f / l;
    half_t* orow = (half_t*)(P.ws + OFF_HA) + ((size_t)b * SEQ + sq) * D + h * 64;
#pragma unroll
    for (int g = 0; g < 4; ++g) { f16x4 a, c;
#pragma unroll
        for (int e = 0; e < 4; ++e) { a[e] = (half_t)(o0[4 * g + e] * il); c[e] = (half_t)(o1[4 * g + e] * il); }
        *(f16x4*)(orow + 8 * g + 4 * hi) = a; *(f16x4*)(orow + 32 + 8 * g + 4 * hi) = c; }
}
DEVFN void attn_meta_rows(const Params& P, int bid, int nb) {
    const half_t* proj = (const half_t*)(P.ws + OFF_BIG); half_t* AO = (half_t*)(P.ws + OFF_HA);
    const int tid = threadIdx.x & 255, sub = threadIdx.x >> 8, head = tid >> 4;
    for (int mrow = 2 * bid + sub; mrow < NMETA; mrow += 2 * nb) {
        const int r = MX + mrow;
        float q[4]; { const f16x4 qv = *(const f16x4*)(proj + (size_t)r * NPROJ + tid * 4); q[0] = (float)qv[0]; q[1] = (float)qv[1]; q[2] = (float)qv[2]; q[3] = (float)qv[3]; }
        float m = -1e30f, l = 0.f, o[4] = {0.f, 0.f, 0.f, 0.f};
        for (int p = 0; p <= mrow; ++p) {
            const half_t* kr = proj + (size_t)(MX + p) * NPROJ + tid * 4;
            const f16x4 kv = *(const f16x4*)(kr + COL_K), vv = *(const f16x4*)(kr + COL_V);
            float d = q[0] * (float)kv[0] + q[1] * (float)kv[1] + q[2] * (float)kv[2] + q[3] * (float)kv[3];
            d += __shfl_xor(d, 1); d += __shfl_xor(d, 2); d += __shfl_xor(d, 4); d += __shfl_xor(d, 8);
            const float s = d + P.rel_bias[t5_bucket(mrow - p) * 16 + head] * LOG2E;
            const float mn = fmaxf(m, s), corr = __builtin_amdgcn_exp2f(m - mn), pe = __builtin_amdgcn_exp2f(s - mn);
            l = l * corr + pe;
#pragma unroll
            for (int c = 0; c < 4; ++c) o[c] = o[c] * corr + pe * (float)vv[c];
            m = mn;
        }
        const float il = 1.0f / l; f16x4 hh; hh[0] = (half_t)(o[0] * il); hh[1] = (half_t)(o[1] * il); hh[2] = (half_t)(o[2] * il); hh[3] = (half_t)(o[3] * il);
        *(f16x4*)(AO + (size_t)r * D + tid * 4) = hh;
    }
}
DEVFN void phase_attn(const Params& P, char* lds, int bid, int nb) {
    attn_meta_rows(P, bid, nb);
    for (int bh = bid; bh < NBATCH * 16; bh += nb)
        for (int qb = 7; qb >= 0; --qb) attn_unit(P, lds, bh >> 4, bh & 15, qb);
}

DEVFN void phase_conv(const Params& P, int bid, int nb) {
    const half_t* U = (const half_t*)(P.ws + OFF_BIG); half_t* C = (half_t*)(P.ws + OFF_C);
    const int lane = threadIdx.x & 63, gw = bid * (NTHREADS / 64) + (threadIdx.x >> 6), ngw = nb * (NTHREADS / 64);
    for (int r = gw; r < MX; r += ngw) {
        const int b = r >> 11, t = (r & 2047) + NMETA;
        float a[2][8];
#pragma unroll
        for (int h = 0; h < 2; ++h)
#pragma unroll
            for (int j = 0; j < 8; ++j) a[h][j] = P.b_dw[h * 512 + lane * 8 + j];
        for (int k = 0; k < 31; ++k) {
            const int p = t - 30 + k; if (p < 0) continue;
            const half_t* ur = U + (size_t)key_row(b, p) * D;
#pragma unroll
            for (int h = 0; h < 2; ++h) { const int c = h * 512 + lane * 8; const f16x8 uv = *(const f16x8*)(ur + c);
                const f32x4 w0 = *(const f32x4*)(P.w_dw + (size_t)k * D + c), w1 = *(const f32x4*)(P.w_dw + (size_t)k * D + c + 4);
#pragma unroll
                for (int j = 0; j < 4; ++j) { a[h][j] = fmaf(w0[j], (float)uv[j], a[h][j]); a[h][4 + j] = fmaf(w1[j], (float)uv[4 + j], a[h][4 + j]); } }
        }
        float s = 0.f;
#pragma unroll
        for (int h = 0; h < 2; ++h)
#pragma unroll
            for (int j = 0; j < 8; ++j) s += a[h][j];
        const float mean = wave_sum(s) * (1.f / D); float q = 0.f;
#pragma unroll
        for (int h = 0; h < 2; ++h)
#pragma unroll
            for (int j = 0; j < 8; ++j) { a[h][j] -= mean; q += a[h][j] * a[h][j]; }
        const float rstd = 1.0f / sqrtf(wave_sum(q) * (1.f / D) + LN_EPS);
#pragma unroll
        for (int h = 0; h < 2; ++h) { const int c = h * 512 + lane * 8; f16x8 o;
#pragma unroll
            for (int j = 0; j < 8; ++j) { const float y = a[h][j] * rstd * P.cln_g[c + j] + P.cln_b[c + j]; o[j] = (half_t)(y * sigmoidf_(y)); }
            *(f16x8*)(C + (size_t)r * D + c) = o; }
    }
}

constexpr int N_PHASES = 13;
constexpr int LDS_BYTES = 147456;
static_assert(pg8::STAGE_BYTES == 131072, "LDS");

DEVFN void run_phase(const Params& P, int ph, char* lds, int bid, int nb) {
    unsigned char* ws = P.ws;
    half_t* HA = (half_t*)(ws + OFF_HA); half_t* BIG = (half_t*)(ws + OFF_BIG); half_t* CB = (half_t*)(ws + OFF_C); half_t* Y = (half_t*)(ws + OFF_Y);
    float* ST0 = (float*)(ws + OFF_ST0); float* ST1 = (float*)(ws + OFF_ST1); const float* C1 = (const float*)(ws + OFF_C1); const float* C2 = (const float*)(ws + OFF_C2);
    switch (ph) {
    case 0: phase_prep(P, lds, bid, nb); break;
    case 1: gemm_phase(HA, (const half_t*)(ws + OFF_W_IN), MP, NPROJ, D, EpiProj{BIG, NPROJ, (half_t*)P.out, (half_t*)P.out + VT_ELEMS}, lds, bid, nb); break;
    case 2: finish_colconsts(P, bid, nb); phase_indexer(P, lds, bid, nb); break;
    case 3: phase_attn(P, lds, bid, nb); break;
    case 4: gemm_phase(HA, (const half_t*)(ws + OFF_W_O), MP, D, D, EpiResidX{P.x, P.meta, Y, ST0}, lds, bid, nb); break;
    case 5: gemm_phase(Y, (const half_t*)(ws + OFF_W_GU0), MP, 2 * DFF, D, EpiLnSwiGLU{BIG, DFF, ST0, C1 + NC_GU0, C2 + NC_GU0, lds}, lds, bid, nb); break;
    case 6: gemm_phase(BIG, (const half_t*)(ws + OFF_W_D0), MP, D, DFF, EpiResidLN{Y, ST0, ST1, P.ln1_g, P.ln1_b, nullptr, lds}, lds, bid, nb); break;
    case 7: gemm_phase(Y, (const half_t*)(ws + OFF_W_PW1), MP, 2 * D, D, EpiLnGLU{BIG, D, ST1, C1 + NC_PW1, C2 + NC_PW1, lds}, lds, bid, nb); break;
    case 8: phase_conv(P, bid, nb); break;
    case 9: gemm_phase(CB, (const half_t*)(ws + OFF_W_PW2), MX, D, D, EpiResidLN{Y, ST1, ST0, P.ln2_g, P.ln2_b, P.b_pw2, lds}, lds, bid, nb); break;
    case 10: gemm_phase(Y, (const half_t*)(ws + OFF_W_GU1), MX, 2 * DFF, D, EpiLnSwiGLU{BIG, DFF, ST0, C1 + NC_GU1, C2 + NC_GU1, lds}, lds, bid, nb); break;
    case 11: gemm_phase(BIG, (const half_t*)(ws + OFF_W_D1), MX, D, DFF, EpiResidLN{Y, ST0, ST1, P.ln1_g + D, P.ln1_b + D, nullptr, lds}, lds, bid, nb); break;
    case 12: phase_final_ln(P, ST1, P.ln2_g + D, P.ln2_b + D, bid, nb); break;
    default: break;
    }
}

#if MODE_COOP
__global__ void __launch_bounds__(NTHREADS, 2) fwd_mega(Params P) {
    extern __shared__ __attribute__((aligned(16))) char lds[];
    cg::grid_group grid = cg::this_grid();
#define PHASE(k) run_phase(P, k, lds, blockIdx.x, gridDim.x)
#define SEAM() grid.sync()
    PHASE(0); SEAM(); PHASE(1); SEAM(); PHASE(2); SEAM(); PHASE(3); SEAM(); PHASE(4); SEAM(); PHASE(5); SEAM(); PHASE(6); SEAM(); PHASE(7); SEAM();
    PHASE(8); SEAM(); PHASE(9); SEAM(); PHASE(10); SEAM(); PHASE(11); SEAM(); PHASE(12);
#undef PHASE
#undef SEAM
}
#else
template <int PH> __global__ void __launch_bounds__(NTHREADS, 2) fwd_phase(Params P) {
    extern __shared__ __attribute__((aligned(16))) char lds[];
    run_phase(P, PH, lds, blockIdx.x, gridDim.x);
}
template <int PH> static void launch_phases(const Params& p, hipStream_t stream) {
    hipFuncSetAttribute((const void*)fwd_phase<PH>, hipFuncAttributeMaxDynamicSharedMemorySize, LDS_BYTES);
    hipLaunchKernelGGL(fwd_phase<PH>, dim3(256), dim3(NTHREADS), LDS_BYTES, stream, p);
    if constexpr (PH + 1 < N_PHASES) launch_phases<PH + 1>(p, stream);
}
#endif

extern "C" void kernel_launch(void* const* d_in, const int* in_sizes, int n_in, void* d_out, int out_size, void* d_ws, size_t ws_size, hipStream_t stream) {
    if (n_in != 20 || ws_size < WS_END || out_size != MX * D) { fprintf(stderr, "kernel_launch: unexpected sizes n_in %d ws %zu out %d\n", n_in, ws_size, out_size); return; }
    Params p{};
    const float** pp = (const float**)&p;
    for (int i = 0; i < 20; ++i) pp[i] = (const float*)d_in[i];
    p.out = (float*)d_out; p.ws = (unsigned char*)d_ws;
#if MODE_COOP
    static int grid_blocks = 0;
    if (!grid_blocks) {
        int dev = 0, cus = 0, per_cu = 0;
        hipGetDevice(&dev); hipDeviceGetAttribute(&cus, hipDeviceAttributeMultiprocessorCount, dev);
        hipFuncSetAttribute((const void*)fwd_mega, hipFuncAttributeMaxDynamicSharedMemorySize, LDS_BYTES);
        hipOccupancyMaxActiveBlocksPerMultiprocessor(&per_cu, fwd_mega, NTHREADS, LDS_BYTES);
        if (per_cu < 1) per_cu = 1;
        grid_blocks = cus * per_cu;
    }
    void* args[] = {&p};
    hipError_t e = hipLaunchCooperativeKernel((void*)fwd_mega, dim3(grid_blocks), dim3(NTHREADS), args, LDS_BYTES, stream);
    if (e != hipSuccess) fprintf(stderr, "cooperative launch failed: %s (grid %d)\n", hipGetErrorString(e), grid_blocks);
#else
    launch_phases<0>(p, stream);
#endif
}
```

```cpp
#include <hip/hip_runtime.h>
#include <hip/hip_cooperative_groups.h>
#include <cstdio>
#include <cstdint>
namespace cg = cooperative_groups;

#ifndef MODE_COOP
#define MODE_COOP 1
#endif

#define DEVFN __device__ __forceinline__
typedef _Float16 half_t;
typedef _Float16 f16x8 __attribute__((ext_vector_type(8)));
typedef _Float16 f16x4 __attribute__((ext_vector_type(4)));
typedef _Float16 f16x2 __attribute__((ext_vector_type(2)));
typedef float f32x4 __attribute__((ext_vector_type(4)));

constexpr int D = 1024, NBATCH = 16, SEQ = 2048, NMETA = 16;
constexpr int MX = NBATCH * SEQ;
constexpr int MV = MX + NMETA;
constexpr int MP = 33024;
constexpr int NPROJ = 3840, NPROJ_VALID = 3656;
constexpr int DFF = 2816;
constexpr int COL_K = 1024, COL_V = 2048, COL_QI = 3072, COL_KI = 3584, COL_WI = 3648;
constexpr int MASK_W64 = 33;
constexpr float ALPHA = 1.41421356237309515f;
constexpr float LN_EPS = 1e-5f;
constexpr int NTHREADS = 512;
constexpr size_t VT_ELEMS = (size_t)NBATCH * 16 * 64 * SEQ;

constexpr size_t MiB = 1u << 20;
constexpr size_t OFF_W_IN = 0, OFF_W_O = 8 * MiB, OFF_W_GU0 = 10 * MiB, OFF_W_GU1 = 21 * MiB, OFF_W_D0 = 32 * MiB, OFF_W_D1 = 38 * MiB,
                 OFF_W_PW1 = 44 * MiB, OFF_W_PW2 = 48 * MiB, OFF_MASK = 50 * MiB, OFF_Y = 60 * MiB, OFF_ST0 = 126 * MiB, OFF_ST1 = 131 * MiB,
                 OFF_CP1 = 136 * MiB, OFF_CP2 = 138 * MiB, OFF_C1 = 140 * MiB, OFF_C2 = 140 * MiB + 65536, OFF_HA = 190 * MiB, OFF_BIG = 256 * MiB,
                 OFF_C = OFF_BIG + 65 * MiB, WS_END = OFF_BIG + 242 * MiB;
constexpr int NC_GU0 = 0, NC_GU1 = 2 * DFF, NC_PW1 = 4 * DFF, NC_TOTAL = 4 * DFF + 2 * D;
static_assert((size_t)MP * 16 * 8 <= 5 * MiB && (size_t)32 * NC_TOTAL * 4 <= 2 * MiB && (size_t)NC_TOTAL * 4 <= 65536, "stats");
static_assert((size_t)NPROJ * D * 2 <= 8 * MiB && (size_t)2 * DFF * D * 2 <= 11 * MiB && (size_t)DFF * D * 2 <= 6 * MiB, "weights");
static_assert((size_t)MP * MASK_W64 * 8 <= 10 * MiB && (size_t)MP * D * 2 <= 65 * MiB && (size_t)MP * NPROJ * 2 <= 242 * MiB, "acts");

struct Params {
    const float *x, *meta, *rel_bias, *w_in, *w_o, *w_pw1, *b_pw1, *w_dw, *b_dw, *cln_g, *cln_b, *w_pw2, *b_pw2, *ln1_g, *ln1_b, *wg, *wu, *wd, *ln2_g, *ln2_b;
    float* out; unsigned char* ws;
};

DEVFN int tid_opaque() { int t = threadIdx.x; asm volatile("" : "+v"(t)); return t; }
DEVFN float wave_sum(float v) {
#pragma unroll
    for (int o = 1; o < 64; o <<= 1) v += __shfl_xor(v, o);
    return v;
}
DEVFN float sigmoidf_(float x) { return 1.0f / (1.0f + __expf(-x)); }

DEVFN void prep_tile(const float* srcA, const float* srcB, int ld, int K, int Nsrc, int mode, half_t* dst, int tile, float* scr  , int qrows,
                     const float* lng, const float* lnb, float* cp1, float* cp2) {
    const int nkt = K / 32, tn = tile / nkt, tk = tile % nkt, n0 = tn * 32, k0 = tk * 32;
    const int tx = tid_opaque() & 31, ty = tid_opaque() >> 5;
    float* scr2 = scr + 32 * 33 + 32;
#pragma unroll
    for (int i = 0; i < 2; ++i) {
        const int k = k0 + ty + 16 * i, n = n0 + tx; float v = 0.f;
        if (mode == 0) { if (n < Nsrc) v = srcA[(size_t)k * ld + n]; if (n < qrows) v *= 0.18033688011112042f; }
        else { const float* s = ((n >> 7) & 1) ? srcB : srcA; v = s[(size_t)k * ld + ((n >> 8) * 128 + (n & 127))]; }
        if (lng) { scr2[(ty + 16 * i) * 33 + tx] = v * lnb[k]; v *= lng[k]; }
        scr[(ty + 16 * i) * 33 + tx] = v;
    }
    __syncthreads();
#pragma unroll
    for (int i = 0; i < 2; ++i) {
        const int n = n0 + ty + 16 * i, k = k0 + tx;
        dst[(size_t)n * K + k] = (half_t)scr[tx * 33 + ty + 16 * i];
    }
    if (lng && ty == 0) { float s1 = 0.f, s2 = 0.f;
#pragma unroll 8
        for (int k = 0; k < 32; ++k) { s1 += (float)(half_t)scr[k * 33 + tx]; s2 += scr2[k * 33 + tx]; }
        cp1[(size_t)tk * NC_TOTAL + n0 + tx] = s1; cp2[(size_t)tk * NC_TOTAL + n0 + tx] = s2; }
    __syncthreads();
}

DEVFN void phase_prep(const Params& P, char* lds, int bid, int nb) {
    float* scr = (float*)lds;
    unsigned char* ws = P.ws;
    float* cp1 = (float*)(ws + OFF_CP1); float* cp2 = (float*)(ws + OFF_CP2);
    constexpr int T_IN = (NPROJ / 32) * (D / 32), T_SQ = (D / 32) * (D / 32), T_GU = (2 * DFF / 32) * (D / 32), T_DN = (D / 32) * (DFF / 32), T_PW1 = (2 * D / 32) * (D / 32);
    constexpr int TOTAL = T_IN + T_SQ + 2 * T_GU + 2 * T_DN + T_PW1 + T_SQ;
    for (int it = bid; it < TOTAL; it += nb) {
        int r = it;
        if (r < T_IN) { prep_tile(P.w_in, nullptr, NPROJ_VALID, D, NPROJ_VALID, 0, (half_t*)(ws + OFF_W_IN), r, scr, D, nullptr, nullptr, nullptr, nullptr); continue; } r -= T_IN;
        if (r < T_SQ) { prep_tile(P.w_o, nullptr, D, D, D, 0, (half_t*)(ws + OFF_W_O), r, scr, 0, nullptr, nullptr, nullptr, nullptr); continue; } r -= T_SQ;
        if (r < T_GU) { prep_tile(P.wg, P.wu, DFF, D, DFF, 1, (half_t*)(ws + OFF_W_GU0), r, scr, 0, P.ln1_g, P.ln1_b, cp1 + NC_GU0, cp2 + NC_GU0); continue; } r -= T_GU;
        if (r < T_GU) { prep_tile(P.wg + (size_t)D * DFF, P.wu + (size_t)D * DFF, DFF, D, DFF, 1, (half_t*)(ws + OFF_W_GU1), r, scr, 0, P.ln1_g + D, P.ln1_b + D, cp1 + NC_GU1, cp2 + NC_GU1); continue; } r -= T_GU;
        if (r < T_DN) { prep_tile(P.wd, nullptr, D, DFF, D, 0, (half_t*)(ws + OFF_W_D0), r, scr, 0, nullptr, nullptr, nullptr, nullptr); continue; } r -= T_DN;
        if (r < T_DN) { prep_tile(P.wd + (size_t)DFF * D, nullptr, D, DFF, D, 0, (half_t*)(ws + OFF_W_D1), r, scr, 0, nullptr, nullptr, nullptr, nullptr); continue; } r -= T_DN;
        if (r < T_PW1) { prep_tile(P.w_pw1, P.w_pw1 + D, 2 * D, D, D, 1, (half_t*)(ws + OFF_W_PW1), r, scr, 0, P.ln2_g, P.ln2_b, cp1 + NC_PW1, cp2 + NC_PW1); continue; } r -= T_PW1;
        prep_tile(P.w_pw2, nullptr, D, D, D, 0, (half_t*)(ws + OFF_W_PW2), r, scr, 0, nullptr, nullptr, nullptr, nullptr);
    }
    half_t* HA = (half_t*)(ws + OFF_HA);
    const int lane = tid_opaque() & 63, gw = bid * (NTHREADS / 64) + (tid_opaque() >> 6), ngw = nb * (NTHREADS / 64);
    for (int r = gw; r < MP; r += ngw) {
        const float* src = r < MX ? P.x + (size_t)r * D : (r < MV ? P.meta + (size_t)(r - MX) * D : nullptr);
#pragma unroll
        for (int j = 0; j < 4; ++j) {
            const int c = lane * 4 + 256 * j;
            f32x4 v = src ? *(const f32x4*)(src + c) : (f32x4){0.f, 0.f, 0.f, 0.f};
            f16x4 h; h[0] = (half_t)v[0]; h[1] = (half_t)v[1]; h[2] = (half_t)v[2]; h[3] = (half_t)v[3];
            *(f16x4*)(HA + (size_t)r * D + c) = h;
        }
    }
}
DEVFN void finish_colconsts(const Params& P, int bid, int nb) {
    const float* cp1 = (const float*)(P.ws + OFF_CP1); const float* cp2 = (const float*)(P.ws + OFF_CP2);
    float* c1 = (float*)(P.ws + OFF_C1); float* c2 = (float*)(P.ws + OFF_C2);
    for (int idx = bid * NTHREADS + tid_opaque(); idx < NC_TOTAL; idx += nb * NTHREADS) {
        float s1 = 0.f, s2 = 0.f;
        for (int tk = 0; tk < 32; ++tk) { s1 += cp1[(size_t)tk * NC_TOTAL + idx]; s2 += cp2[(size_t)tk * NC_TOTAL + idx]; }
        if (idx >= NC_PW1) { const int n = idx - NC_PW1; s2 += P.b_pw1[((n >> 7) & 1) * D + (n >> 8) * 128 + (n & 127)]; }
        c1[idx] = s1; c2[idx] = s2;
    }
}

namespace pg8 {
#define PG8_LAS __attribute__((address_space(3)))
constexpr int BM = 256, BK = 64, HALF = 128, HTB = HALF * BK * 2  , STAGE_BYTES = 8 * HTB, NXCD = 8, WGM = 8;
__host__ __device__ __forceinline__ int lds_byte(int r, int c) { const int st = (r >> 4) * 2 + (c >> 5), rr = r & 15, cc = c & 31, ob = rr * 64 + cc * 2; return st * 1024 + (ob ^ (((ob >> 9) & 1) << 5)); }
__host__ __device__ __forceinline__ void stage_rc(int b, int& R, int& C) { const int st = b / 1024, sb = b % 1024, swz = sb ^ (((sb >> 9) & 1) << 5); R = (st >> 1) * 16 + swz / 64; C = (st & 1) * 32 + (swz % 64) / 2; }
__host__ __device__ __forceinline__ int perm32(int rho) { const int n = rho >> 4, i = rho & 15; return 8 * (i >> 2) + 4 * n + (i & 3); }
struct Unit { int pm, pn; };
struct Gemm { const half_t* A; const half_t* Bt; int M, N, K; };
struct StaticOrder {
    int nM, nN, nwg, G, c;
    __host__ __device__ void init(int M, int N, int G_, int c_) { nM = M / BM; nN = N / BM; nwg = nM * nN; G = G_; c = c_; }
    __host__ __device__ bool next(int i, Unit& u) const {
        const long L = (long)i * G + c; if (L >= nwg) return false;
        int wgid = (int)L; { const int q = nwg / NXCD, r = nwg % NXCD, xcd = wgid % NXCD, off = wgid / NXCD; wgid = (xcd < r ? xcd * (q + 1) : r * (q + 1) + (xcd - r) * q) + off; }
        const int nig = WGM * nN, gid = wgid / nig, fm = gid * WGM, gsz = (nM - fm) < WGM ? (nM - fm) : WGM;
        u.pm = fm + ((wgid % nig) % gsz); u.pn = (wgid % nig) / gsz; return true;
    }
};
template <class Epi, bool ALIGN_EPI = true>
__device__ __forceinline__ void gemm_phase(PG8_LAS unsigned char* lds, const Gemm g, const StaticOrder& S, const Epi& E) {
    int tid = threadIdx.x; asm volatile("" : "+v"(tid));
    const int wid = __builtin_amdgcn_readfirstlane(tid >> 6), lane = tid & 63, wr = wid >> 2, wc = wid & 3, fr = lane & 15, fq = lane >> 4;
    const int K = g.K, nt = K / BK;
    unsigned voffA[2], voffB[2];
#pragma unroll
    for (int i = 0; i < 2; ++i) { int R, C; stage_rc(tid * 16 + i * 8192, R, C); const int Rb = (R & ~31) + perm32(R & 31);
        voffA[i] = (unsigned)(R * K + C) * 2u; voffB[i] = (unsigned)(Rb * K + C) * 2u; }
    const size_t kstep = (size_t)(BK * 2);
    const size_t hstep = (size_t)HALF * K * 2;
    const size_t tstep = 2 * hstep;
    const unsigned ldsw = (unsigned)wid * 1024u;
    const int aoff = lds_byte(wr * 64 + fr, fq * 8), boff = lds_byte(wc * 32 + fr, fq * 8);
#define PG8_SA(b, h) (((b) * 2 + (h)) * HTB)
#define PG8_SB(b, h) ((4 + (b) * 2 + (h)) * HTB)
#define PG8_STAGE(bufoff, gbase, voff) do { _Pragma("unroll") for (int _i = 0; _i < 2; ++_i) \
        __builtin_amdgcn_global_load_lds((const unsigned*)((const char*)(gbase) + (voff)[_i]), (PG8_LAS unsigned*)(lds + (bufoff) + ldsw + _i * 8192), 16, 0, 0); } while (0)
#define PG8_LDA(dst, b, h) do { _Pragma("unroll") for (int m = 0; m < 4; ++m) _Pragma("unroll") for (int k = 0; k < 2; ++k) dst[m][k] = *(const PG8_LAS f16x8*)(lds + PG8_SA(b, h) + aoff + m * 2048 + k * 1024); } while (0)
#define PG8_LDB(dst, b, h) do { _Pragma("unroll") for (int n = 0; n < 2; ++n) _Pragma("unroll") for (int k = 0; k < 2; ++k) dst[n][k] = *(const PG8_LAS f16x8*)(lds + PG8_SB(b, h) + boff + n * 2048 + k * 1024); } while (0)
#define PG8_MMA(ai, bj, At, Bt) do { __builtin_amdgcn_s_setprio(1); _Pragma("unroll") for (int m = 0; m < 4; ++m) _Pragma("unroll") for (int n = 0; n < 2; ++n) _Pragma("unroll") for (int k = 0; k < 2; ++k) \
        acc[ai][bj][m][n] = __builtin_amdgcn_mfma_f32_16x16x32_f16(Bt[n][k], At[m][k], acc[ai][bj][m][n], 0, 0, 0); __builtin_amdgcn_s_setprio(0); } while (0)
#define PG8_WAIT_V(n) asm volatile("s_waitcnt vmcnt(" #n ")" ::: "memory")
#define PG8_WAIT_L(n) asm volatile("s_waitcnt lgkmcnt(" #n ")" ::: "memory")
#define PG8_BAR __builtin_amdgcn_s_barrier()
#define PG8_SCHED __builtin_amdgcn_sched_barrier(0)
    Unit cur, nxt; int ui = 0;
    if (!S.next(0, cur)) return;
    f32x4 acc[2][2][4][2];
#pragma unroll
    for (int a = 0; a < 2; ++a)
#pragma unroll
        for (int b = 0; b < 2; ++b)
#pragma unroll
            for (int m = 0; m < 4; ++m)
#pragma unroll
                for (int n = 0; n < 2; ++n) acc[a][b][m][n] = (f32x4){0.f, 0.f, 0.f, 0.f};
    f16x8 At[4][2], B0[2][2], B1[2][2];
    const char* cA = (const char*)g.A + (size_t)cur.pm * tstep; const char* cB = (const char*)g.Bt + (size_t)cur.pn * tstep;
    E.prepare(cur, 0);
    PG8_STAGE(PG8_SB(0, 0), cB, voffB); PG8_STAGE(PG8_SB(0, 1), cB + hstep, voffB); PG8_STAGE(PG8_SA(0, 0), cA, voffA); PG8_STAGE(PG8_SA(0, 1), cA + hstep, voffA);
    if (wr == 1) PG8_BAR;
    PG8_WAIT_V(2); PG8_BAR;
    PG8_STAGE(PG8_SB(1, 0), cB + kstep, voffB); PG8_STAGE(PG8_SA(1, 0), cA + kstep, voffA); PG8_STAGE(PG8_SB(1, 1), cB + hstep + kstep, voffB);
    PG8_WAIT_V(6); PG8_BAR;
    for (;;) {
        const bool has_next = S.next(ui + 1, nxt);
        const char* nA = has_next ? (const char*)g.A + (size_t)nxt.pm * tstep : cA; const char* nB = has_next ? (const char*)g.Bt + (size_t)nxt.pn * tstep : cB;
        for (int t = 0; t < nt; t += 2) {
            const bool last = (t == nt - 2);
            const char* a1 = cA + (size_t)(t + 1) * kstep;
            const char* a2 = last ? nA : cA + (size_t)(t + 2) * kstep; const char* b2 = last ? nB : cB + (size_t)(t + 2) * kstep;
            const char* a3 = a2 + kstep; const char* b3 = b2 + kstep;
            if (last && has_next) E.prepare(nxt, (ui + 1) & 1);
            PG8_LDB(B0, 0, 0); PG8_LDB(B1, 0, 1); PG8_SCHED; PG8_LDA(At, 0, 0); PG8_STAGE(PG8_SA(1, 1), a1 + hstep, voffA);
            PG8_WAIT_V(8); PG8_WAIT_L(0); PG8_BAR; PG8_MMA(0, 0, At, B0); PG8_MMA(0, 1, At, B1); PG8_BAR; PG8_SCHED;
            PG8_LDA(At, 0, 1); PG8_STAGE(PG8_SB(0, 0), b2, voffB); PG8_STAGE(PG8_SB(0, 1), b2 + hstep, voffB); PG8_STAGE(PG8_SA(0, 0), a2, voffA);
            PG8_WAIT_V(8); PG8_WAIT_L(0); PG8_BAR; PG8_MMA(1, 0, At, B0); PG8_MMA(1, 1, At, B1); PG8_BAR; PG8_SCHED;
            PG8_LDB(B0, 1, 0); PG8_LDB(B1, 1, 1); PG8_SCHED; PG8_LDA(At, 1, 0); PG8_STAGE(PG8_SA(0, 1), a2 + hstep, voffA);
            PG8_WAIT_V(8); PG8_WAIT_L(0); PG8_BAR; PG8_MMA(0, 0, At, B0); PG8_MMA(0, 1, At, B1); PG8_BAR; PG8_SCHED;
            PG8_LDA(At, 1, 1); PG8_STAGE(PG8_SB(1, 0), b3, voffB); PG8_STAGE(PG8_SB(1, 1), b3 + hstep, voffB); PG8_STAGE(PG8_SA(1, 0), a3, voffA);
            PG8_WAIT_V(8); PG8_WAIT_L(0); PG8_BAR; PG8_MMA(1, 0, At, B0); PG8_MMA(1, 1, At, B1); PG8_BAR; PG8_SCHED;
        }
        if constexpr (ALIGN_EPI) { if (wr == 0) PG8_BAR; }
        E(acc, cur, ui & 1, wr, wc, fr, fq);
        if (!has_next) break;
#pragma unroll
        for (int a = 0; a < 2; ++a)
#pragma unroll
            for (int b = 0; b < 2; ++b)
#pragma unroll
                for (int m = 0; m < 4; ++m)
#pragma unroll
                    for (int n = 0; n < 2; ++n) acc[a][b][m][n] = (f32x4){0.f, 0.f, 0.f, 0.f};
        cur = nxt; cA = nA; cB = nB; ++ui;
        if constexpr (ALIGN_EPI) { if (wr == 1) PG8_BAR; }
    }
    PG8_WAIT_V(0);
    if constexpr (!ALIGN_EPI) { if (wr == 0) PG8_BAR; }
    PG8_BAR;
#undef PG8_SA
#undef PG8_SB
#undef PG8_STAGE
#undef PG8_LDA
#undef PG8_LDB
#undef PG8_MMA
#undef PG8_WAIT_V
#undef PG8_WAIT_L
#undef PG8_BAR
#undef PG8_SCHED
}
}

typedef f32x4 acc_t[2][2][4][2];
DEVFN f16x8 pack8(f32x4 a, f32x4 b) { f16x8 h; h[0] = (half_t)a[0]; h[1] = (half_t)a[1]; h[2] = (half_t)a[2]; h[3] = (half_t)a[3]; h[4] = (half_t)b[0]; h[5] = (half_t)b[1]; h[6] = (half_t)b[2]; h[7] = (half_t)b[3]; return h; }
DEVFN f32x4 silu4(f32x4 g) { f32x4 o; o[0] = g[0] * sigmoidf_(g[0]); o[1] = g[1] * sigmoidf_(g[1]); o[2] = g[2] * sigmoidf_(g[2]); o[3] = g[3] * sigmoidf_(g[3]); return o; }
DEVFN f32x4 sigm4(f32x4 g) { f32x4 o; o[0] = sigmoidf_(g[0]); o[1] = sigmoidf_(g[1]); o[2] = sigmoidf_(g[2]); o[3] = sigmoidf_(g[3]); return o; }
struct EpiStoreF16 { half_t* O; int ld;
    DEVFN void prepare(const pg8::Unit&, int) const {}
    DEVFN void operator()(const acc_t& acc, const pg8::Unit& u, int, int wr, int wc, int fr, int fq) const {
        const int row0 = u.pm * 256 + wr * 64 + fr, col0 = u.pn * 256 + wc * 32 + 8 * fq;
#pragma unroll
        for (int ai = 0; ai < 2; ++ai)
#pragma unroll
            for (int m = 0; m < 4; ++m) { half_t* rowp = O + (size_t)(row0 + ai * 128 + m * 16) * ld + col0;
#pragma unroll
                for (int bj = 0; bj < 2; ++bj) *(f16x8*)(rowp + bj * 128) = pack8(acc[ai][bj][m][0], acc[ai][bj][m][1]); }
    } };
struct EpiProj { half_t* O; int ld; half_t* VT; half_t* VTM;
    DEVFN void prepare(const pg8::Unit&, int) const {}
    DEVFN void operator()(const acc_t& acc, const pg8::Unit& u, int, int wr, int wc, int fr, int fq) const {
        const int row0 = u.pm * 256 + wr * 64 + fr, col0 = u.pn * 256 + wc * 32 + 8 * fq;
#pragma unroll
        for (int ai = 0; ai < 2; ++ai)
#pragma unroll
            for (int m = 0; m < 4; ++m) { half_t* rowp = O + (size_t)(row0 + ai * 128 + m * 16) * ld + col0;
#pragma unroll
                for (int bj = 0; bj < 2; ++bj) *(f16x8*)(rowp + bj * 128) = pack8(acc[ai][bj][m][0], acc[ai][bj][m][1]); }
        if (u.pn >= 8 && u.pn < 12) {
            const int sw = (fr & 3) | ((fr & 4) << 1) | ((fr & 8) >> 1);
#pragma unroll
            for (int ai = 0; ai < 2; ++ai)
#pragma unroll
                for (int m = 0; m < 4; ++m) { const int row = row0 + ai * 128 + m * 16;
                    half_t* base; size_t dstride;
                    if (row < MX) { base = VT + (size_t)(row >> 11) * 1024 * SEQ + (((row & 2047) & ~15) | sw); dstride = SEQ; }
                    else { base = VTM + (((row - MX) & ~15) | sw); dstride = 256; }
#pragma unroll
                    for (int bj = 0; bj < 2; ++bj)
#pragma unroll
                        for (int n = 0; n < 2; ++n)
#pragma unroll
                            for (int e = 0; e < 4; ++e) base[(size_t)(col0 - COL_V + bj * 128 + 4 * n + e) * dstride] = (half_t)acc[ai][bj][m][n][e]; }
        }
    } };
constexpr int TAB_OFF = 131072;
DEVFN void rowstat_fill(const float* st, int pm, char* lds, int parity) {
    const int t = tid_opaque();
    if (t < 256) { const f32x4* p = (const f32x4*)(st + (size_t)(pm * 256 + t) * 32); float s = 0.f, q = 0.f;
#pragma unroll
        for (int i = 0; i < 8; ++i) { const f32x4 v = p[i]; s += v[0] + v[2]; q += v[1] + v[3]; }
        const float mean = s * (1.f / D), var = fmaxf(q * (1.f / D) - mean * mean, 0.f);
        float* tab = (float*)(lds + TAB_OFF) + parity * 512;
        tab[2 * t] = mean; tab[2 * t + 1] = 1.0f / sqrtf(var + LN_EPS); }
}
DEVFN void stat_acc(const f16x8 h, float& s, float& q) {
#pragma unroll
    for (int i = 0; i < 8; ++i) { const float v = (float)h[i]; s += v; q = fmaf(v, v, q); }
}
DEVFN void stat_store(float* st, int row, int slot, float s, float q, int fq) {
    s += __shfl_xor(s, 16); s += __shfl_xor(s, 32); q += __shfl_xor(q, 16); q += __shfl_xor(q, 32);
    if (fq == 0) { float* p = st + (size_t)row * 32 + slot * 2; p[0] = s; p[1] = q; }
}
struct EpiLnSwiGLU { half_t* O; int ld; const float* st; const float* c1; const float* c2; char* lds;
    DEVFN void prepare(const pg8::Unit& u, int parity) const { rowstat_fill(st, u.pm, lds, parity); }
    DEVFN void operator()(const acc_t& acc, const pg8::Unit& u, int parity, int wr, int wc, int fr, int fq) const {
        const int rl0 = wr * 64 + fr, col0 = u.pn * 128 + wc * 32 + 8 * fq, n0 = u.pn * 256 + wc * 32 + 8 * fq;
        const float* tab = (const float*)(lds + TAB_OFF) + parity * 512;
        f32x4 k1[2][2], k2[2][2];
#pragma unroll
        for (int bj = 0; bj < 2; ++bj)
#pragma unroll
            for (int n = 0; n < 2; ++n) { k1[bj][n] = *(const f32x4*)(c1 + n0 + bj * 128 + 4 * n); k2[bj][n] = *(const f32x4*)(c2 + n0 + bj * 128 + 4 * n); }
#pragma unroll
        for (int ai = 0; ai < 2; ++ai)
#pragma unroll
            for (int m = 0; m < 4; ++m) { const int rl = rl0 + ai * 128 + m * 16; const float mean = tab[2 * rl], rstd = tab[2 * rl + 1];
                f32x4 g[2], up[2];
#pragma unroll
                for (int n = 0; n < 2; ++n) { g[n] = (acc[ai][0][m][n] - k1[0][n] * mean) * rstd + k2[0][n]; up[n] = (acc[ai][1][m][n] - k1[1][n] * mean) * rstd + k2[1][n]; }
                *(f16x8*)(O + (size_t)(u.pm * 256 + rl) * ld + col0) = pack8(silu4(g[0]) * up[0], silu4(g[1]) * up[1]); }
    } };
struct EpiLnGLU { half_t* O; int ld; const float* st; const float* c1; const float* c2; char* lds;
    DEVFN void prepare(const pg8::Unit& u, int parity) const { rowstat_fill(st, u.pm, lds, parity); }
    DEVFN void operator()(const acc_t& acc, const pg8::Unit& u, int parity, int wr, int wc, int fr, int fq) const {
        const int rl0 = wr * 64 + fr, col0 = u.pn * 128 + wc * 32 + 8 * fq, n0 = u.pn * 256 + wc * 32 + 8 * fq;
        const float* tab = (const float*)(lds + TAB_OFF) + parity * 512;
        f32x4 k1[2][2], k2[2][2];
#pragma unroll
        for (int bj = 0; bj < 2; ++bj)
#pragma unroll
            for (int n = 0; n < 2; ++n) { k1[bj][n] = *(const f32x4*)(c1 + n0 + bj * 128 + 4 * n); k2[bj][n] = *(const f32x4*)(c2 + n0 + bj * 128 + 4 * n); }
#pragma unroll
        for (int ai = 0; ai < 2; ++ai)
#pragma unroll
            for (int m = 0; m < 4; ++m) { const int rl = rl0 + ai * 128 + m * 16; const float mean = tab[2 * rl], rstd = tab[2 * rl + 1];
                f32x4 a[2], sg[2];
#pragma unroll
                for (int n = 0; n < 2; ++n) { a[n] = (acc[ai][0][m][n] - k1[0][n] * mean) * rstd + k2[0][n]; sg[n] = (acc[ai][1][m][n] - k1[1][n] * mean) * rstd + k2[1][n]; }
                *(f16x8*)(O + (size_t)(u.pm * 256 + rl) * ld + col0) = pack8(a[0] * sigm4(sg[0]), a[1] * sigm4(sg[1])); }
    } };
struct EpiResidX { const float* x; const float* meta; half_t* Y; float* sto;
    DEVFN void prepare(const pg8::Unit&, int) const {}
    DEVFN void operator()(const acc_t& acc, const pg8::Unit& u, int, int wr, int wc, int fr, int fq) const {
        const int row0 = u.pm * 256 + wr * 64 + fr, col0 = u.pn * 256 + wc * 32 + 8 * fq;
#pragma unroll
        for (int ai = 0; ai < 2; ++ai)
#pragma unroll
            for (int m = 0; m < 4; ++m) { const int row = row0 + ai * 128 + m * 16;
                const float* src = row < MX ? x + (size_t)row * D : (row < MV ? meta + (size_t)(row - MX) * D : nullptr);
                float s = 0.f, q = 0.f;
#pragma unroll
                for (int bj = 0; bj < 2; ++bj) { const int col = col0 + bj * 128;
                    const f32x4 r0 = src ? *(const f32x4*)(src + col) : (f32x4){0.f, 0.f, 0.f, 0.f}, r1 = src ? *(const f32x4*)(src + col + 4) : (f32x4){0.f, 0.f, 0.f, 0.f};
                    const f16x8 h = pack8(r0 * ALPHA + acc[ai][bj][m][0], r1 * ALPHA + acc[ai][bj][m][1]);
                    *(f16x8*)(Y + (size_t)row * D + col) = h; stat_acc(h, s, q); }
                stat_store(sto, row, u.pn * 4 + wc, s, q, fq); }
    } };
struct EpiResidLN { half_t* Y; const float* sti; float* sto; const float* g; const float* b; const float* bias; char* lds;
    DEVFN void prepare(const pg8::Unit& u, int parity) const { rowstat_fill(sti, u.pm, lds, parity); }
    DEVFN void operator()(const acc_t& acc, const pg8::Unit& u, int parity, int wr, int wc, int fr, int fq) const {
        const int rl0 = wr * 64 + fr, col0 = u.pn * 256 + wc * 32 + 8 * fq;
        const float* tab = (const float*)(lds + TAB_OFF) + parity * 512;
        f32x4 gg[2][2], bb[2][2];
#pragma unroll
        for (int bj = 0; bj < 2; ++bj)
#pragma unroll
            for (int n = 0; n < 2; ++n) { const int c = col0 + bj * 128 + 4 * n; gg[bj][n] = *(const f32x4*)(g + c) * ALPHA;
                bb[bj][n] = *(const f32x4*)(b + c) * ALPHA; if (bias) bb[bj][n] += *(const f32x4*)(bias + c); }
#pragma unroll
        for (int ai = 0; ai < 2; ++ai)
#pragma unroll
            for (int m = 0; m < 4; ++m) { const int rl = rl0 + ai * 128 + m * 16, row = u.pm * 256 + rl; const float mean = tab[2 * rl], rstd = tab[2 * rl + 1];
                float s = 0.f, q = 0.f;
#pragma unroll
                for (int bj = 0; bj < 2; ++bj) { half_t* yp = Y + (size_t)row * D + col0 + bj * 128; const f16x8 yv = *(const f16x8*)yp;
                    f32x4 y0, y1;
#pragma unroll
                    for (int e = 0; e < 4; ++e) { y0[e] = ((float)yv[e] - mean) * rstd; y1[e] = ((float)yv[4 + e] - mean) * rstd; }
                    const f16x8 h = pack8(y0 * gg[bj][0] + bb[bj][0] + acc[ai][bj][m][0], y1 * gg[bj][1] + bb[bj][1] + acc[ai][bj][m][1]);
                    *(f16x8*)yp = h; stat_acc(h, s, q); }
                stat_store(sto, row, u.pn * 4 + wc, s, q, fq); }
    } };
template <class Epi>
DEVFN void gemm_phase(const half_t* A, const half_t* Bt, int M, int N, int K, const Epi& epi, char* lds, int bid, int nb) {
    pg8::Gemm g{A, Bt, M, N, K}; pg8::StaticOrder S; S.init(M, N, nb, bid);
    pg8::gemm_phase<Epi, true>((PG8_LAS unsigned char*)lds, g, S, epi);
}

DEVFN void phase_final_ln(const Params& P, const float* st, const float* g, const float* b, int bid, int nb) {
    const half_t* Y = (const half_t*)(P.ws + OFF_Y);
    const int lane = tid_opaque() & 63, gw = bid * (NTHREADS / 64) + (tid_opaque() >> 6), ngw = nb * (NTHREADS / 64);
    for (int r = gw; r < MX; r += ngw) {
        float s = st[(size_t)r * 32 + (lane & 15) * 2], q = st[(size_t)r * 32 + (lane & 15) * 2 + 1];
#pragma unroll
        for (int o = 1; o < 16; o <<= 1) { s += __shfl_xor(s, o); q += __shfl_xor(q, o); }
        const float mean = s * (1.f / D), rstd = 1.0f / sqrtf(fmaxf(q * (1.f / D) - mean * mean, 0.f) + LN_EPS);
#pragma unroll
        for (int j = 0; j < 2; ++j) { const int c = lane * 8 + 512 * j; const f16x8 yv = *(const f16x8*)(Y + (size_t)r * D + c);
            f32x4 o0, o1;
#pragma unroll
            for (int e = 0; e < 4; ++e) { o0[e] = ((float)yv[e] - mean) * rstd; o1[e] = ((float)yv[4 + e] - mean) * rstd; }
            *(f32x4*)(P.out + (size_t)r * D + c) = o0 * *(const f32x4*)(g + c) + *(const f32x4*)(b + c);
            *(f32x4*)(P.out + (size_t)r * D + c + 4) = o1 * *(const f32x4*)(g + c + 4) + *(const f32x4*)(b + c + 4); }
    }
}

DEVFN int key_row(int b, int p) { return p < NMETA ? MX + p : b * SEQ + p - NMETA; }
constexpr int IDX_ROW = 2116;
DEVFN int half_sum_i(int v) {
#pragma unroll
    for (int o = 1; o < 32; o <<= 1) v += __shfl_xor(v, o);
    return v;
}
DEVFN void phase_indexer(const Params& P, char* lds, int bid, int nb) {
    float* sc = (float*)lds;
    const half_t* proj = (const half_t*)(P.ws + OFF_BIG);
    unsigned long long* maskt = (unsigned long long*)(P.ws + OFF_MASK);
    const int wid = __builtin_amdgcn_readfirstlane(tid_opaque() >> 6);
    for (int L = bid; L < NBATCH * (SEQ / 16); L += nb) {
        const int tid = tid_opaque(), lane = tid & 63, fr = lane & 15, quad = lane >> 4;
        const int i = (SEQ / 16 - 1) - (L >> 4), b = L & 15, s0 = 16 * i;
        if (s0 + 32 <= 256) {
            const int q = tid >> 5, s = s0 + q;
            for (int k = tid & 31; k < 33; k += 32) {
                unsigned long long bits;
                if (k == 0) bits = 0xFFFFull;
                else { const int base = 64 * (k - 1); bits = (s >= base + 63) ? ~0ull : (s < base ? 0ull : ((2ull << (s - base)) - 1ull)); }
                maskt[((size_t)b * 33 + k) * SEQ + s] = bits;
            }
            continue;
        }
        {
            const half_t* qrow = proj + (size_t)(b * SEQ + s0 + fr) * NPROJ;
            f16x8 bq[8][2];
#pragma unroll
            for (int h = 0; h < 8; ++h)
#pragma unroll
                for (int kh = 0; kh < 2; ++kh) bq[h][kh] = *(const f16x8*)(qrow + COL_QI + h * 64 + kh * 32 + quad * 8);
            float w[8]; { const f16x8 wv = *(const f16x8*)(qrow + COL_WI);
#pragma unroll
                for (int h = 0; h < 8; ++h) w[h] = (float)wv[h] * 0.04419417382415922f; }
            const int nblk = i + 2;
            int j = wid;
            const half_t* kp = proj + (size_t)(j == 0 ? MX + fr : b * SEQ + 16 * (j - 1) + fr) * NPROJ + COL_KI + quad * 8;
            f16x8 a0 = *(const f16x8*)kp, a1 = *(const f16x8*)(kp + 32);
            for (; j < nblk; j += 8) {
                const int jn = (j + 8 < nblk) ? j + 8 : j;
                const half_t* kn = proj + (size_t)(jn == 0 ? MX + fr : b * SEQ + 16 * (jn - 1) + fr) * NPROJ + COL_KI + quad * 8;
                const f16x8 n0 = *(const f16x8*)kn, n1 = *(const f16x8*)(kn + 32);
                f32x4 s4 = (f32x4){0.f, 0.f, 0.f, 0.f};
#pragma unroll
                for (int h = 0; h < 8; ++h) {
                    f32x4 acc = __builtin_amdgcn_mfma_f32_16x16x32_f16(a0, bq[h][0], (f32x4){0.f, 0.f, 0.f, 0.f}, 0, 0, 0);
                    acc = __builtin_amdgcn_mfma_f32_16x16x32_f16(a1, bq[h][1], acc, 0, 0, 0);
#pragma unroll
                    for (int e = 0; e < 4; ++e) s4[e] = fmaf(w[h], fmaxf(acc[e], 0.f), s4[e]);
                }
                s4 = s4 + 0.0f;
                const int slot = (j == 0 ? 0 : 64 + 16 * (j - 1)) + 4 * quad;
                *(f32x4*)(sc + fr * IDX_ROW + slot) = s4;
                a0 = n0; a1 = n1;
            }
        }
        __syncthreads();
#pragma unroll 1
        for (int qi2 = 0; qi2 < 2; ++qi2) {
            const int ln = tid_opaque() & 63, qq = 2 * wid + qi2, sq = s0 + qq;
            typedef __attribute__((address_space(3))) unsigned lds_u32;
            typedef unsigned u32x4 __attribute__((ext_vector_type(4)));
            lds_u32* hist = (lds_u32*)(__attribute__((address_space(3))) char*)lds + qq * IDX_ROW;
            const float* row = sc + qq * IDX_ROW;
            float v[33]; float vmin = INFINITY, vmax = -INFINITY;
#pragma unroll
            for (int j = 0; j < 33; ++j) { const int slot = 64 * j + ln; const bool valid = (slot < 16) | ((slot >= 64) & (slot - 64 <= sq));
                const float ld_ = row[slot];
                const float x = valid ? ld_ : -INFINITY; v[j] = x; vmax = fmaxf(vmax, x); vmin = fminf(vmin, valid ? x : INFINITY); }
#pragma unroll
            for (int o = 1; o < 64; o <<= 1) { vmin = fminf(vmin, __shfl_xor(vmin, o)); vmax = fmaxf(vmax, __shfl_xor(vmax, o)); }
#pragma unroll
            for (int k = 0; k < 8; ++k) *(__attribute__((address_space(3))) u32x4*)(hist + 256 * k + 4 * ln) = (u32x4){0u, 0u, 0u, 0u};
            const float range = vmax - vmin, scale = range > 0.f ? 2047.0f / range : 0.f;
            unsigned bins[17];
#pragma unroll
            for (int j = 0; j < 33; ++j) { const unsigned key = v[j] > -INFINITY ? 1u : 0u;
                int t_ = (int)(((key ? v[j] : vmin) - vmin) * scale); t_ = t_ > 2047 ? 2047 : t_;
                __hip_atomic_fetch_add(hist + (key ? t_ : 2048 + ln), 1u, __ATOMIC_RELAXED, __HIP_MEMORY_SCOPE_WORKGROUP);
                const unsigned bn1 = key ? (unsigned)t_ + 1u : 0u;
                if (j & 1) bins[j >> 1] |= bn1 << 16; else bins[j >> 1] = bn1;
                const unsigned u_ = __float_as_uint(v[j]); v[j] = __uint_as_float(u_ ^ (((unsigned)((int)u_ >> 31)) | 0x80000000u)); }
            unsigned tot = 0u;
#pragma unroll
            for (int k = 0; k < 8; ++k) { const u32x4 hq = *(const __attribute__((address_space(3))) u32x4*)(hist + 2016 - 32 * ln + 4 * k); tot += (hq[0] + hq[1]) + (hq[2] + hq[3]); }
            unsigned incl = tot;
#pragma unroll
            for (int o = 1; o < 64; o <<= 1) { const unsigned t_ = __shfl_up(incl, o); incl += ln >= o ? t_ : 0u; }
            const unsigned excl = incl - tot;
            int src = __ffsll((long long)__ballot((excl < 256u) & (256u <= incl))) - 1;
            const unsigned exclO = __shfl(excl, src);
            const int top = 2047 - 32 * src;
            const unsigned cb_ = hist[top - (ln & 31)], c1_ = ln < 32 ? cb_ : 0u;
            unsigned incl2 = c1_;
#pragma unroll
            for (int o = 1; o < 64; o <<= 1) { const unsigned t_ = __shfl_up(incl2, o); incl2 += ln >= o ? t_ : 0u; }
            const unsigned excl2 = incl2 - c1_ + exclO;
            src = __ffsll((long long)__ballot((excl2 < 256u) & (256u <= excl2 + c1_))) - 1;
            const int Bsel = top - src; const unsigned above = __shfl(excl2, src), cB = __shfl(c1_, src);
            const unsigned ub1 = (unsigned)Bsel + 1u;
            int rleft = (int)(256u - above);
            const unsigned allB = rleft >= (int)cB ? 1u : 0u;
            rleft = allB ? 0 : rleft;
            unsigned selm0 = 0u, selm1 = 0u;
            while (rleft > 0) {
                unsigned bk = 0u, bp = 0u;
#pragma unroll
                for (int j = 0; j < 33; ++j) { const unsigned bn1 = (j & 1) ? (bins[j >> 1] >> 16) : (bins[j >> 1] & 0xFFFFu);
                    const unsigned sm = j < 32 ? selm0 : selm1;
                    const unsigned k2 = (bn1 << 1) | ((sm >> (j & 31)) & 1u);
                    const unsigned kk = k2 == (ub1 << 1) ? __float_as_uint(v[j]) : 0u;
                    bp = kk > bk ? (unsigned)j : bp; bk = kk > bk ? kk : bk; }
                bp = (bp << 6) + (unsigned)ln;
                unsigned long long best = ((unsigned long long)bk << 32) | (0xFFFFFFFFu - bp);
#pragma unroll
                for (int o = 1; o < 64; o <<= 1) { const unsigned long long ot = __shfl_xor(best, o); best = ot > best ? ot : best; }
                const unsigned wp = 0xFFFFFFFFu - (unsigned)best, wj = wp >> 6;
                const unsigned bit = (((wp & 63u) == (unsigned)ln) & ((unsigned)(best >> 32) != 0u)) ? (1u << (wj & 31u)) : 0u;
                selm0 |= wj < 32u ? bit : 0u; selm1 |= wj >= 32u ? bit : 0u;
                rleft -= 1;
            }
            unsigned long long myw = 0ull;
            const unsigned thr2 = (ub1 << 1) | 1u;
#pragma unroll
            for (int j = 0; j < 33; ++j) { const unsigned bn1 = (j & 1) ? (bins[j >> 1] >> 16) : (bins[j >> 1] & 0xFFFFu);
                const unsigned sm = j < 32 ? selm0 : selm1;
                const unsigned k2 = (bn1 << 1) | allB | ((sm >> (j & 31)) & 1u);
                const unsigned long long sb = __ballot(k2 >= thr2);
                myw = ln == j ? sb : myw; }
            if (ln < 33) maskt[((size_t)b * 33 + ln) * SEQ + sq] = myw;
        }
        __syncthreads();
    }
}

DEVFN int t5_bucket(int d) {
    if (d < 16) return d;
    const int bd[15] = {19, 21, 24, 27, 31, 35, 40, 46, 52, 59, 67, 77, 87, 99, 113};
    int b = 16;
#pragma unroll
    for (int i = 0; i < 15; ++i) b += (d >= bd[i]) ? 1 : 0;
    return b;
}
constexpr float LOG2E = 1.4426950408889634f;
constexpr float QSCALE = 0.125f * LOG2E;
typedef float f32x16 __attribute__((ext_vector_type(16)));
#define ATT_LAS __attribute__((address_space(3)))
constexpr int ATT_K = 0, ATT_V = 16384, ATT_DL = 32768, ATT_LDS = 32768 + 1024;
DEVFN void attn_unit(const Params& P, char* lds, int b, int h, int qb) {
    const int tid = tid_opaque(), lane = tid & 63, wid = __builtin_amdgcn_readfirstlane(tid >> 6), r32 = lane & 31, hi = lane >> 5;
    const half_t* proj = (const half_t*)(P.ws + OFF_BIG);
    const half_t* VT = (const half_t*)P.out; const half_t* VTM = VT + VT_ELEMS;
    const unsigned long long* maskt = (const unsigned long long*)(P.ws + OFF_MASK) + (size_t)b * 33 * SEQ;
    ATT_LAS char* L = (ATT_LAS char*)lds;
    float* dl = (float*)(lds + ATT_DL);
    const int sq = 256 * qb + 32 * wid + r32;
    const int NT = 4 * qb + 5;
    if (tid < 129) dl[tid] = tid < 128 ? (P.rel_bias[t5_bucket(tid) * 16 + h] - P.rel_bias[31 * 16 + h]) * LOG2E : 0.f;
    f16x8 qf[4];
#pragma unroll
    for (int d0 = 0; d0 < 4; ++d0) qf[d0] = *(const f16x8*)(proj + ((size_t)b * SEQ + sq) * NPROJ + h * 64 + 16 * d0 + 8 * hi);
    const int drow = wid * 8 + (lane >> 3), dch = (lane & 7) ^ ((lane >> 3) & 7);
    const half_t* ksrc_m = proj + (size_t)(MX + drow) * NPROJ + COL_K + h * 64 + dch * 8;
    const half_t* ksrc_x = proj + ((size_t)b * SEQ + drow) * NPROJ + COL_K + h * 64 + dch * 8;
    const half_t* vsrc_m = VTM + (size_t)(h * 64 + drow) * 256 + dch * 8;
    const half_t* vsrc_x = VT + ((size_t)(b * 16 + h) * 64 + drow) * SEQ + dch * 8;
#define ATT_DMA(tt, slot) do { const half_t* ks_ = (tt) == 0 ? ksrc_m : ksrc_x + (size_t)((tt) - 1) * 64 * NPROJ; const half_t* vs_ = (tt) == 0 ? vsrc_m : vsrc_x + ((tt) - 1) * 64; \
        __builtin_amdgcn_global_load_lds((const unsigned*)ks_, (ATT_LAS unsigned*)(L + ATT_K + (slot) * 8192 + wid * 1024), 16, 0, 0); \
        __builtin_amdgcn_global_load_lds((const unsigned*)vs_, (ATT_LAS unsigned*)(L + ATT_V + (slot) * 8192 + wid * 1024), 16, 0, 0); } while (0)
    int foff[8];
#pragma unroll
    for (int c = 0; c < 8; ++c) foff[c] = r32 * 128 + (((c) ^ (r32 & 7)) * 16);
    float m = -1e30f, l = 0.f;
    f32x16 o0, o1;
#pragma unroll
    for (int r = 0; r < 16; ++r) { o0[r] = 0.f; o1[r] = 0.f; }
    ATT_DMA(0, 0);
    unsigned long long mw_next = maskt[sq];
    asm volatile("s_waitcnt vmcnt(0)" ::: "memory");
    __syncthreads();
    for (int tt = 0; tt < NT; ++tt) {
        const int cur = tt & 1;
        const unsigned long long mw = mw_next;
        if (tt + 1 < NT) { ATT_DMA(tt + 1, cur ^ 1); mw_next = maskt[(size_t)(tt + 1) * SEQ + sq]; }
        const int kbase = tt == 0 ? 0 : 64 * (tt - 1);
        const bool active = tt == 0 || kbase <= 256 * qb + 32 * wid + 31;
        if (active) {
            f32x16 c0, c1;
#pragma unroll
            for (int r = 0; r < 16; ++r) { c0[r] = 0.f; c1[r] = 0.f; }
            const ATT_LAS char* kb = L + ATT_K + cur * 8192;
#pragma unroll
            for (int d0 = 0; d0 < 4; ++d0) {
                const f16x8 k0 = *(const ATT_LAS f16x8*)(kb + foff[2 * d0 + hi]);
                const f16x8 k1 = *(const ATT_LAS f16x8*)(kb + 4096 + foff[2 * d0 + hi]);
                c0 = __builtin_amdgcn_mfma_f32_32x32x16_f16(k0, qf[d0], c0, 0, 0, 0);
                c1 = __builtin_amdgcn_mfma_f32_32x32x16_f16(k1, qf[d0], c1, 0, 0, 0);
            }
            const int dist0 = tt == 0 ? sq + 16 - 4 * hi : sq - kbase - 4 * hi;
            const bool nearb = tt == 0 ? (256 * qb + 32 * wid + 16 - 15 < 128) : (256 * qb + 32 * wid - (kbase + 63) < 128);
            if (nearb) {
#pragma unroll
                for (int r = 0; r < 16; ++r) { const int kk = (r & 3) + 8 * (r >> 2);
                    int d0_ = dist0 - kk, d1_ = dist0 - kk - 32; d0_ = d0_ < 0 ? 0 : (d0_ > 128 ? 128 : d0_); d1_ = d1_ < 0 ? 0 : (d1_ > 128 ? 128 : d1_);
                    c0[r] += dl[d0_]; c1[r] += dl[d1_]; }
            }
            const unsigned mlo = (unsigned)mw >> (4 * hi), mhi = (unsigned)(mw >> 32) >> (4 * hi);
            float tmax = -INFINITY;
#pragma unroll
            for (int r = 0; r < 16; ++r) { const int cb = (r & 3) + 8 * (r >> 2);
                c0[r] = ((mlo >> cb) & 1u) ? c0[r] : -INFINITY; c1[r] = ((mhi >> cb) & 1u) ? c1[r] : -INFINITY;
                tmax = fmaxf(tmax, fmaxf(c0[r], c1[r])); }
            tmax = fmaxf(tmax, __shfl_xor(tmax, 32));
            const float mn = fmaxf(m, tmax), alpha = __builtin_amdgcn_exp2f(m - mn);
            m = mn;
            float ls = 0.f;
#pragma unroll
            for (int r = 0; r < 16; ++r) { c0[r] = __builtin_amdgcn_exp2f(c0[r] - mn); c1[r] = __builtin_amdgcn_exp2f(c1[r] - mn); ls += c0[r] + c1[r]; }
            l = l * alpha + ls;
            if (!__all(alpha == 1.0f)) {
#pragma unroll
                for (int r = 0; r < 16; ++r) { o0[r] *= alpha; o1[r] *= alpha; }
            }
            const ATT_LAS char* vb = L + ATT_V + cur * 8192;
#pragma unroll
            for (int s = 0; s < 4; ++s) {
                f16x8 pf;
#pragma unroll
                for (int jj = 0; jj < 8; ++jj) pf[jj] = (half_t)((s < 2) ? c0[8 * (s & 1) + jj] : c1[8 * (s & 1) + jj]);
                const f16x8 v0 = *(const ATT_LAS f16x8*)(vb + foff[2 * s + hi]);
                const f16x8 v1 = *(const ATT_LAS f16x8*)(vb + 4096 + foff[2 * s + hi]);
                o0 = __builtin_amdgcn_mfma_f32_32x32x16_f16(v0, pf, o0, 0, 0, 0);
                o1 = __builtin_amdgcn_mfma_f32_32x32x16_f16(v1, pf, o1, 0, 0, 0);
            }
        }
        asm volatile("s_waitcnt vmcnt(0)" ::: "memory");
        __syncthreads();
    }
#undef ATT_DMA
    l += __shfl_xor(l, 32);
    const float il = 1.0f / l;
    half_t* orow = (half_t*)(P.ws + OFF_HA) + ((size_t)b * SEQ + sq) * D + h * 64;
#pragma unroll
    for (int g = 0; g < 4; ++g) { f16x4 a, c;
#pragma unroll
        for (int e = 0; e < 4; ++e) { a[e] = (half_t)(o0[4 * g + e] * il); c[e] = (half_t)(o1[4 * g + e] * il); }
        *(f16x4*)(orow + 8 * g + 4 * hi) = a; *(f16x4*)(orow + 32 + 8 * g + 4 * hi) = c; }
}
DEVFN void attn_meta_rows(const Params& P, int bid, int nb) {
    const half_t* proj = (const half_t*)(P.ws + OFF_BIG); half_t* AO = (half_t*)(P.ws + OFF_HA);
    const int tid = tid_opaque() & 255, sub = tid_opaque() >> 8, head = tid >> 4;
    for (int mrow = 2 * bid + sub; mrow < NMETA; mrow += 2 * nb) {
        const int r = MX + mrow;
        float q[4]; { const f16x4 qv = *(const f16x4*)(proj + (size_t)r * NPROJ + tid * 4); q[0] = (float)qv[0]; q[1] = (float)qv[1]; q[2] = (float)qv[2]; q[3] = (float)qv[3]; }
        float m = -1e30f, l = 0.f, o[4] = {0.f, 0.f, 0.f, 0.f};
        for (int p = 0; p <= mrow; ++p) {
            const half_t* kr = proj + (size_t)(MX + p) * NPROJ + tid * 4;
            const f16x4 kv = *(const f16x4*)(kr + COL_K), vv = *(const f16x4*)(kr + COL_V);
            float d = q[0] * (float)kv[0] + q[1] * (float)kv[1] + q[2] * (float)kv[2] + q[3] * (float)kv[3];
            d += __shfl_xor(d, 1); d += __shfl_xor(d, 2); d += __shfl_xor(d, 4); d += __shfl_xor(d, 8);
            const float s = d + P.rel_bias[t5_bucket(mrow - p) * 16 + head] * LOG2E;
            const float mn = fmaxf(m, s), corr = __builtin_amdgcn_exp2f(m - mn), pe = __builtin_amdgcn_exp2f(s - mn);
            l = l * corr + pe;
#pragma unroll
            for (int c = 0; c < 4; ++c) o[c] = o[c] * corr + pe * (float)vv[c];
            m = mn;
        }
        const float il = 1.0f / l; f16x4 hh; hh[0] = (half_t)(o[0] * il); hh[1] = (half_t)(o[1] * il); hh[2] = (half_t)(o[2] * il); hh[3] = (half_t)(o[3] * il);
        *(f16x4*)(AO + (size_t)r * D + tid * 4) = hh;
    }
}
DEVFN void phase_attn(const Params& P, char* lds, int bid, int nb) {
    attn_meta_rows(P, bid, nb);
    for (int bh = bid; bh < NBATCH * 16; bh += nb)
        for (int qb = 7; qb >= 0; --qb) attn_unit(P, lds, bh >> 4, bh & 15, qb);
}

typedef float f32x2 __attribute__((ext_vector_type(2)));
DEVFN void phase_conv(const Params& P, char* lds, int bid, int nb) {
    const half_t* U = (const half_t*)(P.ws + OFF_BIG); half_t* C = (half_t*)(P.ws + OFF_C);
    const int tid = tid_opaque(), lane = tid & 63, wid = __builtin_amdgcn_readfirstlane(tid >> 6);
    const int c0 = 128 * wid + 2 * lane;
    float* ys = (float*)lds;
    f32x2 w[31];
#pragma unroll
    for (int k = 0; k < 31; ++k) w[k] = *(const f32x2*)(P.w_dw + (size_t)k * D + c0);
    const f32x2 bias = *(const f32x2*)(P.b_dw + c0);
    for (int unit = bid; unit < NBATCH * (SEQ / 32); unit += nb) {
        const int b = unit >> 6, sbase = 32 * (unit & 63);
        f32x2 uw[62];
#pragma unroll
        for (int wi = 0; wi < 62; ++wi) { const int sx = sbase - 30 + wi;
            const int row = sx >= 0 ? b * SEQ + sx : MX + (sx + 16 >= 0 ? sx + 16 : 0);
            const f16x2 ld_ = *(const f16x2*)(U + (size_t)row * D + c0);
            uw[wi] = sx + 16 >= 0 ? (f32x2){(float)ld_[0], (float)ld_[1]} : (f32x2){0.f, 0.f}; }
#pragma unroll
        for (int i = 0; i < 32; ++i) { f32x2 a = bias;
#pragma unroll
            for (int k = 0; k < 31; ++k) a = w[k] * uw[i + k] + a;
            *(f32x2*)(ys + i * D + c0) = a; }
        __syncthreads();
#pragma unroll 1
        for (int tt = 0; tt < 4; ++tt) { const int i = 4 * wid + tt;
            f32x4 y[4]; float s = 0.f;
#pragma unroll
            for (int q = 0; q < 4; ++q) { y[q] = *(const f32x4*)(ys + i * D + 4 * lane + 256 * q); s += (y[q][0] + y[q][1]) + (y[q][2] + y[q][3]); }
            const float mean = wave_sum(s) * (1.f / D); float qv = 0.f;
#pragma unroll
            for (int q = 0; q < 4; ++q) { y[q] = y[q] - mean; qv += (y[q][0] * y[q][0] + y[q][1] * y[q][1]) + (y[q][2] * y[q][2] + y[q][3] * y[q][3]); }
            const float rstd = 1.0f / sqrtf(wave_sum(qv) * (1.f / D) + LN_EPS);
            half_t* orow = C + ((size_t)b * SEQ + sbase + i) * D + 4 * lane;
#pragma unroll
            for (int q = 0; q < 4; ++q) { const f32x4 z = y[q] * rstd * *(const f32x4*)(P.cln_g + 4 * lane + 256 * q) + *(const f32x4*)(P.cln_b + 4 * lane + 256 * q); const f32x4 o = silu4(z);
                f16x4 h; h[0] = (half_t)o[0]; h[1] = (half_t)o[1]; h[2] = (half_t)o[2]; h[3] = (half_t)o[3];
                *(f16x4*)(orow + 256 * q) = h; }
        }
        __syncthreads();
    }
}

constexpr int N_PHASES = 13;
constexpr int LDS_BYTES = 147456;
static_assert(pg8::STAGE_BYTES == 131072, "LDS");

DEVFN void run_phase(const Params& P, int ph, char* lds, int bid, int nb) {
    unsigned char* ws = P.ws;
    half_t* HA = (half_t*)(ws + OFF_HA); half_t* BIG = (half_t*)(ws + OFF_BIG); half_t* CB = (half_t*)(ws + OFF_C); half_t* Y = (half_t*)(ws + OFF_Y);
    float* ST0 = (float*)(ws + OFF_ST0); float* ST1 = (float*)(ws + OFF_ST1); const float* C1 = (const float*)(ws + OFF_C1); const float* C2 = (const float*)(ws + OFF_C2);
    switch (ph) {
    case 0: phase_prep(P, lds, bid, nb); break;
    case 1: gemm_phase(HA, (const half_t*)(ws + OFF_W_IN), MP, NPROJ, D, EpiProj{BIG, NPROJ, (half_t*)P.out, (half_t*)P.out + VT_ELEMS}, lds, bid, nb); break;
    case 2: finish_colconsts(P, bid, nb); phase_indexer(P, lds, bid, nb); break;
    case 3: phase_attn(P, lds, bid, nb); break;
    case 4: gemm_phase(HA, (const half_t*)(ws + OFF_W_O), MP, D, D, EpiResidX{P.x, P.meta, Y, ST0}, lds, bid, nb); break;
    case 5: gemm_phase(Y, (const half_t*)(ws + OFF_W_GU0), MP, 2 * DFF, D, EpiLnSwiGLU{BIG, DFF, ST0, C1 + NC_GU0, C2 + NC_GU0, lds}, lds, bid, nb); break;
    case 6: gemm_phase(BIG, (const half_t*)(ws + OFF_W_D0), MP, D, DFF, EpiResidLN{Y, ST0, ST1, P.ln1_g, P.ln1_b, nullptr, lds}, lds, bid, nb); break;
    case 7: gemm_phase(Y, (const half_t*)(ws + OFF_W_PW1), MP, 2 * D, D, EpiLnGLU{BIG, D, ST1, C1 + NC_PW1, C2 + NC_PW1, lds}, lds, bid, nb); break;
    case 8: phase_conv(P, lds, bid, nb); break;
    case 9: gemm_phase(CB, (const half_t*)(ws + OFF_W_PW2), MX, D, D, EpiResidLN{Y, ST1, ST0, P.ln2_g, P.ln2_b, P.b_pw2, lds}, lds, bid, nb); break;
    case 10: gemm_phase(Y, (const half_t*)(ws + OFF_W_GU1), MX, 2 * DFF, D, EpiLnSwiGLU{BIG, DFF, ST0, C1 + NC_GU1, C2 + NC_GU1, lds}, lds, bid, nb); break;
    case 11: gemm_phase(BIG, (const half_t*)(ws + OFF_W_D1), MX, D, DFF, EpiResidLN{Y, ST0, ST1, P.ln1_g + D, P.ln1_b + D, nullptr, lds}, lds, bid, nb); break;
    case 12: phase_final_ln(P, ST1, P.ln2_g + D, P.ln2_b + D, bid, nb); break;
    default: break;
    }
}

#if MODE_COOP
__global__ void __launch_bounds__(NTHREADS, 2) fwd_mega(Params P) {
    extern __shared__ __attribute__((aligned(16))) char lds[];
    cg::grid_group grid = cg::this_grid();
#define PHASE(k) run_phase(P, k, lds, blockIdx.x, gridDim.x)
#define SEAM() grid.sync()
    PHASE(0); SEAM(); PHASE(1); SEAM(); PHASE(2); SEAM(); PHASE(3); SEAM(); PHASE(4); SEAM(); PHASE(5); SEAM(); PHASE(6); SEAM(); PHASE(7); SEAM();
    PHASE(8); SEAM(); PHASE(9); SEAM(); PHASE(10); SEAM(); PHASE(11); SEAM(); PHASE(12);
#undef PHASE
#undef SEAM
}
#else
template <int PH> __global__ void __launch_bounds__(NTHREADS, 2) fwd_phase(Params P) {
    extern __shared__ __attribute__((aligned(16))) char lds[];
    run_phase(P, PH, lds, blockIdx.x, gridDim.x);
}
template <int PH> static void launch_phases(const Params& p, hipStream_t stream) {
    hipFuncSetAttribute((const void*)fwd_phase<PH>, hipFuncAttributeMaxDynamicSharedMemorySize, LDS_BYTES);
    hipLaunchKernelGGL(fwd_phase<PH>, dim3(256), dim3(NTHREADS), LDS_BYTES, stream, p);
    if constexpr (PH + 1 < N_PHASES) launch_phases<PH + 1>(p, stream);
}
#endif

extern "C" void kernel_launch(void* const* d_in, const int* in_sizes, int n_in, void* d_out, int out_size, void* d_ws, size_t ws_size, hipStream_t stream) {
    if (n_in != 20 || ws_size < WS_END || out_size != MX * D) { fprintf(stderr, "kernel_launch: unexpected sizes n_in %d ws %zu out %d\n", n_in, ws_size, out_size); return; }
    Params p{};
    const float** pp = (const float**)&p;
    for (int i = 0; i < 20; ++i) pp[i] = (const float*)d_in[i];
    p.out = (float*)d_out; p.ws = (unsigned char*)d_ws;
#if MODE_COOP
    static int grid_blocks = 0;
    if (!grid_blocks) {
        int dev = 0, cus = 0, per_cu = 0;
        hipGetDevice(&dev); hipDeviceGetAttribute(&cus, hipDeviceAttributeMultiprocessorCount, dev);
        hipFuncSetAttribute((const void*)fwd_mega, hipFuncAttributeMaxDynamicSharedMemorySize, LDS_BYTES);
        hipOccupancyMaxActiveBlocksPerMultiprocessor(&per_cu, fwd_mega, NTHREADS, LDS_BYTES);
        if (per_cu < 1) per_cu = 1;
        grid_blocks = cus * per_cu;
    }
    void* args[] = {&p};
    hipError_t e = hipLaunchCooperativeKernel((void*)fwd_mega, dim3(grid_blocks), dim3(NTHREADS), args, LDS_BYTES, stream);
    if (e != hipSuccess) fprintf(stderr, "cooperative launch failed: %s (grid %d)\n", hipGetErrorString(e), grid_blocks);
#else
    launch_phases<0>(p, stream);
#endif
}
```

```cpp
#include <hip/hip_runtime.h>
#include <hip/hip_cooperative_groups.h>
#include <cstdio>
#include <cstdint>
namespace cg = cooperative_groups;

#ifndef MODE_COOP
#define MODE_COOP 1
#endif

#define DEVFN __device__ __forceinline__
typedef _Float16 half_t;
typedef _Float16 f16x8 __attribute__((ext_vector_type(8)));
typedef _Float16 f16x4 __attribute__((ext_vector_type(4)));
typedef _Float16 f16x2 __attribute__((ext_vector_type(2)));
typedef float f32x4 __attribute__((ext_vector_type(4)));

constexpr int D = 1024, NBATCH = 16, SEQ = 2048, NMETA = 16;
constexpr int MX = NBATCH * SEQ;
constexpr int MV = MX + NMETA;
constexpr int MP = 33024;
constexpr int NPROJ = 3840, NPROJ_VALID = 3656;
constexpr int DFF = 2816;
constexpr int COL_K = 1024, COL_V = 2048, COL_QI = 3072, COL_KI = 3584, COL_WI = 3648;
constexpr int MASK_W64 = 33;
constexpr float ALPHA = 1.41421356237309515f;
constexpr float LN_EPS = 1e-5f;
constexpr int NTHREADS = 512;
constexpr size_t VT_ELEMS = (size_t)NBATCH * 16 * 64 * SEQ;

constexpr size_t MiB = 1u << 20;
constexpr size_t OFF_W_IN = 0, OFF_W_O = 8 * MiB, OFF_W_GU0 = 10 * MiB, OFF_W_GU1 = 21 * MiB, OFF_W_D0 = 32 * MiB, OFF_W_D1 = 38 * MiB,
                 OFF_W_PW1 = 44 * MiB, OFF_W_PW2 = 48 * MiB, OFF_MASK = 50 * MiB, OFF_Y = 60 * MiB, OFF_ST0 = 126 * MiB, OFF_ST1 = 131 * MiB,
                 OFF_CP1 = 136 * MiB, OFF_CP2 = 138 * MiB, OFF_C1 = 140 * MiB, OFF_C2 = 140 * MiB + 65536, OFF_CTL = 141 * MiB, OFF_HA = 190 * MiB, OFF_BIG = 256 * MiB,
                 OFF_C = OFF_BIG + 65 * MiB, WS_END = OFF_BIG + 242 * MiB;
constexpr int NC_GU0 = 0, NC_GU1 = 2 * DFF, NC_PW1 = 4 * DFF, NC_TOTAL = 4 * DFF + 2 * D;
static_assert((size_t)MP * 16 * 8 <= 5 * MiB && (size_t)32 * NC_TOTAL * 4 <= 2 * MiB && (size_t)NC_TOTAL * 4 <= 65536, "stats");
static_assert((size_t)NPROJ * D * 2 <= 8 * MiB && (size_t)2 * DFF * D * 2 <= 11 * MiB && (size_t)DFF * D * 2 <= 6 * MiB, "weights");
static_assert((size_t)MP * MASK_W64 * 8 <= 10 * MiB && (size_t)MP * D * 2 <= 65 * MiB && (size_t)MP * NPROJ * 2 <= 242 * MiB, "acts");

struct Params {
    const float *x, *meta, *rel_bias, *w_in, *w_o, *w_pw1, *b_pw1, *w_dw, *b_dw, *cln_g, *cln_b, *w_pw2, *b_pw2, *ln1_g, *ln1_b, *wg, *wu, *wd, *ln2_g, *ln2_b;
    float* out; unsigned char* ws;
};

DEVFN int tid_opaque() { int t = threadIdx.x; asm volatile("" : "+v"(t)); return t; }
DEVFN float wave_sum(float v) {
#pragma unroll
    for (int o = 1; o < 64; o <<= 1) v += __shfl_xor(v, o);
    return v;
}
DEVFN float sigmoidf_(float x) { return 1.0f / (1.0f + __expf(-x)); }

DEVFN void prep_tile(const float* srcA, const float* srcB, int ld, int K, int Nsrc, int mode, half_t* dst, int tile, float* scr  , int qrows,
                     const float* lng, const float* lnb, float* cp1, float* cp2) {
    const int nkt = K / 32, tn = tile / nkt, tk = tile % nkt, n0 = tn * 32, k0 = tk * 32;
    const int tx = tid_opaque() & 31, ty = tid_opaque() >> 5;
    float* scr2 = scr + 32 * 33 + 32;
#pragma unroll
    for (int i = 0; i < 2; ++i) {
        const int k = k0 + ty + 16 * i, n = n0 + tx; float v = 0.f;
        if (mode == 0) { if (n < Nsrc) v = srcA[(size_t)k * ld + n]; if (n < qrows) v *= 0.18033688011112042f; }
        else { const float* s = ((n >> 7) & 1) ? srcB : srcA; v = s[(size_t)k * ld + ((n >> 8) * 128 + (n & 127))]; }
        if (lng) { scr2[(ty + 16 * i) * 33 + tx] = v * lnb[k]; v *= lng[k]; }
        scr[(ty + 16 * i) * 33 + tx] = v;
    }
    __syncthreads();
#pragma unroll
    for (int i = 0; i < 2; ++i) {
        const int n = n0 + ty + 16 * i, k = k0 + tx;
        dst[(size_t)n * K + k] = (half_t)scr[tx * 33 + ty + 16 * i];
    }
    if (lng && ty == 0) { float s1 = 0.f, s2 = 0.f;
#pragma unroll 8
        for (int k = 0; k < 32; ++k) { s1 += (float)(half_t)scr[k * 33 + tx]; s2 += scr2[k * 33 + tx]; }
        cp1[(size_t)tk * NC_TOTAL + n0 + tx] = s1; cp2[(size_t)tk * NC_TOTAL + n0 + tx] = s2; }
    __syncthreads();
}

DEVFN void phase_prep(const Params& P, char* lds, int bid, int nb) {
    float* scr = (float*)lds;
    unsigned char* ws = P.ws;
    float* cp1 = (float*)(ws + OFF_CP1); float* cp2 = (float*)(ws + OFF_CP2);
    constexpr int T_IN = (NPROJ / 32) * (D / 32), T_SQ = (D / 32) * (D / 32), T_GU = (2 * DFF / 32) * (D / 32), T_DN = (D / 32) * (DFF / 32), T_PW1 = (2 * D / 32) * (D / 32);
    constexpr int TOTAL = T_IN + T_SQ + 2 * T_GU + 2 * T_DN + T_PW1 + T_SQ;
    for (int it = bid; it < TOTAL; it += nb) {
        int r = it;
        if (r < T_IN) { prep_tile(P.w_in, nullptr, NPROJ_VALID, D, NPROJ_VALID, 0, (half_t*)(ws + OFF_W_IN), r, scr, D, nullptr, nullptr, nullptr, nullptr); continue; } r -= T_IN;
        if (r < T_SQ) { prep_tile(P.w_o, nullptr, D, D, D, 0, (half_t*)(ws + OFF_W_O), r, scr, 0, nullptr, nullptr, nullptr, nullptr); continue; } r -= T_SQ;
        if (r < T_GU) { prep_tile(P.wg, P.wu, DFF, D, DFF, 1, (half_t*)(ws + OFF_W_GU0), r, scr, 0, P.ln1_g, P.ln1_b, cp1 + NC_GU0, cp2 + NC_GU0); continue; } r -= T_GU;
        if (r < T_GU) { prep_tile(P.wg + (size_t)D * DFF, P.wu + (size_t)D * DFF, DFF, D, DFF, 1, (half_t*)(ws + OFF_W_GU1), r, scr, 0, P.ln1_g + D, P.ln1_b + D, cp1 + NC_GU1, cp2 + NC_GU1); continue; } r -= T_GU;
        if (r < T_DN) { prep_tile(P.wd, nullptr, D, DFF, D, 0, (half_t*)(ws + OFF_W_D0), r, scr, 0, nullptr, nullptr, nullptr, nullptr); continue; } r -= T_DN;
        if (r < T_DN) { prep_tile(P.wd + (size_t)DFF * D, nullptr, D, DFF, D, 0, (half_t*)(ws + OFF_W_D1), r, scr, 0, nullptr, nullptr, nullptr, nullptr); continue; } r -= T_DN;
        if (r < T_PW1) { prep_tile(P.w_pw1, P.w_pw1 + D, 2 * D, D, D, 1, (half_t*)(ws + OFF_W_PW1), r, scr, 0, P.ln2_g, P.ln2_b, cp1 + NC_PW1, cp2 + NC_PW1); continue; } r -= T_PW1;
        prep_tile(P.w_pw2, nullptr, D, D, D, 0, (half_t*)(ws + OFF_W_PW2), r, scr, 0, nullptr, nullptr, nullptr, nullptr);
    }
    half_t* HA = (half_t*)(ws + OFF_HA);
    const int lane = tid_opaque() & 63, gw = bid * (NTHREADS / 64) + (tid_opaque() >> 6), ngw = nb * (NTHREADS / 64);
    for (int r = gw; r < MP; r += ngw) {
        const float* src = r < MX ? P.x + (size_t)r * D : (r < MV ? P.meta + (size_t)(r - MX) * D : nullptr);
#pragma unroll
        for (int j = 0; j < 4; ++j) {
            const int c = lane * 4 + 256 * j;
            f32x4 v = src ? *(const f32x4*)(src + c) : (f32x4){0.f, 0.f, 0.f, 0.f};
            f16x4 h; h[0] = (half_t)v[0]; h[1] = (half_t)v[1]; h[2] = (half_t)v[2]; h[3] = (half_t)v[3];
            *(f16x4*)(HA + (size_t)r * D + c) = h;
        }
    }
}
DEVFN void finish_colconsts(const Params& P, int bid, int nb) {
    const float* cp1 = (const float*)(P.ws + OFF_CP1); const float* cp2 = (const float*)(P.ws + OFF_CP2);
    float* c1 = (float*)(P.ws + OFF_C1); float* c2 = (float*)(P.ws + OFF_C2);
    for (int idx = bid * NTHREADS + tid_opaque(); idx < NC_TOTAL; idx += nb * NTHREADS) {
        float s1 = 0.f, s2 = 0.f;
        for (int tk = 0; tk < 32; ++tk) { s1 += cp1[(size_t)tk * NC_TOTAL + idx]; s2 += cp2[(size_t)tk * NC_TOTAL + idx]; }
        if (idx >= NC_PW1) { const int n = idx - NC_PW1; s2 += P.b_pw1[((n >> 7) & 1) * D + (n >> 8) * 128 + (n & 127)]; }
        c1[idx] = s1; c2[idx] = s2;
    }
}

namespace pg8 {
#define PG8_LAS __attribute__((address_space(3)))
constexpr int BM = 256, BK = 64, HALF = 128, HTB = HALF * BK * 2  , STAGE_BYTES = 8 * HTB, NXCD = 8, WGM = 8;
__host__ __device__ __forceinline__ int lds_byte(int r, int c) { const int st = (r >> 4) * 2 + (c >> 5), rr = r & 15, cc = c & 31, ob = rr * 64 + cc * 2; return st * 1024 + (ob ^ (((ob >> 9) & 1) << 5)); }
__host__ __device__ __forceinline__ void stage_rc(int b, int& R, int& C) { const int st = b / 1024, sb = b % 1024, swz = sb ^ (((sb >> 9) & 1) << 5); R = (st >> 1) * 16 + swz / 64; C = (st & 1) * 32 + (swz % 64) / 2; }
__host__ __device__ __forceinline__ int perm32(int rho) { const int n = rho >> 4, i = rho & 15; return 8 * (i >> 2) + 4 * n + (i & 3); }
struct Unit { int pm, pn; };
struct Gemm { const half_t* A; const half_t* Bt; int M, N, K; };
struct StaticOrder {
    int nM, nN, nwg, G, c;
    __host__ __device__ void init(int M, int N, int G_, int c_) { nM = M / BM; nN = N / BM; nwg = nM * nN; G = G_; c = c_; }
    __host__ __device__ bool next(int i, Unit& u) const {
        const long L = (long)i * G + c; if (L >= nwg) return false;
        int wgid = (int)L; { const int q = nwg / NXCD, r = nwg % NXCD, xcd = wgid % NXCD, off = wgid / NXCD; wgid = (xcd < r ? xcd * (q + 1) : r * (q + 1) + (xcd - r) * q) + off; }
        const int nig = WGM * nN, gid = wgid / nig, fm = gid * WGM, gsz = (nM - fm) < WGM ? (nM - fm) : WGM;
        u.pm = fm + ((wgid % nig) % gsz); u.pn = (wgid % nig) / gsz; return true;
    }
};
template <class Epi, bool ALIGN_EPI = true>
__device__ __forceinline__ void gemm_phase(PG8_LAS unsigned char* lds, const Gemm g, const StaticOrder& S, const Epi& E) {
    int tid = threadIdx.x; asm volatile("" : "+v"(tid));
    const int wid = __builtin_amdgcn_readfirstlane(tid >> 6), lane = tid & 63, wr = wid >> 2, wc = wid & 3, fr = lane & 15, fq = lane >> 4;
    const int K = g.K, nt = K / BK;
    unsigned voffA[2], voffB[2];
#pragma unroll
    for (int i = 0; i < 2; ++i) { int R, C; stage_rc(tid * 16 + i * 8192, R, C); const int Rb = (R & ~31) + perm32(R & 31);
        voffA[i] = (unsigned)(R * K + C) * 2u; voffB[i] = (unsigned)(Rb * K + C) * 2u; }
    const size_t kstep = (size_t)(BK * 2);
    const size_t hstep = (size_t)HALF * K * 2;
    const size_t tstep = 2 * hstep;
    const unsigned ldsw = (unsigned)wid * 1024u;
    const int aoff = lds_byte(wr * 64 + fr, fq * 8), boff = lds_byte(wc * 32 + fr, fq * 8);
#define PG8_SA(b, h) (((b) * 2 + (h)) * HTB)
#define PG8_SB(b, h) ((4 + (b) * 2 + (h)) * HTB)
#define PG8_STAGE(bufoff, gbase, voff) do { _Pragma("unroll") for (int _i = 0; _i < 2; ++_i) \
        __builtin_amdgcn_global_load_lds((const unsigned*)((const char*)(gbase) + (voff)[_i]), (PG8_LAS unsigned*)(lds + (bufoff) + ldsw + _i * 8192), 16, 0, 0); } while (0)
#define PG8_LDA(dst, b, h) do { _Pragma("unroll") for (int m = 0; m < 4; ++m) _Pragma("unroll") for (int k = 0; k < 2; ++k) dst[m][k] = *(const PG8_LAS f16x8*)(lds + PG8_SA(b, h) + aoff + m * 2048 + k * 1024); } while (0)
#define PG8_LDB(dst, b, h) do { _Pragma("unroll") for (int n = 0; n < 2; ++n) _Pragma("unroll") for (int k = 0; k < 2; ++k) dst[n][k] = *(const PG8_LAS f16x8*)(lds + PG8_SB(b, h) + boff + n * 2048 + k * 1024); } while (0)
#define PG8_MMA(ai, bj, At, Bt) do { __builtin_amdgcn_s_setprio(1); _Pragma("unroll") for (int m = 0; m < 4; ++m) _Pragma("unroll") for (int n = 0; n < 2; ++n) _Pragma("unroll") for (int k = 0; k < 2; ++k) \
        acc[ai][bj][m][n] = __builtin_amdgcn_mfma_f32_16x16x32_f16(Bt[n][k], At[m][k], acc[ai][bj][m][n], 0, 0, 0); __builtin_amdgcn_s_setprio(0); } while (0)
#define PG8_WAIT_V(n) asm volatile("s_waitcnt vmcnt(" #n ")" ::: "memory")
#define PG8_WAIT_L(n) asm volatile("s_waitcnt lgkmcnt(" #n ")" ::: "memory")
#define PG8_BAR __builtin_amdgcn_s_barrier()
#define PG8_SCHED __builtin_amdgcn_sched_barrier(0)
    Unit cur, nxt; int ui = 0;
    if (!S.next(0, cur)) return;
    f32x4 acc[2][2][4][2];
#pragma unroll
    for (int a = 0; a < 2; ++a)
#pragma unroll
        for (int b = 0; b < 2; ++b)
#pragma unroll
            for (int m = 0; m < 4; ++m)
#pragma unroll
                for (int n = 0; n < 2; ++n) acc[a][b][m][n] = (f32x4){0.f, 0.f, 0.f, 0.f};
    f16x8 At[4][2], B0[2][2], B1[2][2];
    const char* cA = (const char*)g.A + (size_t)cur.pm * tstep; const char* cB = (const char*)g.Bt + (size_t)cur.pn * tstep;
    E.prepare(cur, 0);
    PG8_STAGE(PG8_SB(0, 0), cB, voffB); PG8_STAGE(PG8_SB(0, 1), cB + hstep, voffB); PG8_STAGE(PG8_SA(0, 0), cA, voffA); PG8_STAGE(PG8_SA(0, 1), cA + hstep, voffA);
    if (wr == 1) PG8_BAR;
    PG8_WAIT_V(2); PG8_BAR;
    PG8_STAGE(PG8_SB(1, 0), cB + kstep, voffB); PG8_STAGE(PG8_SA(1, 0), cA + kstep, voffA); PG8_STAGE(PG8_SB(1, 1), cB + hstep + kstep, voffB);
    PG8_WAIT_V(6); PG8_BAR;
    for (;;) {
        const bool has_next = S.next(ui + 1, nxt);
        const char* nA = has_next ? (const char*)g.A + (size_t)nxt.pm * tstep : cA; const char* nB = has_next ? (const char*)g.Bt + (size_t)nxt.pn * tstep : cB;
        for (int t = 0; t < nt; t += 2) {
            const bool last = (t == nt - 2);
            const char* a1 = cA + (size_t)(t + 1) * kstep;
            const char* a2 = last ? nA : cA + (size_t)(t + 2) * kstep; const char* b2 = last ? nB : cB + (size_t)(t + 2) * kstep;
            const char* a3 = a2 + kstep; const char* b3 = b2 + kstep;
            if (last && has_next) E.prepare(nxt, (ui + 1) & 1);
            PG8_LDB(B0, 0, 0); PG8_LDB(B1, 0, 1); PG8_SCHED; PG8_LDA(At, 0, 0); PG8_STAGE(PG8_SA(1, 1), a1 + hstep, voffA);
            PG8_WAIT_V(8); PG8_WAIT_L(0); PG8_BAR; PG8_MMA(0, 0, At, B0); PG8_MMA(0, 1, At, B1); PG8_BAR; PG8_SCHED;
            PG8_LDA(At, 0, 1); PG8_STAGE(PG8_SB(0, 0), b2, voffB); PG8_STAGE(PG8_SB(0, 1), b2 + hstep, voffB); PG8_STAGE(PG8_SA(0, 0), a2, voffA);
            PG8_WAIT_V(8); PG8_WAIT_L(0); PG8_BAR; PG8_MMA(1, 0, At, B0); PG8_MMA(1, 1, At, B1); PG8_BAR; PG8_SCHED;
            PG8_LDB(B0, 1, 0); PG8_LDB(B1, 1, 1); PG8_SCHED; PG8_LDA(At, 1, 0); PG8_STAGE(PG8_SA(0, 1), a2 + hstep, voffA);
            PG8_WAIT_V(8); PG8_WAIT_L(0); PG8_BAR; PG8_MMA(0, 0, At, B0); PG8_MMA(0, 1, At, B1); PG8_BAR; PG8_SCHED;
            PG8_LDA(At, 1, 1); PG8_STAGE(PG8_SB(1, 0), b3, voffB); PG8_STAGE(PG8_SB(1, 1), b3 + hstep, voffB); PG8_STAGE(PG8_SA(1, 0), a3, voffA);
            PG8_WAIT_V(8); PG8_WAIT_L(0); PG8_BAR; PG8_MMA(1, 0, At, B0); PG8_MMA(1, 1, At, B1); PG8_BAR; PG8_SCHED;
        }
        if constexpr (ALIGN_EPI) { if (wr == 0) PG8_BAR; }
        E(acc, cur, ui & 1, wr, wc, fr, fq);
        if (!has_next) break;
#pragma unroll
        for (int a = 0; a < 2; ++a)
#pragma unroll
            for (int b = 0; b < 2; ++b)
#pragma unroll
                for (int m = 0; m < 4; ++m)
#pragma unroll
                    for (int n = 0; n < 2; ++n) acc[a][b][m][n] = (f32x4){0.f, 0.f, 0.f, 0.f};
        cur = nxt; cA = nA; cB = nB; ++ui;
        if constexpr (ALIGN_EPI) { if (wr == 1) PG8_BAR; }
    }
    PG8_WAIT_V(0);
    if constexpr (!ALIGN_EPI) { if (wr == 0) PG8_BAR; }
    PG8_BAR;
#undef PG8_SA
#undef PG8_SB
#undef PG8_STAGE
#undef PG8_LDA
#undef PG8_LDB
#undef PG8_MMA
#undef PG8_WAIT_V
#undef PG8_WAIT_L
#undef PG8_BAR
#undef PG8_SCHED
}
}

typedef f32x4 acc_t[2][2][4][2];
DEVFN f16x8 pack8(f32x4 a, f32x4 b) { f16x8 h; h[0] = (half_t)a[0]; h[1] = (half_t)a[1]; h[2] = (half_t)a[2]; h[3] = (half_t)a[3]; h[4] = (half_t)b[0]; h[5] = (half_t)b[1]; h[6] = (half_t)b[2]; h[7] = (half_t)b[3]; return h; }
DEVFN f32x4 silu4(f32x4 g) { f32x4 o; o[0] = g[0] * sigmoidf_(g[0]); o[1] = g[1] * sigmoidf_(g[1]); o[2] = g[2] * sigmoidf_(g[2]); o[3] = g[3] * sigmoidf_(g[3]); return o; }
DEVFN f32x4 sigm4(f32x4 g) { f32x4 o; o[0] = sigmoidf_(g[0]); o[1] = sigmoidf_(g[1]); o[2] = sigmoidf_(g[2]); o[3] = sigmoidf_(g[3]); return o; }
struct EpiStoreF16 { half_t* O; int ld;
    DEVFN void prepare(const pg8::Unit&, int) const {}
    DEVFN void operator()(const acc_t& acc, const pg8::Unit& u, int, int wr, int wc, int fr, int fq) const {
        const int row0 = u.pm * 256 + wr * 64 + fr, col0 = u.pn * 256 + wc * 32 + 8 * fq;
#pragma unroll
        for (int ai = 0; ai < 2; ++ai)
#pragma unroll
            for (int m = 0; m < 4; ++m) { half_t* rowp = O + (size_t)(row0 + ai * 128 + m * 16) * ld + col0;
#pragma unroll
                for (int bj = 0; bj < 2; ++bj) *(f16x8*)(rowp + bj * 128) = pack8(acc[ai][bj][m][0], acc[ai][bj][m][1]); }
    } };
struct EpiProj { half_t* O; int ld; half_t* VT; half_t* VTM;
    DEVFN void prepare(const pg8::Unit&, int) const {}
    DEVFN void operator()(const acc_t& acc, const pg8::Unit& u, int, int wr, int wc, int fr, int fq) const {
        const int row0 = u.pm * 256 + wr * 64 + fr, col0 = u.pn * 256 + wc * 32 + 8 * fq;
#pragma unroll
        for (int ai = 0; ai < 2; ++ai)
#pragma unroll
            for (int m = 0; m < 4; ++m) { half_t* rowp = O + (size_t)(row0 + ai * 128 + m * 16) * ld + col0;
#pragma unroll
                for (int bj = 0; bj < 2; ++bj) *(f16x8*)(rowp + bj * 128) = pack8(acc[ai][bj][m][0], acc[ai][bj][m][1]); }
        if (u.pn >= 8 && u.pn < 12) {
            const int sw = (fr & 3) | ((fr & 4) << 1) | ((fr & 8) >> 1);
#pragma unroll
            for (int ai = 0; ai < 2; ++ai)
#pragma unroll
                for (int m = 0; m < 4; ++m) { const int row = row0 + ai * 128 + m * 16;
                    half_t* base; size_t dstride;
                    if (row < MX) { base = VT + (size_t)(row >> 11) * 1024 * SEQ + (((row & 2047) & ~15) | sw); dstride = SEQ; }
                    else { base = VTM + (((row - MX) & ~15) | sw); dstride = 256; }
#pragma unroll
                    for (int bj = 0; bj < 2; ++bj)
#pragma unroll
                        for (int n = 0; n < 2; ++n)
#pragma unroll
                            for (int e = 0; e < 4; ++e) base[(size_t)(col0 - COL_V + bj * 128 + 4 * n + e) * dstride] = (half_t)acc[ai][bj][m][n][e]; }
        }
    } };
constexpr int TAB_OFF = 131072;
DEVFN void rowstat_fill(const float* st, int pm, char* lds, int parity) {
    const int t = tid_opaque();
    if (t < 256) { const f32x4* p = (const f32x4*)(st + (size_t)(pm * 256 + t) * 32); float s = 0.f, q = 0.f;
#pragma unroll
        for (int i = 0; i < 8; ++i) { const f32x4 v = p[i]; s += v[0] + v[2]; q += v[1] + v[3]; }
        const float mean = s * (1.f / D), var = fmaxf(q * (1.f / D) - mean * mean, 0.f);
        float* tab = (float*)(lds + TAB_OFF) + parity * 512;
        tab[2 * t] = mean; tab[2 * t + 1] = 1.0f / sqrtf(var + LN_EPS); }
}
DEVFN void stat_acc(const f16x8 h, float& s, float& q) {
#pragma unroll
    for (int i = 0; i < 8; ++i) { const float v = (float)h[i]; s += v; q = fmaf(v, v, q); }
}
DEVFN void stat_store(float* st, int row, int slot, float s, float q, int fq) {
    s += __shfl_xor(s, 16); s += __shfl_xor(s, 32); q += __shfl_xor(q, 16); q += __shfl_xor(q, 32);
    if (fq == 0) { float* p = st + (size_t)row * 32 + slot * 2; p[0] = s; p[1] = q; }
}
struct EpiLnSwiGLU { half_t* O; int ld; const float* st; const float* c1; const float* c2; char* lds;
    DEVFN void prepare(const pg8::Unit& u, int parity) const { rowstat_fill(st, u.pm, lds, parity); }
    DEVFN void operator()(const acc_t& acc, const pg8::Unit& u, int parity, int wr, int wc, int fr, int fq) const {
        const int rl0 = wr * 64 + fr, col0 = u.pn * 128 + wc * 32 + 8 * fq, n0 = u.pn * 256 + wc * 32 + 8 * fq;
        const float* tab = (const float*)(lds + TAB_OFF) + parity * 512;
        f32x4 k1[2][2], k2[2][2];
#pragma unroll
        for (int bj = 0; bj < 2; ++bj)
#pragma unroll
            for (int n = 0; n < 2; ++n) { k1[bj][n] = *(const f32x4*)(c1 + n0 + bj * 128 + 4 * n); k2[bj][n] = *(const f32x4*)(c2 + n0 + bj * 128 + 4 * n); }
#pragma unroll
        for (int ai = 0; ai < 2; ++ai)
#pragma unroll
            for (int m = 0; m < 4; ++m) { const int rl = rl0 + ai * 128 + m * 16; const float mean = tab[2 * rl], rstd = tab[2 * rl + 1];
                f32x4 g[2], up[2];
#pragma unroll
                for (int n = 0; n < 2; ++n) { g[n] = (acc[ai][0][m][n] - k1[0][n] * mean) * rstd + k2[0][n]; up[n] = (acc[ai][1][m][n] - k1[1][n] * mean) * rstd + k2[1][n]; }
                *(f16x8*)(O + (size_t)(u.pm * 256 + rl) * ld + col0) = pack8(silu4(g[0]) * up[0], silu4(g[1]) * up[1]); }
    } };
struct EpiLnGLU { half_t* O; int ld; const float* st; const float* c1; const float* c2; char* lds;
    DEVFN void prepare(const pg8::Unit& u, int parity) const { rowstat_fill(st, u.pm, lds, parity); }
    DEVFN void operator()(const acc_t& acc, const pg8::Unit& u, int parity, int wr, int wc, int fr, int fq) const {
        const int rl0 = wr * 64 + fr, col0 = u.pn * 128 + wc * 32 + 8 * fq, n0 = u.pn * 256 + wc * 32 + 8 * fq;
        const float* tab = (const float*)(lds + TAB_OFF) + parity * 512;
        f32x4 k1[2][2], k2[2][2];
#pragma unroll
        for (int bj = 0; bj < 2; ++bj)
#pragma unroll
            for (int n = 0; n < 2; ++n) { k1[bj][n] = *(const f32x4*)(c1 + n0 + bj * 128 + 4 * n); k2[bj][n] = *(const f32x4*)(c2 + n0 + bj * 128 + 4 * n); }
#pragma unroll
        for (int ai = 0; ai < 2; ++ai)
#pragma unroll
            for (int m = 0; m < 4; ++m) { const int rl = rl0 + ai * 128 + m * 16; const float mean = tab[2 * rl], rstd = tab[2 * rl + 1];
                f32x4 a[2], sg[2];
#pragma unroll
                for (int n = 0; n < 2; ++n) { a[n] = (acc[ai][0][m][n] - k1[0][n] * mean) * rstd + k2[0][n]; sg[n] = (acc[ai][1][m][n] - k1[1][n] * mean) * rstd + k2[1][n]; }
                *(f16x8*)(O + (size_t)(u.pm * 256 + rl) * ld + col0) = pack8(a[0] * sigm4(sg[0]), a[1] * sigm4(sg[1])); }
    } };
struct EpiResidX { const float* x; const float* meta; half_t* Y; float* sto;
    DEVFN void prepare(const pg8::Unit&, int) const {}
    DEVFN void operator()(const acc_t& acc, const pg8::Unit& u, int, int wr, int wc, int fr, int fq) const {
        const int row0 = u.pm * 256 + wr * 64 + fr, col0 = u.pn * 256 + wc * 32 + 8 * fq;
#pragma unroll
        for (int ai = 0; ai < 2; ++ai)
#pragma unroll
            for (int m = 0; m < 4; ++m) { const int row = row0 + ai * 128 + m * 16;
                const float* src = row < MX ? x + (size_t)row * D : (row < MV ? meta + (size_t)(row - MX) * D : nullptr);
                float s = 0.f, q = 0.f;
#pragma unroll
                for (int bj = 0; bj < 2; ++bj) { const int col = col0 + bj * 128;
                    const f32x4 r0 = src ? *(const f32x4*)(src + col) : (f32x4){0.f, 0.f, 0.f, 0.f}, r1 = src ? *(const f32x4*)(src + col + 4) : (f32x4){0.f, 0.f, 0.f, 0.f};
                    const f16x8 h = pack8(r0 * ALPHA + acc[ai][bj][m][0], r1 * ALPHA + acc[ai][bj][m][1]);
                    *(f16x8*)(Y + (size_t)row * D + col) = h; stat_acc(h, s, q); }
                stat_store(sto, row, u.pn * 4 + wc, s, q, fq); }
    } };
struct EpiResidLN { half_t* Y; const float* sti; float* sto; const float* g; const float* b; const float* bias; char* lds;
    DEVFN void prepare(const pg8::Unit& u, int parity) const { rowstat_fill(sti, u.pm, lds, parity); }
    DEVFN void operator()(const acc_t& acc, const pg8::Unit& u, int parity, int wr, int wc, int fr, int fq) const {
        const int rl0 = wr * 64 + fr, col0 = u.pn * 256 + wc * 32 + 8 * fq;
        const float* tab = (const float*)(lds + TAB_OFF) + parity * 512;
        f32x4 gg[2][2], bb[2][2];
#pragma unroll
        for (int bj = 0; bj < 2; ++bj)
#pragma unroll
            for (int n = 0; n < 2; ++n) { const int c = col0 + bj * 128 + 4 * n; gg[bj][n] = *(const f32x4*)(g + c) * ALPHA;
                bb[bj][n] = *(const f32x4*)(b + c) * ALPHA; if (bias) bb[bj][n] += *(const f32x4*)(bias + c); }
#pragma unroll
        for (int ai = 0; ai < 2; ++ai)
#pragma unroll
            for (int m = 0; m < 4; ++m) { const int rl = rl0 + ai * 128 + m * 16, row = u.pm * 256 + rl; const float mean = tab[2 * rl], rstd = tab[2 * rl + 1];
                float s = 0.f, q = 0.f;
#pragma unroll
                for (int bj = 0; bj < 2; ++bj) { half_t* yp = Y + (size_t)row * D + col0 + bj * 128; const f16x8 yv = *(const f16x8*)yp;
                    f32x4 y0, y1;
#pragma unroll
                    for (int e = 0; e < 4; ++e) { y0[e] = ((float)yv[e] - mean) * rstd; y1[e] = ((float)yv[4 + e] - mean) * rstd; }
                    const f16x8 h = pack8(y0 * gg[bj][0] + bb[bj][0] + acc[ai][bj][m][0], y1 * gg[bj][1] + bb[bj][1] + acc[ai][bj][m][1]);
                    *(f16x8*)yp = h; stat_acc(h, s, q); }
                stat_store(sto, row, u.pn * 4 + wc, s, q, fq); }
    } };
template <class Epi>
DEVFN void gemm_phase(const half_t* A, const half_t* Bt, int M, int N, int K, const Epi& epi, char* lds, int bid, int nb) {
    pg8::Gemm g{A, Bt, M, N, K}; pg8::StaticOrder S; S.init(M, N, nb, bid);
    pg8::gemm_phase<Epi, true>((PG8_LAS unsigned char*)lds, g, S, epi);
}

DEVFN void phase_final_ln(const Params& P, const float* st, const float* g, const float* b, int bid, int nb) {
    const half_t* Y = (const half_t*)(P.ws + OFF_Y);
    const int lane = tid_opaque() & 63, gw = bid * (NTHREADS / 64) + (tid_opaque() >> 6), ngw = nb * (NTHREADS / 64);
    for (int r = gw; r < MX; r += ngw) {
        float s = st[(size_t)r * 32 + (lane & 15) * 2], q = st[(size_t)r * 32 + (lane & 15) * 2 + 1];
#pragma unroll
        for (int o = 1; o < 16; o <<= 1) { s += __shfl_xor(s, o); q += __shfl_xor(q, o); }
        const float mean = s * (1.f / D), rstd = 1.0f / sqrtf(fmaxf(q * (1.f / D) - mean * mean, 0.f) + LN_EPS);
#pragma unroll
        for (int j = 0; j < 2; ++j) { const int c = lane * 8 + 512 * j; const f16x8 yv = *(const f16x8*)(Y + (size_t)r * D + c);
            f32x4 o0, o1;
#pragma unroll
            for (int e = 0; e < 4; ++e) { o0[e] = ((float)yv[e] - mean) * rstd; o1[e] = ((float)yv[4 + e] - mean) * rstd; }
            *(f32x4*)(P.out + (size_t)r * D + c) = o0 * *(const f32x4*)(g + c) + *(const f32x4*)(b + c);
            *(f32x4*)(P.out + (size_t)r * D + c + 4) = o1 * *(const f32x4*)(g + c + 4) + *(const f32x4*)(b + c + 4); }
    }
}

DEVFN int key_row(int b, int p) { return p < NMETA ? MX + p : b * SEQ + p - NMETA; }
constexpr int IDX_ROW = 2116;
DEVFN int half_sum_i(int v) {
#pragma unroll
    for (int o = 1; o < 32; o <<= 1) v += __shfl_xor(v, o);
    return v;
}
DEVFN void phase_indexer(const Params& P, char* lds, int bid, int nb) {
    float* sc = (float*)lds;
    const half_t* proj = (const half_t*)(P.ws + OFF_BIG);
    unsigned long long* maskt = (unsigned long long*)(P.ws + OFF_MASK);
    const int wid = __builtin_amdgcn_readfirstlane(tid_opaque() >> 6);
    for (int L = bid; L < NBATCH * (SEQ / 16); L += nb) {
        const int tid = tid_opaque(), lane = tid & 63, fr = lane & 15, quad = lane >> 4;
        const int i = (SEQ / 16 - 1) - (L >> 4), b = L & 15, s0 = 16 * i;
        if (s0 + 32 <= 256) {
            const int q = tid >> 5, s = s0 + q;
            for (int k = tid & 31; k < 33; k += 32) {
                unsigned long long bits;
                if (k == 0) bits = 0xFFFFull;
                else { const int base = 64 * (k - 1); bits = (s >= base + 63) ? ~0ull : (s < base ? 0ull : ((2ull << (s - base)) - 1ull)); }
                maskt[((size_t)b * 33 + k) * SEQ + s] = bits;
            }
            continue;
        }
        {
            const half_t* qrow = proj + (size_t)(b * SEQ + s0 + fr) * NPROJ;
            f16x8 bq[8][2];
#pragma unroll
            for (int h = 0; h < 8; ++h)
#pragma unroll
                for (int kh = 0; kh < 2; ++kh) bq[h][kh] = *(const f16x8*)(qrow + COL_QI + h * 64 + kh * 32 + quad * 8);
            float w[8]; { const f16x8 wv = *(const f16x8*)(qrow + COL_WI);
#pragma unroll
                for (int h = 0; h < 8; ++h) w[h] = (float)wv[h] * 0.04419417382415922f; }
            const int nblk = i + 2;
            int j = wid;
            const half_t* kp = proj + (size_t)(j == 0 ? MX + fr : b * SEQ + 16 * (j - 1) + fr) * NPROJ + COL_KI + quad * 8;
            f16x8 a0 = *(const f16x8*)kp, a1 = *(const f16x8*)(kp + 32);
            for (; j < nblk; j += 8) {
                const int jn = (j + 8 < nblk) ? j + 8 : j;
                const half_t* kn = proj + (size_t)(jn == 0 ? MX + fr : b * SEQ + 16 * (jn - 1) + fr) * NPROJ + COL_KI + quad * 8;
                const f16x8 n0 = *(const f16x8*)kn, n1 = *(const f16x8*)(kn + 32);
                f32x4 s4 = (f32x4){0.f, 0.f, 0.f, 0.f};
#pragma unroll
                for (int h = 0; h < 8; ++h) {
                    f32x4 acc = __builtin_amdgcn_mfma_f32_16x16x32_f16(a0, bq[h][0], (f32x4){0.f, 0.f, 0.f, 0.f}, 0, 0, 0);
                    acc = __builtin_amdgcn_mfma_f32_16x16x32_f16(a1, bq[h][1], acc, 0, 0, 0);
#pragma unroll
                    for (int e = 0; e < 4; ++e) s4[e] = fmaf(w[h], fmaxf(acc[e], 0.f), s4[e]);
                }
                s4 = s4 + 0.0f;
                const int slot = (j == 0 ? 0 : 64 + 16 * (j - 1)) + 4 * quad;
                *(f32x4*)(sc + fr * IDX_ROW + slot) = s4;
                a0 = n0; a1 = n1;
            }
        }
        __syncthreads();
#pragma unroll 1
        for (int qi2 = 0; qi2 < 2; ++qi2) {
            const int ln = tid_opaque() & 63, qq = 2 * wid + qi2, sq = s0 + qq;
            typedef __attribute__((address_space(3))) unsigned lds_u32;
            typedef unsigned u32x4 __attribute__((ext_vector_type(4)));
            lds_u32* hist = (lds_u32*)(__attribute__((address_space(3))) char*)lds + qq * IDX_ROW;
            const float* row = sc + qq * IDX_ROW;
            float v[33]; float vmin = INFINITY, vmax = -INFINITY;
#pragma unroll
            for (int j = 0; j < 33; ++j) { const int slot = 64 * j + ln; const bool valid = (slot < 16) | ((slot >= 64) & (slot - 64 <= sq));
                const float ld_ = row[slot];
                const float x = valid ? ld_ : -INFINITY; v[j] = x; vmax = fmaxf(vmax, x); vmin = fminf(vmin, valid ? x : INFINITY); }
#pragma unroll
            for (int o = 1; o < 64; o <<= 1) { vmin = fminf(vmin, __shfl_xor(vmin, o)); vmax = fmaxf(vmax, __shfl_xor(vmax, o)); }
#pragma unroll
            for (int k = 0; k < 8; ++k) *(__attribute__((address_space(3))) u32x4*)(hist + 256 * k + 4 * ln) = (u32x4){0u, 0u, 0u, 0u};
            const float range = vmax - vmin, scale = range > 0.f ? 2047.0f / range : 0.f;
            unsigned bins[17];
#pragma unroll
            for (int j = 0; j < 33; ++j) { const unsigned key = v[j] > -INFINITY ? 1u : 0u;
                int t_ = (int)(((key ? v[j] : vmin) - vmin) * scale); t_ = t_ > 2047 ? 2047 : t_;
                __hip_atomic_fetch_add(hist + (key ? t_ : 2048 + ln), 1u, __ATOMIC_RELAXED, __HIP_MEMORY_SCOPE_WORKGROUP);
                const unsigned bn1 = key ? (unsigned)t_ + 1u : 0u;
                if (j & 1) bins[j >> 1] |= bn1 << 16; else bins[j >> 1] = bn1;
                const unsigned u_ = __float_as_uint(v[j]); v[j] = __uint_as_float(u_ ^ (((unsigned)((int)u_ >> 31)) | 0x80000000u)); }
            unsigned tot = 0u;
#pragma unroll
            for (int k = 0; k < 8; ++k) { const u32x4 hq = *(const __attribute__((address_space(3))) u32x4*)(hist + 2016 - 32 * ln + 4 * k); tot += (hq[0] + hq[1]) + (hq[2] + hq[3]); }
            unsigned incl = tot;
#pragma unroll
            for (int o = 1; o < 64; o <<= 1) { const unsigned t_ = __shfl_up(incl, o); incl += ln >= o ? t_ : 0u; }
            const unsigned excl = incl - tot;
            int src = __ffsll((long long)__ballot((excl < 256u) & (256u <= incl))) - 1;
            const unsigned exclO = __shfl(excl, src);
            const int top = 2047 - 32 * src;
            const unsigned cb_ = hist[top - (ln & 31)], c1_ = ln < 32 ? cb_ : 0u;
            unsigned incl2 = c1_;
#pragma unroll
            for (int o = 1; o < 64; o <<= 1) { const unsigned t_ = __shfl_up(incl2, o); incl2 += ln >= o ? t_ : 0u; }
            const unsigned excl2 = incl2 - c1_ + exclO;
            src = __ffsll((long long)__ballot((excl2 < 256u) & (256u <= excl2 + c1_))) - 1;
            const int Bsel = top - src; const unsigned above = __shfl(excl2, src), cB = __shfl(c1_, src);
            const unsigned ub1 = (unsigned)Bsel + 1u;
            int rleft = (int)(256u - above);
            const unsigned allB = rleft >= (int)cB ? 1u : 0u;
            rleft = allB ? 0 : rleft;
            unsigned selm0 = 0u, selm1 = 0u;
            while (rleft > 0) {
                unsigned bk = 0u, bp = 0u;
#pragma unroll
                for (int j = 0; j < 33; ++j) { const unsigned bn1 = (j & 1) ? (bins[j >> 1] >> 16) : (bins[j >> 1] & 0xFFFFu);
                    const unsigned sm = j < 32 ? selm0 : selm1;
                    const unsigned k2 = (bn1 << 1) | ((sm >> (j & 31)) & 1u);
                    const unsigned kk = k2 == (ub1 << 1) ? __float_as_uint(v[j]) : 0u;
                    bp = kk > bk ? (unsigned)j : bp; bk = kk > bk ? kk : bk; }
                bp = (bp << 6) + (unsigned)ln;
                unsigned long long best = ((unsigned long long)bk << 32) | (0xFFFFFFFFu - bp);
#pragma unroll
                for (int o = 1; o < 64; o <<= 1) { const unsigned long long ot = __shfl_xor(best, o); best = ot > best ? ot : best; }
                const unsigned wp = 0xFFFFFFFFu - (unsigned)best, wj = wp >> 6;
                const unsigned bit = (((wp & 63u) == (unsigned)ln) & ((unsigned)(best >> 32) != 0u)) ? (1u << (wj & 31u)) : 0u;
                selm0 |= wj < 32u ? bit : 0u; selm1 |= wj >= 32u ? bit : 0u;
                rleft -= 1;
            }
            unsigned long long myw = 0ull;
            const unsigned thr2 = (ub1 << 1) | 1u;
#pragma unroll
            for (int j = 0; j < 33; ++j) { const unsigned bn1 = (j & 1) ? (bins[j >> 1] >> 16) : (bins[j >> 1] & 0xFFFFu);
                const unsigned sm = j < 32 ? selm0 : selm1;
                const unsigned k2 = (bn1 << 1) | allB | ((sm >> (j & 31)) & 1u);
                const unsigned long long sb = __ballot(k2 >= thr2);
                myw = ln == j ? sb : myw; }
            if (ln < 33) maskt[((size_t)b * 33 + ln) * SEQ + sq] = myw;
        }
        __syncthreads();
    }
}

DEVFN int t5_bucket(int d) {
    if (d < 16) return d;
    const int bd[15] = {19, 21, 24, 27, 31, 35, 40, 46, 52, 59, 67, 77, 87, 99, 113};
    int b = 16;
#pragma unroll
    for (int i = 0; i < 15; ++i) b += (d >= bd[i]) ? 1 : 0;
    return b;
}
constexpr float LOG2E = 1.4426950408889634f;
constexpr float QSCALE = 0.125f * LOG2E;
typedef float f32x16 __attribute__((ext_vector_type(16)));
#define ATT_LAS __attribute__((address_space(3)))
constexpr int ATT_K = 0, ATT_V = 16384, ATT_DL = 32768, ATT_LDS = 32768 + 1024;
DEVFN void attn_unit(const Params& P, char* lds, int b, int h, int qb) {
    const int tid = tid_opaque(), lane = tid & 63, wid = __builtin_amdgcn_readfirstlane(tid >> 6), r32 = lane & 31, hi = lane >> 5;
    const half_t* proj = (const half_t*)(P.ws + OFF_BIG);
    const half_t* VT = (const half_t*)P.out; const half_t* VTM = VT + VT_ELEMS;
    const unsigned long long* maskt = (const unsigned long long*)(P.ws + OFF_MASK) + (size_t)b * 33 * SEQ;
    ATT_LAS char* L = (ATT_LAS char*)lds;
    float* dl = (float*)(lds + ATT_DL);
    const int sq = 256 * qb + 32 * wid + r32;
    const int NT = 4 * qb + 5;
    if (tid < 129) dl[tid] = tid < 128 ? (P.rel_bias[t5_bucket(tid) * 16 + h] - P.rel_bias[31 * 16 + h]) * LOG2E : 0.f;
    f16x8 qf[4];
#pragma unroll
    for (int d0 = 0; d0 < 4; ++d0) qf[d0] = *(const f16x8*)(proj + ((size_t)b * SEQ + sq) * NPROJ + h * 64 + 16 * d0 + 8 * hi);
    const int drow = wid * 8 + (lane >> 3), dch = (lane & 7) ^ ((lane >> 3) & 7);
    const half_t* ksrc_m = proj + (size_t)(MX + drow) * NPROJ + COL_K + h * 64 + dch * 8;
    const half_t* ksrc_x = proj + ((size_t)b * SEQ + drow) * NPROJ + COL_K + h * 64 + dch * 8;
    const half_t* vsrc_m = VTM + (size_t)(h * 64 + drow) * 256 + dch * 8;
    const half_t* vsrc_x = VT + ((size_t)(b * 16 + h) * 64 + drow) * SEQ + dch * 8;
#define ATT_DMA(tt, slot) do { const half_t* ks_ = (tt) == 0 ? ksrc_m : ksrc_x + (size_t)((tt) - 1) * 64 * NPROJ; const half_t* vs_ = (tt) == 0 ? vsrc_m : vsrc_x + ((tt) - 1) * 64; \
        __builtin_amdgcn_global_load_lds((const unsigned*)ks_, (ATT_LAS unsigned*)(L + ATT_K + (slot) * 8192 + wid * 1024), 16, 0, 0); \
        __builtin_amdgcn_global_load_lds((const unsigned*)vs_, (ATT_LAS unsigned*)(L + ATT_V + (slot) * 8192 + wid * 1024), 16, 0, 0); } while (0)
    int foff[8];
#pragma unroll
    for (int c = 0; c < 8; ++c) foff[c] = r32 * 128 + (((c) ^ (r32 & 7)) * 16);
    float m = -1e30f, l = 0.f;
    f32x16 o0, o1;
#pragma unroll
    for (int r = 0; r < 16; ++r) { o0[r] = 0.f; o1[r] = 0.f; }
    ATT_DMA(0, 0);
    unsigned long long mw_next = maskt[sq];
    asm volatile("s_waitcnt vmcnt(0)" ::: "memory");
    __syncthreads();
    for (int tt = 0; tt < NT; ++tt) {
        const int cur = tt & 1;
        const unsigned long long mw = mw_next;
        if (tt + 1 < NT) { ATT_DMA(tt + 1, cur ^ 1); mw_next = maskt[(size_t)(tt + 1) * SEQ + sq]; }
        const int kbase = tt == 0 ? 0 : 64 * (tt - 1);
        const bool active = tt == 0 || kbase <= 256 * qb + 32 * wid + 31;
        if (active) {
            f32x16 c0, c1;
#pragma unroll
            for (int r = 0; r < 16; ++r) { c0[r] = 0.f; c1[r] = 0.f; }
            const ATT_LAS char* kb = L + ATT_K + cur * 8192;
#pragma unroll
            for (int d0 = 0; d0 < 4; ++d0) {
                const f16x8 k0 = *(const ATT_LAS f16x8*)(kb + foff[2 * d0 + hi]);
                const f16x8 k1 = *(const ATT_LAS f16x8*)(kb + 4096 + foff[2 * d0 + hi]);
                c0 = __builtin_amdgcn_mfma_f32_32x32x16_f16(k0, qf[d0], c0, 0, 0, 0);
                c1 = __builtin_amdgcn_mfma_f32_32x32x16_f16(k1, qf[d0], c1, 0, 0, 0);
            }
            const int dist0 = tt == 0 ? sq + 16 - 4 * hi : sq - kbase - 4 * hi;
            const bool nearb = tt == 0 ? (256 * qb + 32 * wid + 16 - 15 < 128) : (256 * qb + 32 * wid - (kbase + 63) < 128);
            if (nearb) {
#pragma unroll
                for (int r = 0; r < 16; ++r) { const int kk = (r & 3) + 8 * (r >> 2);
                    int d0_ = dist0 - kk, d1_ = dist0 - kk - 32; d0_ = d0_ < 0 ? 0 : (d0_ > 128 ? 128 : d0_); d1_ = d1_ < 0 ? 0 : (d1_ > 128 ? 128 : d1_);
                    c0[r] += dl[d0_]; c1[r] += dl[d1_]; }
            }
            const unsigned mlo = (unsigned)mw >> (4 * hi), mhi = (unsigned)(mw >> 32) >> (4 * hi);
            float tmax = -INFINITY;
#pragma unroll
            for (int r = 0; r < 16; ++r) { const int cb = (r & 3) + 8 * (r >> 2);
                c0[r] = ((mlo >> cb) & 1u) ? c0[r] : -INFINITY; c1[r] = ((mhi >> cb) & 1u) ? c1[r] : -INFINITY;
                tmax = fmaxf(tmax, fmaxf(c0[r], c1[r])); }
            tmax = fmaxf(tmax, __shfl_xor(tmax, 32));
            const float mn = fmaxf(m, tmax), alpha = __builtin_amdgcn_exp2f(m - mn);
            m = mn;
            float ls = 0.f;
#pragma unroll
            for (int r = 0; r < 16; ++r) { c0[r] = __builtin_amdgcn_exp2f(c0[r] - mn); c1[r] = __builtin_amdgcn_exp2f(c1[r] - mn); ls += c0[r] + c1[r]; }
            l = l * alpha + ls;
            if (!__all(alpha == 1.0f)) {
#pragma unroll
                for (int r = 0; r < 16; ++r) { o0[r] *= alpha; o1[r] *= alpha; }
            }
            const ATT_LAS char* vb = L + ATT_V + cur * 8192;
#pragma unroll
            for (int s = 0; s < 4; ++s) {
                f16x8 pf;
#pragma unroll
                for (int jj = 0; jj < 8; ++jj) pf[jj] = (half_t)((s < 2) ? c0[8 * (s & 1) + jj] : c1[8 * (s & 1) + jj]);
                const f16x8 v0 = *(const ATT_LAS f16x8*)(vb + foff[2 * s + hi]);
                const f16x8 v1 = *(const ATT_LAS f16x8*)(vb + 4096 + foff[2 * s + hi]);
                o0 = __builtin_amdgcn_mfma_f32_32x32x16_f16(v0, pf, o0, 0, 0, 0);
                o1 = __builtin_amdgcn_mfma_f32_32x32x16_f16(v1, pf, o1, 0, 0, 0);
            }
        }
        asm volatile("s_waitcnt vmcnt(0)" ::: "memory");
        __syncthreads();
    }
#undef ATT_DMA
    l += __shfl_xor(l, 32);
    const float il = 1.0f / l;
    half_t* orow = (half_t*)(P.ws + OFF_HA) + ((size_t)b * SEQ + sq) * D + h * 64;
#pragma unroll
    for (int g = 0; g < 4; ++g) { f16x4 a, c;
#pragma unroll
        for (int e = 0; e < 4; ++e) { a[e] = (half_t)(o0[4 * g + e] * il); c[e] = (half_t)(o1[4 * g + e] * il); }
        *(f16x4*)(orow + 8 * g + 4 * hi) = a; *(f16x4*)(orow + 32 + 8 * g + 4 * hi) = c; }
}
DEVFN void attn_meta_rows(const Params& P, int bid, int nb) {
    const half_t* proj = (const half_t*)(P.ws + OFF_BIG); half_t* AO = (half_t*)(P.ws + OFF_HA);
    const int tid = tid_opaque() & 255, sub = tid_opaque() >> 8, head = tid >> 4;
    for (int mrow = 2 * bid + sub; mrow < NMETA; mrow += 2 * nb) {
        const int r = MX + mrow;
        float q[4]; { const f16x4 qv = *(const f16x4*)(proj + (size_t)r * NPROJ + tid * 4); q[0] = (float)qv[0]; q[1] = (float)qv[1]; q[2] = (float)qv[2]; q[3] = (float)qv[3]; }
        float m = -1e30f, l = 0.f, o[4] = {0.f, 0.f, 0.f, 0.f};
        for (int p = 0; p <= mrow; ++p) {
            const half_t* kr = proj + (size_t)(MX + p) * NPROJ + tid * 4;
            const f16x4 kv = *(const f16x4*)(kr + COL_K), vv = *(const f16x4*)(kr + COL_V);
            float d = q[0] * (float)kv[0] + q[1] * (float)kv[1] + q[2] * (float)kv[2] + q[3] * (float)kv[3];
            d += __shfl_xor(d, 1); d += __shfl_xor(d, 2); d += __shfl_xor(d, 4); d += __shfl_xor(d, 8);
            const float s = d + P.rel_bias[t5_bucket(mrow - p) * 16 + head] * LOG2E;
            const float mn = fmaxf(m, s), corr = __builtin_amdgcn_exp2f(m - mn), pe = __builtin_amdgcn_exp2f(s - mn);
            l = l * corr + pe;
#pragma unroll
            for (int c = 0; c < 4; ++c) o[c] = o[c] * corr + pe * (float)vv[c];
            m = mn;
        }
        const float il = 1.0f / l; f16x4 hh; hh[0] = (half_t)(o[0] * il); hh[1] = (half_t)(o[1] * il); hh[2] = (half_t)(o[2] * il); hh[3] = (half_t)(o[3] * il);
        *(f16x4*)(AO + (size_t)r * D + tid * 4) = hh;
    }
}
DEVFN void phase_attn(const Params& P, char* lds, int bid, int nb) {
    attn_meta_rows(P, bid, nb);
    for (int bh = bid; bh < NBATCH * 16; bh += nb)
        for (int qb = 7; qb >= 0; --qb) attn_unit(P, lds, bh >> 4, bh & 15, qb);
}

typedef float f32x2 __attribute__((ext_vector_type(2)));
DEVFN void phase_conv(const Params& P, char* lds, int bid, int nb) {
    const half_t* U = (const half_t*)(P.ws + OFF_BIG); half_t* C = (half_t*)(P.ws + OFF_C);
    const int tid = tid_opaque(), lane = tid & 63, wid = __builtin_amdgcn_readfirstlane(tid >> 6);
    const int c0 = 128 * wid + 2 * lane;
    float* ys = (float*)lds;
    f32x2 w[31];
#pragma unroll
    for (int k = 0; k < 31; ++k) w[k] = *(const f32x2*)(P.w_dw + (size_t)k * D + c0);
    const f32x2 bias = *(const f32x2*)(P.b_dw + c0);
    for (int unit = bid; unit < NBATCH * (SEQ / 32); unit += nb) {
        const int b = unit >> 6, sbase = 32 * (unit & 63);
        f32x2 uw[62];
#pragma unroll
        for (int wi = 0; wi < 62; ++wi) { const int sx = sbase - 30 + wi;
            const int row = sx >= 0 ? b * SEQ + sx : MX + (sx + 16 >= 0 ? sx + 16 : 0);
            const f16x2 ld_ = *(const f16x2*)(U + (size_t)row * D + c0);
            uw[wi] = sx + 16 >= 0 ? (f32x2){(float)ld_[0], (float)ld_[1]} : (f32x2){0.f, 0.f}; }
#pragma unroll
        for (int i = 0; i < 32; ++i) { f32x2 a = bias;
#pragma unroll
            for (int k = 0; k < 31; ++k) a = w[k] * uw[i + k] + a;
            *(f32x2*)(ys + i * D + c0) = a; }
        __syncthreads();
#pragma unroll 1
        for (int tt = 0; tt < 4; ++tt) { const int i = 4 * wid + tt;
            f32x4 y[4]; float s = 0.f;
#pragma unroll
            for (int q = 0; q < 4; ++q) { y[q] = *(const f32x4*)(ys + i * D + 4 * lane + 256 * q); s += (y[q][0] + y[q][1]) + (y[q][2] + y[q][3]); }
            const float mean = wave_sum(s) * (1.f / D); float qv = 0.f;
#pragma unroll
            for (int q = 0; q < 4; ++q) { y[q] = y[q] - mean; qv += (y[q][0] * y[q][0] + y[q][1] * y[q][1]) + (y[q][2] * y[q][2] + y[q][3] * y[q][3]); }
            const float rstd = 1.0f / sqrtf(wave_sum(qv) * (1.f / D) + LN_EPS);
            half_t* orow = C + ((size_t)b * SEQ + sbase + i) * D + 4 * lane;
#pragma unroll
            for (int q = 0; q < 4; ++q) { const f32x4 z = y[q] * rstd * *(const f32x4*)(P.cln_g + 4 * lane + 256 * q) + *(const f32x4*)(P.cln_b + 4 * lane + 256 * q); const f32x4 o = silu4(z);
                f16x4 h; h[0] = (half_t)o[0]; h[1] = (half_t)o[1]; h[2] = (half_t)o[2]; h[3] = (half_t)o[3];
                *(f16x4*)(orow + 256 * q) = h; }
        }
        __syncthreads();
    }
}

#define XB_TMO      128
#define XB_XCNT(j)  (256  + 64 * (j))
#define XB_XSUB(j)  (1280 + 64 * (j))
#define XB_XGEN(j)  (2304 + 64 * (j))
#define XB_TOP      3328
#define XB_TOPGEN   3392
#define XCD_BAR_WORDS 3456
#define XB_SPIN_CAP (1u << 18)
#define XB_LAS __attribute__((address_space(3)))
__device__ __forceinline__ unsigned xb_ld(unsigned* p)              { return __hip_atomic_load(p, __ATOMIC_RELAXED, __HIP_MEMORY_SCOPE_AGENT); }
__device__ __forceinline__ unsigned xb_add(unsigned* p, unsigned v) { return __hip_atomic_fetch_add(p, v, __ATOMIC_RELAXED, __HIP_MEMORY_SCOPE_AGENT); }
__device__ __forceinline__ unsigned xb_xcc_id() { return (unsigned)__builtin_amdgcn_s_getreg((3 << 11) | 20) & 0xFu; }
#define XB_SPIN(cond, bar) do { unsigned _sp = 0; while (cond) { __builtin_amdgcn_s_sleep(1); \
    if ((++_sp & 255u) == 0u) { if (xb_ld(&(bar)[XB_TMO])) break; if (_sp > XB_SPIN_CAP) { atomicAdd(&(bar)[XB_TMO], 1u); break; } } } } while (0)
struct XcdBarrier { unsigned* bar; unsigned x; volatile XB_LAS unsigned* st; };
__device__ __forceinline__ XcdBarrier xcd_barrier_post(unsigned* bar, volatile XB_LAS unsigned* st) {
    XcdBarrier b; b.bar = bar; b.x = xb_xcc_id(); b.st = st;
    if (threadIdx.x == 0) (void)xb_add(&bar[XB_XCNT(b.x)], 1u);
    return b;
}
__device__ __forceinline__ void xcd_barrier_complete(unsigned* bar, unsigned x, unsigned& nloc, unsigned& nx) {
    const unsigned G = gridDim.x * gridDim.y * gridDim.z;
    unsigned sum, cnt, mine, sp = 0u;
    for (;;) {
        sum = 0u; cnt = 0u; mine = 0u;
#pragma unroll
        for (unsigned j = 0; j < 16; ++j) { const unsigned c = xb_ld(&bar[XB_XCNT(j)]); sum += c; cnt += (c > 0u) ? 1u : 0u; mine = (j == x) ? c : mine; }
        if (sum == G) break;
        __builtin_amdgcn_s_sleep(1);
        if ((++sp & 255u) == 0u) { if (xb_ld(&bar[XB_TMO])) break; if (sp > XB_SPIN_CAP) { atomicAdd(&bar[XB_TMO], 1u); break; } }
    }
    nloc = mine > 0u ? mine : 1u; nx = cnt > 0u ? cnt : 1u;
}
__device__ __forceinline__ void xcd_barrier(const XcdBarrier& b) {
    asm volatile("s_waitcnt vmcnt(0)" ::: "memory");
    __syncthreads();
    if (threadIdx.x == 0) {
        unsigned* bar = b.bar;
        __builtin_amdgcn_s_waitcnt(0);
        unsigned nloc = b.st[0], nx = b.st[1];
        if (nloc == 0u) { xcd_barrier_complete(bar, b.x, nloc, nx); b.st[0] = nloc; b.st[1] = nx; }
        const unsigned old = xb_add(&bar[XB_XSUB(b.x)], 1u);
        const unsigned gen = old / nloc;
        if (old + 1u == (gen + 1u) * nloc) {
            __builtin_amdgcn_fence(__ATOMIC_RELEASE, "agent");
            asm volatile("s_waitcnt vmcnt(0)" ::: "memory");
            const unsigned og = xb_add(&bar[XB_TOP], 1u);
            const unsigned tg = og / nx;
            if (og + 1u == (tg + 1u) * nx) xb_add(&bar[XB_TOPGEN], 1u);
            else XB_SPIN(xb_ld(&bar[XB_TOPGEN]) == tg, bar);
            __builtin_amdgcn_fence(__ATOMIC_ACQUIRE, "agent");
            xb_add(&bar[XB_XGEN(b.x)], 1u);
            asm volatile("s_waitcnt vmcnt(0)" ::: "memory");
        } else {
            XB_SPIN(xb_ld(&bar[XB_XGEN(b.x)]) == gen, bar);
            __builtin_amdgcn_fence(__ATOMIC_ACQUIRE, "agent");
            asm volatile("s_waitcnt vmcnt(0)" ::: "memory");
        }
    }
    __syncthreads();
}
constexpr int MISC_OFF = 147456 - 16;

constexpr int N_PHASES = 13;
constexpr int LDS_BYTES = 147456;
static_assert(pg8::STAGE_BYTES == 131072, "LDS");

DEVFN void run_phase(const Params& P, int ph, char* lds, int bid, int nb) {
    unsigned char* ws = P.ws;
    half_t* HA = (half_t*)(ws + OFF_HA); half_t* BIG = (half_t*)(ws + OFF_BIG); half_t* CB = (half_t*)(ws + OFF_C); half_t* Y = (half_t*)(ws + OFF_Y);
    float* ST0 = (float*)(ws + OFF_ST0); float* ST1 = (float*)(ws + OFF_ST1); const float* C1 = (const float*)(ws + OFF_C1); const float* C2 = (const float*)(ws + OFF_C2);
    switch (ph) {
    case 0: phase_prep(P, lds, bid, nb); break;
    case 1: gemm_phase(HA, (const half_t*)(ws + OFF_W_IN), MP, NPROJ, D, EpiProj{BIG, NPROJ, (half_t*)P.out, (half_t*)P.out + VT_ELEMS}, lds, bid, nb); break;
    case 2: finish_colconsts(P, bid, nb); phase_indexer(P, lds, bid, nb); break;
    case 3: phase_attn(P, lds, bid, nb); break;
    case 4: gemm_phase(HA, (const half_t*)(ws + OFF_W_O), MP, D, D, EpiResidX{P.x, P.meta, Y, ST0}, lds, bid, nb); break;
    case 5: gemm_phase(Y, (const half_t*)(ws + OFF_W_GU0), MP, 2 * DFF, D, EpiLnSwiGLU{BIG, DFF, ST0, C1 + NC_GU0, C2 + NC_GU0, lds}, lds, bid, nb); break;
    case 6: gemm_phase(BIG, (const half_t*)(ws + OFF_W_D0), MP, D, DFF, EpiResidLN{Y, ST0, ST1, P.ln1_g, P.ln1_b, nullptr, lds}, lds, bid, nb); break;
    case 7: gemm_phase(Y, (const half_t*)(ws + OFF_W_PW1), MP, 2 * D, D, EpiLnGLU{BIG, D, ST1, C1 + NC_PW1, C2 + NC_PW1, lds}, lds, bid, nb); break;
    case 8: phase_conv(P, lds, bid, nb); break;
    case 9: gemm_phase(CB, (const half_t*)(ws + OFF_W_PW2), MX, D, D, EpiResidLN{Y, ST1, ST0, P.ln2_g, P.ln2_b, P.b_pw2, lds}, lds, bid, nb); break;
    case 10: gemm_phase(Y, (const half_t*)(ws + OFF_W_GU1), MX, 2 * DFF, D, EpiLnSwiGLU{BIG, DFF, ST0, C1 + NC_GU1, C2 + NC_GU1, lds}, lds, bid, nb); break;
    case 11: gemm_phase(BIG, (const half_t*)(ws + OFF_W_D1), MX, D, DFF, EpiResidLN{Y, ST0, ST1, P.ln1_g + D, P.ln1_b + D, nullptr, lds}, lds, bid, nb); break;
    case 12: phase_final_ln(P, ST1, P.ln2_g + D, P.ln2_b + D, bid, nb); break;
    default: break;
    }
}

#if MODE_COOP
__global__ void __launch_bounds__(NTHREADS, 2) fwd_mega(Params P) {
    extern __shared__ __attribute__((aligned(16))) char lds[];
    cg::grid_group grid = cg::this_grid();
    volatile XB_LAS unsigned* misc = (volatile XB_LAS unsigned*)((XB_LAS char*)lds + MISC_OFF);
    if (threadIdx.x < 4) misc[threadIdx.x] = 0u;
    __syncthreads();
    const XcdBarrier bar = xcd_barrier_post((unsigned*)(P.ws + OFF_CTL), misc);
#define PHASE(k) run_phase(P, k, lds, blockIdx.x, gridDim.x)
#define SEAM() xcd_barrier(bar)
    PHASE(0); grid.sync();
    PHASE(1); SEAM(); PHASE(2); SEAM(); PHASE(3); SEAM(); PHASE(4); SEAM(); PHASE(5); SEAM(); PHASE(6); SEAM(); PHASE(7); SEAM();
    PHASE(8); SEAM(); PHASE(9); SEAM(); PHASE(10); SEAM(); PHASE(11); SEAM(); PHASE(12);
#undef PHASE
#undef SEAM
}
#else
template <int PH> __global__ void __launch_bounds__(NTHREADS, 2) fwd_phase(Params P) {
    extern __shared__ __attribute__((aligned(16))) char lds[];
    run_phase(P, PH, lds, blockIdx.x, gridDim.x);
}
template <int PH> static void launch_phases(const Params& p, hipStream_t stream) {
    hipFuncSetAttribute((const void*)fwd_phase<PH>, hipFuncAttributeMaxDynamicSharedMemorySize, LDS_BYTES);
    hipLaunchKernelGGL(fwd_phase<PH>, dim3(256), dim3(NTHREADS), LDS_BYTES, stream, p);
    if constexpr (PH + 1 < N_PHASES) launch_phases<PH + 1>(p, stream);
}
#endif

extern "C" void kernel_launch(void* const* d_in, const int* in_sizes, int n_in, void* d_out, int out_size, void* d_ws, size_t ws_size, hipStream_t stream) {
    if (n_in != 20 || ws_size < WS_END || out_size != MX * D) { fprintf(stderr, "kernel_launch: unexpected sizes n_in %d ws %zu out %d\n", n_in, ws_size, out_size); return; }
    Params p{};
    const float** pp = (const float**)&p;
    for (int i = 0; i < 20; ++i) pp[i] = (const float*)d_in[i];
    p.out = (float*)d_out; p.ws = (unsigned char*)d_ws;
#if MODE_COOP
    static int grid_blocks = 0;
    if (!grid_blocks) {
        int dev = 0, cus = 0, per_cu = 0;
        hipGetDevice(&dev); hipDeviceGetAttribute(&cus, hipDeviceAttributeMultiprocessorCount, dev);
        hipFuncSetAttribute((const void*)fwd_mega, hipFuncAttributeMaxDynamicSharedMemorySize, LDS_BYTES);
        hipOccupancyMaxActiveBlocksPerMultiprocessor(&per_cu, fwd_mega, NTHREADS, LDS_BYTES);
        if (per_cu < 1) per_cu = 1;
        grid_blocks = cus * per_cu;
    }
    hipMemsetAsync((char*)d_ws + OFF_CTL, 0, XCD_BAR_WORDS * 4, stream);
    void* args[] = {&p};
    hipError_t e = hipLaunchCooperativeKernel((void*)fwd_mega, dim3(grid_blocks), dim3(NTHREADS), args, LDS_BYTES, stream);
    if (e != hipSuccess) fprintf(stderr, "cooperative launch failed: %s (grid %d)\n", hipGetErrorString(e), grid_blocks);
#else
    launch_phases<0>(p, stream);
#endif
}
```

```cpp
#include <hip/hip_runtime.h>
#include <hip/hip_cooperative_groups.h>
#include <cstdio>
#include <cstdint>
namespace cg = cooperative_groups;

#ifndef MODE_COOP
#define MODE_COOP 1
#endif

#define DEVFN __device__ __forceinline__
typedef _Float16 half_t;
typedef _Float16 f16x8 __attribute__((ext_vector_type(8)));
typedef _Float16 f16x4 __attribute__((ext_vector_type(4)));
typedef _Float16 f16x2 __attribute__((ext_vector_type(2)));
typedef float f32x4 __attribute__((ext_vector_type(4)));

constexpr int D = 1024, NBATCH = 16, SEQ = 2048, NMETA = 16;
constexpr int MX = NBATCH * SEQ;
constexpr int MV = MX + NMETA;
constexpr int MP = 33024;
constexpr int NPROJ = 3840, NPROJ_VALID = 3656;
constexpr int DFF = 2816;
constexpr int COL_K = 1024, COL_V = 2048, COL_QI = 3072, COL_KI = 3584, COL_WI = 3648;
constexpr int MASK_W64 = 33;
constexpr float ALPHA = 1.41421356237309515f;
constexpr float LN_EPS = 1e-5f;
constexpr int NTHREADS = 512;
constexpr size_t VT_ELEMS = (size_t)NBATCH * 16 * 64 * SEQ;

constexpr size_t MiB = 1u << 20;
constexpr size_t OFF_W_IN = 0, OFF_W_O = 8 * MiB, OFF_W_GU0 = 10 * MiB, OFF_W_GU1 = 21 * MiB, OFF_W_D0 = 32 * MiB, OFF_W_D1 = 38 * MiB,
                 OFF_W_PW1 = 44 * MiB, OFF_W_PW2 = 48 * MiB, OFF_MASK = 50 * MiB, OFF_Y = 60 * MiB, OFF_ST0 = 126 * MiB, OFF_ST1 = 131 * MiB,
                 OFF_CP1 = 136 * MiB, OFF_CP2 = 138 * MiB, OFF_C1 = 140 * MiB, OFF_C2 = 140 * MiB + 65536, OFF_CTL = 141 * MiB, OFF_HA = 190 * MiB, OFF_BIG = 256 * MiB,
                 OFF_C = OFF_BIG + 65 * MiB, WS_END = OFF_BIG + 242 * MiB;
constexpr int NC_GU0 = 0, NC_GU1 = 2 * DFF, NC_PW1 = 4 * DFF, NC_TOTAL = 4 * DFF + 2 * D;
static_assert((size_t)MP * 16 * 8 <= 5 * MiB && (size_t)32 * NC_TOTAL * 4 <= 2 * MiB && (size_t)NC_TOTAL * 4 <= 65536, "stats");
static_assert((size_t)NPROJ * D * 2 <= 8 * MiB && (size_t)2 * DFF * D * 2 <= 11 * MiB && (size_t)DFF * D * 2 <= 6 * MiB, "weights");
static_assert((size_t)MP * MASK_W64 * 8 <= 10 * MiB && (size_t)MP * D * 2 <= 65 * MiB && (size_t)MP * NPROJ * 2 <= 242 * MiB, "acts");

struct Params {
    const float *x, *meta, *rel_bias, *w_in, *w_o, *w_pw1, *b_pw1, *w_dw, *b_dw, *cln_g, *cln_b, *w_pw2, *b_pw2, *ln1_g, *ln1_b, *wg, *wu, *wd, *ln2_g, *ln2_b;
    float* out; unsigned char* ws;
};

DEVFN int tid_opaque() { int t = threadIdx.x; asm volatile("" : "+v"(t)); return t; }
DEVFN float wave_sum(float v) {
#pragma unroll
    for (int o = 1; o < 64; o <<= 1) v += __shfl_xor(v, o);
    return v;
}
DEVFN float sigmoidf_(float x) { return __builtin_amdgcn_rcpf(1.0f + __builtin_amdgcn_exp2f(x * -1.4426950408889634f)); }

DEVFN void prep_item(const float* srcA, const float* srcB, int ld, int K, int Nsrc, int mode, half_t* dst, int item, float* scr  , int qrows,
                     const float* lng, const float* lnb, float* cp1, float* cp2, int lane) {
    const int nkb = K / 64, tn = item / nkb, kb = item % nkb, n0 = tn * 32, k0 = kb * 64;
    float* scr2 = scr + 64 * 33;
    { const int n = n0 + (lane & 31); const bool ok = mode == 1 || n < Nsrc;
      const float* colp = mode == 1 ? (((n >> 7) & 1) ? srcB : srcA) + ((n >> 8) * 128 + (n & 127)) : srcA + (ok ? n : 0);
      const float sc_ = !ok ? 0.f : (n < qrows ? 0.18033688011112042f : 1.f);
      float vv[32];
#pragma unroll
      for (int i = 0; i < 32; ++i) vv[i] = colp[(size_t)(k0 + 2 * i + (lane >> 5)) * ld];
#pragma unroll
      for (int i = 0; i < 32; ++i) { const int kk = 2 * i + (lane >> 5); float v = vv[i] * sc_;
          if (lng) { scr2[kk * 33 + (lane & 31)] = v * lnb[k0 + kk]; v *= lng[k0 + kk]; }
          scr[kk * 33 + (lane & 31)] = v; } }
    asm volatile("s_waitcnt lgkmcnt(0)" ::: "memory");
    { const int c = lane & 7;
#pragma unroll
      for (int j = 0; j < 4; ++j) { const int n = (lane >> 3) + 8 * j; const float* sp = scr + (8 * c) * 33 + n; f16x8 h;
#pragma unroll
          for (int e = 0; e < 8; ++e) h[e] = (half_t)sp[e * 33];
          *(f16x8*)(dst + (size_t)(n0 + n) * K + k0 + 8 * c) = h; } }
    if (lng && lane < 32) { float s1 = 0.f, s2 = 0.f;
#pragma unroll 8
        for (int k = 0; k < 64; ++k) { s1 += (float)(half_t)scr[k * 33 + lane]; s2 += scr2[k * 33 + lane]; }
        cp1[(size_t)kb * NC_TOTAL + n0 + lane] = s1; cp2[(size_t)kb * NC_TOTAL + n0 + lane] = s2; }
    asm volatile("s_waitcnt lgkmcnt(0)" ::: "memory");
}

DEVFN void phase_prep(const Params& P, char* lds, int bid, int nb) {
    unsigned char* ws = P.ws;
    float* cp1 = (float*)(ws + OFF_CP1); float* cp2 = (float*)(ws + OFF_CP2);
    const int lane = tid_opaque() & 63, wv = __builtin_amdgcn_readfirstlane(tid_opaque() >> 6), gw = bid * (NTHREADS / 64) + wv, ngw = nb * (NTHREADS / 64);
    float* scr = (float*)lds + wv * (2 * 64 * 33);
    constexpr int T_IN = (NPROJ / 32) * (D / 64), T_SQ = (D / 32) * (D / 64), T_GU = (2 * DFF / 32) * (D / 64), T_DN = (D / 32) * (DFF / 64), T_PW1 = (2 * D / 32) * (D / 64);
    constexpr int TOTAL = T_IN + T_SQ + 2 * T_GU + 2 * T_DN + T_PW1 + T_SQ;
    for (int it = gw; it < TOTAL; it += ngw) {
        int r = it;
        if (r < T_IN) { prep_item(P.w_in, nullptr, NPROJ_VALID, D, NPROJ_VALID, 0, (half_t*)(ws + OFF_W_IN), r, scr, D, nullptr, nullptr, nullptr, nullptr, lane); continue; } r -= T_IN;
        if (r < T_SQ) { prep_item(P.w_o, nullptr, D, D, D, 0, (half_t*)(ws + OFF_W_O), r, scr, 0, nullptr, nullptr, nullptr, nullptr, lane); continue; } r -= T_SQ;
        if (r < T_GU) { prep_item(P.wg, P.wu, DFF, D, DFF, 1, (half_t*)(ws + OFF_W_GU0), r, scr, 0, P.ln1_g, P.ln1_b, cp1 + NC_GU0, cp2 + NC_GU0, lane); continue; } r -= T_GU;
        if (r < T_GU) { prep_item(P.wg + (size_t)D * DFF, P.wu + (size_t)D * DFF, DFF, D, DFF, 1, (half_t*)(ws + OFF_W_GU1), r, scr, 0, P.ln1_g + D, P.ln1_b + D, cp1 + NC_GU1, cp2 + NC_GU1, lane); continue; } r -= T_GU;
        if (r < T_DN) { prep_item(P.wd, nullptr, D, DFF, D, 0, (half_t*)(ws + OFF_W_D0), r, scr, 0, nullptr, nullptr, nullptr, nullptr, lane); continue; } r -= T_DN;
        if (r < T_DN) { prep_item(P.wd + (size_t)DFF * D, nullptr, D, DFF, D, 0, (half_t*)(ws + OFF_W_D1), r, scr, 0, nullptr, nullptr, nullptr, nullptr, lane); continue; } r -= T_DN;
        if (r < T_PW1) { prep_item(P.w_pw1, P.w_pw1 + D, 2 * D, D, D, 1, (half_t*)(ws + OFF_W_PW1), r, scr, 0, P.ln2_g, P.ln2_b, cp1 + NC_PW1, cp2 + NC_PW1, lane); continue; } r -= T_PW1;
        prep_item(P.w_pw2, nullptr, D, D, D, 0, (half_t*)(ws + OFF_W_PW2), r, scr, 0, nullptr, nullptr, nullptr, nullptr, lane);
    }
    half_t* HA = (half_t*)(ws + OFF_HA);
    for (int r0 = gw; r0 < MP; r0 += 4 * ngw) {
        f32x4 v[4][4];
#pragma unroll
        for (int u = 0; u < 4; ++u) { const int r = r0 + u * ngw; const float* src = r < MX ? P.x + (size_t)r * D : (r < MV ? P.meta + (size_t)(r - MX) * D : P.meta);
#pragma unroll
            for (int j = 0; j < 4; ++j) v[u][j] = *(const f32x4*)(src + lane * 4 + 256 * j); }
#pragma unroll
        for (int u = 0; u < 4; ++u) { const int r = r0 + u * ngw; const float z = r < MV ? 1.f : 0.f;
            if (r < MP) {
#pragma unroll
                for (int j = 0; j < 4; ++j) { const f32x4 t = v[u][j] * z; f16x4 h; h[0] = (half_t)t[0]; h[1] = (half_t)t[1]; h[2] = (half_t)t[2]; h[3] = (half_t)t[3];
                    *(f16x4*)(HA + (size_t)r * D + lane * 4 + 256 * j) = h; } } }
    }
}
DEVFN void finish_colconsts(const Params& P, int bid, int nb) {
    const float* cp1 = (const float*)(P.ws + OFF_CP1); const float* cp2 = (const float*)(P.ws + OFF_CP2);
    float* c1 = (float*)(P.ws + OFF_C1); float* c2 = (float*)(P.ws + OFF_C2);
    for (int idx = bid * NTHREADS + tid_opaque(); idx < NC_TOTAL; idx += nb * NTHREADS) {
        float s1 = 0.f, s2 = 0.f;
        for (int tk = 0; tk < 16; ++tk) { s1 += cp1[(size_t)tk * NC_TOTAL + idx]; s2 += cp2[(size_t)tk * NC_TOTAL + idx]; }
        if (idx >= NC_PW1) { const int n = idx - NC_PW1; s2 += P.b_pw1[((n >> 7) & 1) * D + (n >> 8) * 128 + (n & 127)]; }
        c1[idx] = s1; c2[idx] = s2;
    }
}

namespace pg8 {
#define PG8_LAS __attribute__((address_space(3)))
constexpr int BM = 256, BK = 64, HALF = 128, HTB = HALF * BK * 2  , STAGE_BYTES = 8 * HTB, NXCD = 8, WGM = 8;
__host__ __device__ __forceinline__ int lds_byte(int r, int c) { const int st = (r >> 4) * 2 + (c >> 5), rr = r & 15, cc = c & 31, ob = rr * 64 + cc * 2; return st * 1024 + (ob ^ (((ob >> 9) & 1) << 5)); }
__host__ __device__ __forceinline__ void stage_rc(int b, int& R, int& C) { const int st = b / 1024, sb = b % 1024, swz = sb ^ (((sb >> 9) & 1) << 5); R = (st >> 1) * 16 + swz / 64; C = (st & 1) * 32 + (swz % 64) / 2; }
__host__ __device__ __forceinline__ int perm32(int rho) { const int n = rho >> 4, i = rho & 15; return 8 * (i >> 2) + 4 * n + (i & 3); }
struct Unit { int pm, pn; };
struct Gemm { const half_t* A; const half_t* Bt; int M, N, K; };
struct StaticOrder {
    int nM, nN, nwg, G, c;
    __host__ __device__ void init(int M, int N, int G_, int c_) { nM = M / BM; nN = N / BM; nwg = nM * nN; G = G_; c = c_; }
    __host__ __device__ bool next(int i, Unit& u) const {
        const long L = (long)i * G + c; if (L >= nwg) return false;
        int wgid = (int)L; { const int q = nwg / NXCD, r = nwg % NXCD, xcd = wgid % NXCD, off = wgid / NXCD; wgid = (xcd < r ? xcd * (q + 1) : r * (q + 1) + (xcd - r) * q) + off; }
        const int nig = WGM * nN, gid = wgid / nig, fm = gid * WGM, gsz = (nM - fm) < WGM ? (nM - fm) : WGM;
        u.pm = fm + ((wgid % nig) % gsz); u.pn = (wgid % nig) / gsz; return true;
    }
};
template <class Epi, bool ALIGN_EPI = true>
__device__ __forceinline__ void gemm_phase(PG8_LAS unsigned char* lds, const Gemm g, const StaticOrder& S, const Epi& E) {
    int tid = threadIdx.x; asm volatile("" : "+v"(tid));
    const int wid = __builtin_amdgcn_readfirstlane(tid >> 6), lane = tid & 63, wr = wid >> 2, wc = wid & 3, fr = lane & 15, fq = lane >> 4;
    const int K = g.K, nt = K / BK;
    unsigned voffA[2], voffB[2];
#pragma unroll
    for (int i = 0; i < 2; ++i) { int R, C; stage_rc(tid * 16 + i * 8192, R, C); const int Rb = (R & ~31) + perm32(R & 31);
        voffA[i] = (unsigned)(R * K + C) * 2u; voffB[i] = (unsigned)(Rb * K + C) * 2u; }
    const size_t kstep = (size_t)(BK * 2);
    const size_t hstep = (size_t)HALF * K * 2;
    const size_t tstep = 2 * hstep;
    const unsigned ldsw = (unsigned)wid * 1024u;
    const int aoff = lds_byte(wr * 64 + fr, fq * 8), boff = lds_byte(wc * 32 + fr, fq * 8);
#define PG8_SA(b, h) (((b) * 2 + (h)) * HTB)
#define PG8_SB(b, h) ((4 + (b) * 2 + (h)) * HTB)
#define PG8_STAGE(bufoff, gbase, voff) do { _Pragma("unroll") for (int _i = 0; _i < 2; ++_i) \
        __builtin_amdgcn_global_load_lds((const unsigned*)((const char*)(gbase) + (voff)[_i]), (PG8_LAS unsigned*)(lds + (bufoff) + ldsw + _i * 8192), 16, 0, 0); } while (0)
#define PG8_LDA(dst, b, h) do { _Pragma("unroll") for (int m = 0; m < 4; ++m) _Pragma("unroll") for (int k = 0; k < 2; ++k) dst[m][k] = *(const PG8_LAS f16x8*)(lds + PG8_SA(b, h) + aoff + m * 2048 + k * 1024); } while (0)
#define PG8_LDB(dst, b, h) do { _Pragma("unroll") for (int n = 0; n < 2; ++n) _Pragma("unroll") for (int k = 0; k < 2; ++k) dst[n][k] = *(const PG8_LAS f16x8*)(lds + PG8_SB(b, h) + boff + n * 2048 + k * 1024); } while (0)
#define PG8_MMA(ai, bj, At, Bt) do { __builtin_amdgcn_s_setprio(1); _Pragma("unroll") for (int m = 0; m < 4; ++m) _Pragma("unroll") for (int n = 0; n < 2; ++n) _Pragma("unroll") for (int k = 0; k < 2; ++k) \
        acc[ai][bj][m][n] = __builtin_amdgcn_mfma_f32_16x16x32_f16(Bt[n][k], At[m][k], acc[ai][bj][m][n], 0, 0, 0); __builtin_amdgcn_s_setprio(0); } while (0)
#define PG8_WAIT_V(n) asm volatile("s_waitcnt vmcnt(" #n ")" ::: "memory")
#define PG8_WAIT_L(n) asm volatile("s_waitcnt lgkmcnt(" #n ")" ::: "memory")
#define PG8_BAR __builtin_amdgcn_s_barrier()
#define PG8_SCHED __builtin_amdgcn_sched_barrier(0)
    Unit cur, nxt; int ui = 0;
    if (!S.next(0, cur)) return;
    f32x4 acc[2][2][4][2];
#pragma unroll
    for (int a = 0; a < 2; ++a)
#pragma unroll
        for (int b = 0; b < 2; ++b)
#pragma unroll
            for (int m = 0; m < 4; ++m)
#pragma unroll
                for (int n = 0; n < 2; ++n) acc[a][b][m][n] = (f32x4){0.f, 0.f, 0.f, 0.f};
    f16x8 At[4][2], B0[2][2], B1[2][2];
    const char* cA = (const char*)g.A + (size_t)cur.pm * tstep; const char* cB = (const char*)g.Bt + (size_t)cur.pn * tstep;
    E.prepare(cur, 0);
    PG8_STAGE(PG8_SB(0, 0), cB, voffB); PG8_STAGE(PG8_SB(0, 1), cB + hstep, voffB); PG8_STAGE(PG8_SA(0, 0), cA, voffA); PG8_STAGE(PG8_SA(0, 1), cA + hstep, voffA);
    if (wr == 1) PG8_BAR;
    PG8_WAIT_V(2); PG8_BAR;
    PG8_STAGE(PG8_SB(1, 0), cB + kstep, voffB); PG8_STAGE(PG8_SA(1, 0), cA + kstep, voffA); PG8_STAGE(PG8_SB(1, 1), cB + hstep + kstep, voffB);
    PG8_WAIT_V(6); PG8_BAR;
    for (;;) {
        const bool has_next = S.next(ui + 1, nxt);
        const char* nA = has_next ? (const char*)g.A + (size_t)nxt.pm * tstep : cA; const char* nB = has_next ? (const char*)g.Bt + (size_t)nxt.pn * tstep : cB;
        for (int t = 0; t < nt; t += 2) {
            const bool last = (t == nt - 2);
            const char* a1 = cA + (size_t)(t + 1) * kstep;
            const char* a2 = last ? nA : cA + (size_t)(t + 2) * kstep; const char* b2 = last ? nB : cB + (size_t)(t + 2) * kstep;
            const char* a3 = a2 + kstep; const char* b3 = b2 + kstep;
            if (last && has_next) E.prepare(nxt, (ui + 1) & 1);
            PG8_LDB(B0, 0, 0); PG8_LDB(B1, 0, 1); PG8_SCHED; PG8_LDA(At, 0, 0); PG8_STAGE(PG8_SA(1, 1), a1 + hstep, voffA);
            PG8_WAIT_V(8); PG8_WAIT_L(0); PG8_BAR; PG8_MMA(0, 0, At, B0); PG8_MMA(0, 1, At, B1); PG8_BAR; PG8_SCHED;
            PG8_LDA(At, 0, 1); PG8_STAGE(PG8_SB(0, 0), b2, voffB); PG8_STAGE(PG8_SB(0, 1), b2 + hstep, voffB); PG8_STAGE(PG8_SA(0, 0), a2, voffA);
            PG8_WAIT_V(8); PG8_WAIT_L(0); PG8_BAR; PG8_MMA(1, 0, At, B0); PG8_MMA(1, 1, At, B1); PG8_BAR; PG8_SCHED;
            PG8_LDB(B0, 1, 0); PG8_LDB(B1, 1, 1); PG8_SCHED; PG8_LDA(At, 1, 0); PG8_STAGE(PG8_SA(0, 1), a2 + hstep, voffA);
            PG8_WAIT_V(8); PG8_WAIT_L(0); PG8_BAR; PG8_MMA(0, 0, At, B0); PG8_MMA(0, 1, At, B1); PG8_BAR; PG8_SCHED;
            PG8_LDA(At, 1, 1); PG8_STAGE(PG8_SB(1, 0), b3, voffB); PG8_STAGE(PG8_SB(1, 1), b3 + hstep, voffB); PG8_STAGE(PG8_SA(1, 0), a3, voffA);
            PG8_WAIT_V(8); PG8_WAIT_L(0); PG8_BAR; PG8_MMA(1, 0, At, B0); PG8_MMA(1, 1, At, B1); PG8_BAR; PG8_SCHED;
        }
        if constexpr (ALIGN_EPI) { if (wr == 0) PG8_BAR; }
        E(acc, cur, ui & 1, wr, wc, fr, fq);
        if (!has_next) break;
#pragma unroll
        for (int a = 0; a < 2; ++a)
#pragma unroll
            for (int b = 0; b < 2; ++b)
#pragma unroll
                for (int m = 0; m < 4; ++m)
#pragma unroll
                    for (int n = 0; n < 2; ++n) acc[a][b][m][n] = (f32x4){0.f, 0.f, 0.f, 0.f};
        cur = nxt; cA = nA; cB = nB; ++ui;
        if constexpr (ALIGN_EPI) { if (wr == 1) PG8_BAR; }
    }
    PG8_WAIT_V(0);
    if constexpr (!ALIGN_EPI) { if (wr == 0) PG8_BAR; }
    PG8_BAR;
#undef PG8_SA
#undef PG8_SB
#undef PG8_STAGE
#undef PG8_LDA
#undef PG8_LDB
#undef PG8_MMA
#undef PG8_WAIT_V
#undef PG8_WAIT_L
#undef PG8_BAR
#undef PG8_SCHED
}
}

typedef f32x4 acc_t[2][2][4][2];
DEVFN f16x8 pack8(f32x4 a, f32x4 b) { f16x8 h; h[0] = (half_t)a[0]; h[1] = (half_t)a[1]; h[2] = (half_t)a[2]; h[3] = (half_t)a[3]; h[4] = (half_t)b[0]; h[5] = (half_t)b[1]; h[6] = (half_t)b[2]; h[7] = (half_t)b[3]; return h; }
DEVFN f32x4 silu4(f32x4 g) { f32x4 o; o[0] = g[0] * sigmoidf_(g[0]); o[1] = g[1] * sigmoidf_(g[1]); o[2] = g[2] * sigmoidf_(g[2]); o[3] = g[3] * sigmoidf_(g[3]); return o; }
DEVFN f32x4 sigm4(f32x4 g) { f32x4 o; o[0] = sigmoidf_(g[0]); o[1] = sigmoidf_(g[1]); o[2] = sigmoidf_(g[2]); o[3] = sigmoidf_(g[3]); return o; }
struct EpiStoreF16 { half_t* O; int ld;
    DEVFN void prepare(const pg8::Unit&, int) const {}
    DEVFN void operator()(const acc_t& acc, const pg8::Unit& u, int, int wr, int wc, int fr, int fq) const {
        const int row0 = u.pm * 256 + wr * 64 + fr, col0 = u.pn * 256 + wc * 32 + 8 * fq;
#pragma unroll
        for (int ai = 0; ai < 2; ++ai)
#pragma unroll
            for (int m = 0; m < 4; ++m) { half_t* rowp = O + (size_t)(row0 + ai * 128 + m * 16) * ld + col0;
#pragma unroll
                for (int bj = 0; bj < 2; ++bj) *(f16x8*)(rowp + bj * 128) = pack8(acc[ai][bj][m][0], acc[ai][bj][m][1]); }
    } };
struct EpiProj { half_t* O; int ld; half_t* VT; half_t* VTM;
    DEVFN void prepare(const pg8::Unit&, int) const {}
    DEVFN void operator()(const acc_t& acc, const pg8::Unit& u, int, int wr, int wc, int fr, int fq) const {
        const int row0 = u.pm * 256 + wr * 64 + fr, col0 = u.pn * 256 + wc * 32 + 8 * fq;
#pragma unroll
        for (int ai = 0; ai < 2; ++ai)
#pragma unroll
            for (int m = 0; m < 4; ++m) { half_t* rowp = O + (size_t)(row0 + ai * 128 + m * 16) * ld + col0;
#pragma unroll
                for (int bj = 0; bj < 2; ++bj) *(f16x8*)(rowp + bj * 128) = pack8(acc[ai][bj][m][0], acc[ai][bj][m][1]); }
        if (u.pn >= 8 && u.pn < 12) {
            const int sw = (fr & 3) | ((fr & 4) << 1) | ((fr & 8) >> 1);
#pragma unroll
            for (int ai = 0; ai < 2; ++ai)
#pragma unroll
                for (int m = 0; m < 4; ++m) { const int row = row0 + ai * 128 + m * 16;
                    half_t* base; size_t dstride;
                    if (row < MX) { base = VT + (size_t)(row >> 11) * 1024 * SEQ + (((row & 2047) & ~15) | sw); dstride = SEQ; }
                    else { base = VTM + (((row - MX) & ~15) | sw); dstride = 256; }
#pragma unroll
                    for (int bj = 0; bj < 2; ++bj)
#pragma unroll
                        for (int n = 0; n < 2; ++n)
#pragma unroll
                            for (int e = 0; e < 4; ++e) base[(size_t)(col0 - COL_V + bj * 128 + 4 * n + e) * dstride] = (half_t)acc[ai][bj][m][n][e]; }
        }
    } };
constexpr int TAB_OFF = 131072;
DEVFN void rowstat_fill(const float* st, int pm, char* lds, int parity) {
    const int t = tid_opaque();
    if (t < 256) { const f32x4* p = (const f32x4*)(st + (size_t)(pm * 256 + t) * 32); float s = 0.f, q = 0.f;
#pragma unroll
        for (int i = 0; i < 8; ++i) { const f32x4 v = p[i]; s += v[0] + v[2]; q += v[1] + v[3]; }
        const float mean = s * (1.f / D), var = fmaxf(q * (1.f / D) - mean * mean, 0.f);
        float* tab = (float*)(lds + TAB_OFF) + parity * 512;
        tab[2 * t] = mean; tab[2 * t + 1] = 1.0f / sqrtf(var + LN_EPS); }
}
DEVFN void stat_acc(const f16x8 h, float& s, float& q) {
#pragma unroll
    for (int i = 0; i < 8; ++i) { const float v = (float)h[i]; s += v; q = fmaf(v, v, q); }
}
DEVFN void stat_store(float* st, int row, int slot, float s, float q, int fq) {
    s += __shfl_xor(s, 16); s += __shfl_xor(s, 32); q += __shfl_xor(q, 16); q += __shfl_xor(q, 32);
    if (fq == 0) { float* p = st + (size_t)row * 32 + slot * 2; p[0] = s; p[1] = q; }
}
struct EpiLnSwiGLU { half_t* O; int ld; const float* st; const float* c1; const float* c2; char* lds;
    DEVFN void prepare(const pg8::Unit& u, int parity) const { rowstat_fill(st, u.pm, lds, parity); }
    DEVFN void operator()(const acc_t& acc, const pg8::Unit& u, int parity, int wr, int wc, int fr, int fq) const {
        const int rl0 = wr * 64 + fr, col0 = u.pn * 128 + wc * 32 + 8 * fq, n0 = u.pn * 256 + wc * 32 + 8 * fq;
        const float* tab = (const float*)(lds + TAB_OFF) + parity * 512;
        f32x4 k1[2][2], k2[2][2];
#pragma unroll
        for (int bj = 0; bj < 2; ++bj)
#pragma unroll
            for (int n = 0; n < 2; ++n) { k1[bj][n] = *(const f32x4*)(c1 + n0 + bj * 128 + 4 * n); k2[bj][n] = *(const f32x4*)(c2 + n0 + bj * 128 + 4 * n); }
#pragma unroll
        for (int ai = 0; ai < 2; ++ai)
#pragma unroll
            for (int m = 0; m < 4; ++m) { const int rl = rl0 + ai * 128 + m * 16; const float mean = tab[2 * rl], rstd = tab[2 * rl + 1];
                f32x4 g[2], up[2];
#pragma unroll
                for (int n = 0; n < 2; ++n) { g[n] = (acc[ai][0][m][n] - k1[0][n] * mean) * rstd + k2[0][n]; up[n] = (acc[ai][1][m][n] - k1[1][n] * mean) * rstd + k2[1][n]; }
                *(f16x8*)(O + (size_t)(u.pm * 256 + rl) * ld + col0) = pack8(silu4(g[0]) * up[0], silu4(g[1]) * up[1]); }
    } };
struct EpiLnGLU { half_t* O; int ld; const float* st; const float* c1; const float* c2; char* lds;
    DEVFN void prepare(const pg8::Unit& u, int parity) const { rowstat_fill(st, u.pm, lds, parity); }
    DEVFN void operator()(const acc_t& acc, const pg8::Unit& u, int parity, int wr, int wc, int fr, int fq) const {
        const int rl0 = wr * 64 + fr, col0 = u.pn * 128 + wc * 32 + 8 * fq, n0 = u.pn * 256 + wc * 32 + 8 * fq;
        const float* tab = (const float*)(lds + TAB_OFF) + parity * 512;
        f32x4 k1[2][2], k2[2][2];
#pragma unroll
        for (int bj = 0; bj < 2; ++bj)
#pragma unroll
            for (int n = 0; n < 2; ++n) { k1[bj][n] = *(const f32x4*)(c1 + n0 + bj * 128 + 4 * n); k2[bj][n] = *(const f32x4*)(c2 + n0 + bj * 128 + 4 * n); }
#pragma unroll
        for (int ai = 0; ai < 2; ++ai)
#pragma unroll
            for (int m = 0; m < 4; ++m) { const int rl = rl0 + ai * 128 + m * 16; const float mean = tab[2 * rl], rstd = tab[2 * rl + 1];
                f32x4 a[2], sg[2];
#pragma unroll
                for (int n = 0; n < 2; ++n) { a[n] = (acc[ai][0][m][n] - k1[0][n] * mean) * rstd + k2[0][n]; sg[n] = (acc[ai][1][m][n] - k1[1][n] * mean) * rstd + k2[1][n]; }
                *(f16x8*)(O + (size_t)(u.pm * 256 + rl) * ld + col0) = pack8(a[0] * sigm4(sg[0]), a[1] * sigm4(sg[1])); }
    } };
struct EpiResidX { const float* x; const float* meta; half_t* Y; float* sto;
    DEVFN void prepare(const pg8::Unit&, int) const {}
    DEVFN void operator()(const acc_t& acc, const pg8::Unit& u, int, int wr, int wc, int fr, int fq) const {
        const int row0 = u.pm * 256 + wr * 64 + fr, col0 = u.pn * 256 + wc * 32 + 8 * fq;
#pragma unroll
        for (int ai = 0; ai < 2; ++ai)
#pragma unroll
            for (int m = 0; m < 4; ++m) { const int row = row0 + ai * 128 + m * 16;
                const float* src = row < MX ? x + (size_t)row * D : (row < MV ? meta + (size_t)(row - MX) * D : nullptr);
                float s = 0.f, q = 0.f;
#pragma unroll
                for (int bj = 0; bj < 2; ++bj) { const int col = col0 + bj * 128;
                    const f32x4 r0 = src ? *(const f32x4*)(src + col) : (f32x4){0.f, 0.f, 0.f, 0.f}, r1 = src ? *(const f32x4*)(src + col + 4) : (f32x4){0.f, 0.f, 0.f, 0.f};
                    const f16x8 h = pack8(r0 * ALPHA + acc[ai][bj][m][0], r1 * ALPHA + acc[ai][bj][m][1]);
                    *(f16x8*)(Y + (size_t)row * D + col) = h; stat_acc(h, s, q); }
                stat_store(sto, row, u.pn * 4 + wc, s, q, fq); }
    } };
struct EpiResidLN { half_t* Y; const float* sti; float* sto; const float* g; const float* b; const float* bias; char* lds;
    DEVFN void prepare(const pg8::Unit& u, int parity) const { rowstat_fill(sti, u.pm, lds, parity); }
    DEVFN void operator()(const acc_t& acc, const pg8::Unit& u, int parity, int wr, int wc, int fr, int fq) const {
        const int rl0 = wr * 64 + fr, col0 = u.pn * 256 + wc * 32 + 8 * fq;
        const float* tab = (const float*)(lds + TAB_OFF) + parity * 512;
        f32x4 gg[2][2], bb[2][2];
#pragma unroll
        for (int bj = 0; bj < 2; ++bj)
#pragma unroll
            for (int n = 0; n < 2; ++n) { const int c = col0 + bj * 128 + 4 * n; gg[bj][n] = *(const f32x4*)(g + c) * ALPHA;
                bb[bj][n] = *(const f32x4*)(b + c) * ALPHA; if (bias) bb[bj][n] += *(const f32x4*)(bias + c); }
#pragma unroll
        for (int ai = 0; ai < 2; ++ai)
#pragma unroll
            for (int m = 0; m < 4; ++m) { const int rl = rl0 + ai * 128 + m * 16, row = u.pm * 256 + rl; const float mean = tab[2 * rl], rstd = tab[2 * rl + 1];
                float s = 0.f, q = 0.f;
#pragma unroll
                for (int bj = 0; bj < 2; ++bj) { half_t* yp = Y + (size_t)row * D + col0 + bj * 128; const f16x8 yv = *(const f16x8*)yp;
                    f32x4 y0, y1;
#pragma unroll
                    for (int e = 0; e < 4; ++e) { y0[e] = ((float)yv[e] - mean) * rstd; y1[e] = ((float)yv[4 + e] - mean) * rstd; }
                    const f16x8 h = pack8(y0 * gg[bj][0] + bb[bj][0] + acc[ai][bj][m][0], y1 * gg[bj][1] + bb[bj][1] + acc[ai][bj][m][1]);
                    *(f16x8*)yp = h; stat_acc(h, s, q); }
                stat_store(sto, row, u.pn * 4 + wc, s, q, fq); }
    } };
template <class Epi>
DEVFN void gemm_phase(const half_t* A, const half_t* Bt, int M, int N, int K, const Epi& epi, char* lds, int bid, int nb) {
    pg8::Gemm g{A, Bt, M, N, K}; pg8::StaticOrder S; S.init(M, N, nb, bid);
    pg8::gemm_phase<Epi, true>((PG8_LAS unsigned char*)lds, g, S, epi);
}

DEVFN void meta_rowstat(const float* st, int row, float& mean, float& rstd) {
    const f32x4* p = (const f32x4*)(st + (size_t)row * 32); float s = 0.f, q = 0.f;
#pragma unroll
    for (int i = 0; i < 8; ++i) { const f32x4 v = p[i]; s += v[0] + v[2]; q += v[1] + v[3]; }
    mean = s * (1.f / D); rstd = 1.0f / sqrtf(fmaxf(q * (1.f / D) - mean * mean, 0.f) + LN_EPS);
}
template <int MODE>
DEVFN void meta_rows_gemm(const Params& P, const half_t* A  , const half_t* Bt, int K, const float* sti, float* sto, const float* c1, const float* c2,
                          const float* lg, const float* lb, const float* bias, half_t* O, char* lds, int bid) {
    constexpr int NT = (MODE == 0 || MODE == 2) ? 4 : 2;
    const int ntask = MODE == 1 ? DFF / 16 : (MODE == 3 ? D / 16 : D / 64);
    if (bid >= ntask) return;
    const int tid = tid_opaque(), lane = tid & 63, wid = __builtin_amdgcn_readfirstlane(tid >> 6), fr = lane & 15, fq = lane >> 4;
    int rowg[NT];
    if (MODE == 0 || MODE == 2) { for (int t = 0; t < NT; ++t) rowg[t] = 64 * bid + 16 * t; }
    else { const int j0 = 16 * bid; rowg[0] = 256 * (j0 >> 7) + (j0 & 127); rowg[1] = rowg[0] + 128; }
    f32x4 acc[NT];
#pragma unroll
    for (int t = 0; t < NT; ++t) acc[t] = (f32x4){0.f, 0.f, 0.f, 0.f};
    const int kw = K / 8, kbeg = wid * kw;
    const half_t* ap = A + (size_t)(MX + fr) * K + kbeg + fq * 8;
    for (int k0 = 0; k0 < kw; k0 += 32) {
        const f16x8 af = *(const f16x8*)(ap + k0);
#pragma unroll
        for (int t = 0; t < NT; ++t) { const f16x8 bf = *(const f16x8*)(Bt + (size_t)(rowg[t] + fr) * K + kbeg + fq * 8 + k0);
            acc[t] = __builtin_amdgcn_mfma_f32_16x16x32_f16(bf, af, acc[t], 0, 0, 0); }
    }
    f32x4* red = (f32x4*)lds;
#pragma unroll
    for (int t = 0; t < NT; ++t) red[(wid * NT + t) * 64 + lane] = acc[t];
    __syncthreads();
    if (wid == 0) {
#pragma unroll
        for (int t = 0; t < NT; ++t) { f32x4 s = red[t * 64 + lane];
#pragma unroll
            for (int w = 1; w < 8; ++w) s += red[(w * NT + t) * 64 + lane];
            acc[t] = s; }
        const int row = MX + fr;
        if (MODE == 0) {
            float s = 0.f, q = 0.f;
#pragma unroll
            for (int t = 0; t < NT; ++t) { const int col = rowg[t] + 4 * fq; const f32x4 y = *(const f32x4*)(P.meta + (size_t)fr * D + col) * ALPHA + acc[t];
                f16x4 h; h[0] = (half_t)y[0]; h[1] = (half_t)y[1]; h[2] = (half_t)y[2]; h[3] = (half_t)y[3]; *(f16x4*)(O + (size_t)row * D + col) = h;
#pragma unroll
                for (int e = 0; e < 4; ++e) { const float v = (float)h[e]; s += v; q = fmaf(v, v, q); } }
            stat_store(sto, row, bid, s, q, fq);
        } else if (MODE == 2) {
            float mean, rstd; meta_rowstat(sti, row, mean, rstd);
            float s = 0.f, q = 0.f;
#pragma unroll
            for (int t = 0; t < NT; ++t) { const int col = rowg[t] + 4 * fq; half_t* yp = O + (size_t)row * D + col; const f16x4 yv = *(const f16x4*)yp;
                const f32x4 g = *(const f32x4*)(lg + col), bb = *(const f32x4*)(lb + col), bi = bias ? *(const f32x4*)(bias + col) : (f32x4){0.f, 0.f, 0.f, 0.f};
                f16x4 h;
#pragma unroll
                for (int e = 0; e < 4; ++e) { const float hn = (((float)yv[e] - mean) * rstd * g[e] + bb[e]) * ALPHA + bi[e] + acc[t][e]; h[e] = (half_t)hn; const float v = (float)h[e]; s += v; q = fmaf(v, v, q); }
                *(f16x4*)yp = h; }
            stat_store(sto, row, bid, s, q, fq);
        } else {
            float mean, rstd; meta_rowstat(sti, row, mean, rstd);
            const int j0 = 16 * bid + 4 * fq;
            const f32x4 ka1 = *(const f32x4*)(c1 + rowg[0] + 4 * fq), ka2 = *(const f32x4*)(c2 + rowg[0] + 4 * fq), kb1 = *(const f32x4*)(c1 + rowg[1] + 4 * fq), kb2 = *(const f32x4*)(c2 + rowg[1] + 4 * fq);
            const f32x4 a = (acc[0] - ka1 * mean) * rstd + ka2, bq = (acc[1] - kb1 * mean) * rstd + kb2;
            const f32x4 o = MODE == 1 ? silu4(a) * bq : a * sigm4(bq);
            f16x4 h; h[0] = (half_t)o[0]; h[1] = (half_t)o[1]; h[2] = (half_t)o[2]; h[3] = (half_t)o[3];
            *(f16x4*)(O + (size_t)row * (MODE == 1 ? DFF : D) + j0) = h;
        }
    }
    __syncthreads();
}

DEVFN void phase_final_ln(const Params& P, const float* st, const float* g, const float* b, int bid, int nb) {
    const half_t* Y = (const half_t*)(P.ws + OFF_Y);
    const int lane = tid_opaque() & 63, gw = bid * (NTHREADS / 64) + (tid_opaque() >> 6), ngw = nb * (NTHREADS / 64);
    for (int r = gw; r < MX; r += ngw) {
        float s = st[(size_t)r * 32 + (lane & 15) * 2], q = st[(size_t)r * 32 + (lane & 15) * 2 + 1];
#pragma unroll
        for (int o = 1; o < 16; o <<= 1) { s += __shfl_xor(s, o); q += __shfl_xor(q, o); }
        const float mean = s * (1.f / D), rstd = 1.0f / sqrtf(fmaxf(q * (1.f / D) - mean * mean, 0.f) + LN_EPS);
#pragma unroll
        for (int j = 0; j < 2; ++j) { const int c = lane * 8 + 512 * j; const f16x8 yv = *(const f16x8*)(Y + (size_t)r * D + c);
            f32x4 o0, o1;
#pragma unroll
            for (int e = 0; e < 4; ++e) { o0[e] = ((float)yv[e] - mean) * rstd; o1[e] = ((float)yv[4 + e] - mean) * rstd; }
            *(f32x4*)(P.out + (size_t)r * D + c) = o0 * *(const f32x4*)(g + c) + *(const f32x4*)(b + c);
            *(f32x4*)(P.out + (size_t)r * D + c + 4) = o1 * *(const f32x4*)(g + c + 4) + *(const f32x4*)(b + c + 4); }
    }
}

DEVFN int key_row(int b, int p) { return p < NMETA ? MX + p : b * SEQ + p - NMETA; }
constexpr int IDX_ROW = 2116;
DEVFN int half_sum_i(int v) {
#pragma unroll
    for (int o = 1; o < 32; o <<= 1) v += __shfl_xor(v, o);
    return v;
}
DEVFN void phase_indexer(const Params& P, char* lds, int bid, int nb) {
    float* sc = (float*)lds;
    const half_t* proj = (const half_t*)(P.ws + OFF_BIG);
    unsigned long long* maskt = (unsigned long long*)(P.ws + OFF_MASK);
    const int wid = __builtin_amdgcn_readfirstlane(tid_opaque() >> 6);
    for (int L = bid; L < NBATCH * (SEQ / 16); L += nb) {
        const int tid = tid_opaque(), lane = tid & 63, fr = lane & 15, quad = lane >> 4;
        const int i = (SEQ / 16 - 1) - (L >> 4), b = L & 15, s0 = 16 * i;
        if (s0 + 32 <= 256) {
            const int q = tid >> 5, s = s0 + q;
            for (int k = tid & 31; k < 33; k += 32) {
                unsigned long long bits;
                if (k == 0) bits = 0xFFFFull;
                else { const int base = 64 * (k - 1); bits = (s >= base + 63) ? ~0ull : (s < base ? 0ull : ((2ull << (s - base)) - 1ull)); }
                maskt[((size_t)b * 33 + k) * SEQ + s] = bits;
            }
            continue;
        }
        {
            const half_t* qrow = proj + (size_t)(b * SEQ + s0 + fr) * NPROJ;
            f16x8 bq[8][2];
#pragma unroll
            for (int h = 0; h < 8; ++h)
#pragma unroll
                for (int kh = 0; kh < 2; ++kh) bq[h][kh] = *(const f16x8*)(qrow + COL_QI + h * 64 + kh * 32 + quad * 8);
            float w[8]; { const f16x8 wv = *(const f16x8*)(qrow + COL_WI);
#pragma unroll
                for (int h = 0; h < 8; ++h) w[h] = (float)wv[h] * 0.04419417382415922f; }
            const int nblk = i + 2;
            int j = wid;
            const half_t* kp = proj + (size_t)(j == 0 ? MX + fr : b * SEQ + 16 * (j - 1) + fr) * NPROJ + COL_KI + quad * 8;
            f16x8 a0 = *(const f16x8*)kp, a1 = *(const f16x8*)(kp + 32);
            for (; j < nblk; j += 8) {
                const int jn = (j + 8 < nblk) ? j + 8 : j;
                const half_t* kn = proj + (size_t)(jn == 0 ? MX + fr : b * SEQ + 16 * (jn - 1) + fr) * NPROJ + COL_KI + quad * 8;
                const f16x8 n0 = *(const f16x8*)kn, n1 = *(const f16x8*)(kn + 32);
                f32x4 s4 = (f32x4){0.f, 0.f, 0.f, 0.f};
#pragma unroll
                for (int h = 0; h < 8; ++h) {
                    f32x4 acc = __builtin_amdgcn_mfma_f32_16x16x32_f16(a0, bq[h][0], (f32x4){0.f, 0.f, 0.f, 0.f}, 0, 0, 0);
                    acc = __builtin_amdgcn_mfma_f32_16x16x32_f16(a1, bq[h][1], acc, 0, 0, 0);
#pragma unroll
                    for (int e = 0; e < 4; ++e) s4[e] = fmaf(w[h], fmaxf(acc[e], 0.f), s4[e]);
                }
                s4 = s4 + 0.0f;
                const int slot = (j == 0 ? 0 : 64 + 16 * (j - 1)) + 4 * quad;
                *(f32x4*)(sc + fr * IDX_ROW + slot) = s4;
                a0 = n0; a1 = n1;
            }
        }
        __syncthreads();
#pragma unroll 1
        for (int qi2 = 0; qi2 < 2; ++qi2) {
            const int ln = tid_opaque() & 63, qq = 2 * wid + qi2, sq = s0 + qq;
            typedef __attribute__((address_space(3))) unsigned lds_u32;
            typedef unsigned u32x4 __attribute__((ext_vector_type(4)));
            lds_u32* hist = (lds_u32*)(__attribute__((address_space(3))) char*)lds + qq * IDX_ROW;
            const float* row = sc + qq * IDX_ROW;
            float v[33]; float vmin = INFINITY, vmax = -INFINITY;
#pragma unroll
            for (int j = 0; j < 33; ++j) { const int slot = 64 * j + ln; const bool valid = (slot < 16) | ((slot >= 64) & (slot - 64 <= sq));
                const float ld_ = row[slot];
                const float x = valid ? ld_ : -INFINITY; v[j] = x; vmax = fmaxf(vmax, x); vmin = fminf(vmin, valid ? x : INFINITY); }
#pragma unroll
            for (int o = 1; o < 64; o <<= 1) { vmin = fminf(vmin, __shfl_xor(vmin, o)); vmax = fmaxf(vmax, __shfl_xor(vmax, o)); }
#pragma unroll
            for (int k = 0; k < 8; ++k) *(__attribute__((address_space(3))) u32x4*)(hist + 256 * k + 4 * ln) = (u32x4){0u, 0u, 0u, 0u};
            const float range = vmax - vmin, scale = range > 0.f ? 2047.0f / range : 0.f;
            unsigned bins[17];
#pragma unroll
            for (int j = 0; j < 33; ++j) { const unsigned key = v[j] > -INFINITY ? 1u : 0u;
                int t_ = (int)(((key ? v[j] : vmin) - vmin) * scale); t_ = t_ > 2047 ? 2047 : t_;
                __hip_atomic_fetch_add(hist + (key ? t_ : 2048 + ln), 1u, __ATOMIC_RELAXED, __HIP_MEMORY_SCOPE_WORKGROUP);
                const unsigned bn1 = key ? (unsigned)t_ + 1u : 0u;
                if (j & 1) bins[j >> 1] |= bn1 << 16; else bins[j >> 1] = bn1;
                const unsigned u_ = __float_as_uint(v[j]); v[j] = __uint_as_float(u_ ^ (((unsigned)((int)u_ >> 31)) | 0x80000000u)); }
            unsigned tot = 0u;
#pragma unroll
            for (int k = 0; k < 8; ++k) { const u32x4 hq = *(const __attribute__((address_space(3))) u32x4*)(hist + 2016 - 32 * ln + 4 * k); tot += (hq[0] + hq[1]) + (hq[2] + hq[3]); }
            unsigned incl = tot;
#pragma unroll
            for (int o = 1; o < 64; o <<= 1) { const unsigned t_ = __shfl_up(incl, o); incl += ln >= o ? t_ : 0u; }
            const unsigned excl = incl - tot;
            int src = __ffsll((long long)__ballot((excl < 256u) & (256u <= incl))) - 1;
            const unsigned exclO = __shfl(excl, src);
            const int top = 2047 - 32 * src;
            const unsigned cb_ = hist[top - (ln & 31)], c1_ = ln < 32 ? cb_ : 0u;
            unsigned incl2 = c1_;
#pragma unroll
            for (int o = 1; o < 64; o <<= 1) { const unsigned t_ = __shfl_up(incl2, o); incl2 += ln >= o ? t_ : 0u; }
            const unsigned excl2 = incl2 - c1_ + exclO;
            src = __ffsll((long long)__ballot((excl2 < 256u) & (256u <= excl2 + c1_))) - 1;
            const int Bsel = top - src; const unsigned above = __shfl(excl2, src), cB = __shfl(c1_, src);
            const unsigned ub1 = (unsigned)Bsel + 1u;
            int rleft = (int)(256u - above);
            const unsigned allB = rleft >= (int)cB ? 1u : 0u;
            rleft = allB ? 0 : rleft;
            unsigned selm0 = 0u, selm1 = 0u;
            while (rleft > 0) {
                unsigned bk = 0u, bp = 0u;
#pragma unroll
                for (int j = 0; j < 33; ++j) { const unsigned bn1 = (j & 1) ? (bins[j >> 1] >> 16) : (bins[j >> 1] & 0xFFFFu);
                    const unsigned sm = j < 32 ? selm0 : selm1;
                    const unsigned k2 = (bn1 << 1) | ((sm >> (j & 31)) & 1u);
                    const unsigned kk = k2 == (ub1 << 1) ? __float_as_uint(v[j]) : 0u;
                    bp = kk > bk ? (unsigned)j : bp; bk = kk > bk ? kk : bk; }
                bp = (bp << 6) + (unsigned)ln;
                unsigned long long best = ((unsigned long long)bk << 32) | (0xFFFFFFFFu - bp);
#pragma unroll
                for (int o = 1; o < 64; o <<= 1) { const unsigned long long ot = __shfl_xor(best, o); best = ot > best ? ot : best; }
                const unsigned wp = 0xFFFFFFFFu - (unsigned)best, wj = wp >> 6;
                const unsigned bit = (((wp & 63u) == (unsigned)ln) & ((unsigned)(best >> 32) != 0u)) ? (1u << (wj & 31u)) : 0u;
                selm0 |= wj < 32u ? bit : 0u; selm1 |= wj >= 32u ? bit : 0u;
                rleft -= 1;
            }
            unsigned long long myw = 0ull;
            const unsigned thr2 = (ub1 << 1) | 1u;
#pragma unroll
            for (int j = 0; j < 33; ++j) { const unsigned bn1 = (j & 1) ? (bins[j >> 1] >> 16) : (bins[j >> 1] & 0xFFFFu);
                const unsigned sm = j < 32 ? selm0 : selm1;
                const unsigned k2 = (bn1 << 1) | allB | ((sm >> (j & 31)) & 1u);
                const unsigned long long sb = __ballot(k2 >= thr2);
                myw = ln == j ? sb : myw; }
            if (ln < 33) maskt[((size_t)b * 33 + ln) * SEQ + sq] = myw;
        }
        __syncthreads();
    }
}

DEVFN int t5_bucket(int d) {
    if (d < 16) return d;
    const int bd[15] = {19, 21, 24, 27, 31, 35, 40, 46, 52, 59, 67, 77, 87, 99, 113};
    int b = 16;
#pragma unroll
    for (int i = 0; i < 15; ++i) b += (d >= bd[i]) ? 1 : 0;
    return b;
}
constexpr float LOG2E = 1.4426950408889634f;
constexpr float QSCALE = 0.125f * LOG2E;
typedef float f32x16 __attribute__((ext_vector_type(16)));
#define ATT_LAS __attribute__((address_space(3)))
constexpr int ATT_K = 0, ATT_V = 16384, ATT_DL = 32768, ATT_LDS = 32768 + 1024;
DEVFN void attn_unit(const Params& P, char* lds, int b, int h, int qb) {
    const int tid = tid_opaque(), lane = tid & 63, wid = __builtin_amdgcn_readfirstlane(tid >> 6), r32 = lane & 31, hi = lane >> 5;
    const half_t* proj = (const half_t*)(P.ws + OFF_BIG);
    const half_t* VT = (const half_t*)P.out; const half_t* VTM = VT + VT_ELEMS;
    const unsigned long long* maskt = (const unsigned long long*)(P.ws + OFF_MASK) + (size_t)b * 33 * SEQ;
    ATT_LAS char* L = (ATT_LAS char*)lds;
    float* dl = (float*)(lds + ATT_DL);
    const int sq = 256 * qb + 32 * wid + r32;
    const int NT = 4 * qb + 5;
    if (tid < 129) dl[tid] = tid < 128 ? (P.rel_bias[t5_bucket(tid) * 16 + h] - P.rel_bias[31 * 16 + h]) * LOG2E : 0.f;
    f16x8 qf[4];
#pragma unroll
    for (int d0 = 0; d0 < 4; ++d0) qf[d0] = *(const f16x8*)(proj + ((size_t)b * SEQ + sq) * NPROJ + h * 64 + 16 * d0 + 8 * hi);
    const int drow = wid * 8 + (lane >> 3), dch = (lane & 7) ^ ((lane >> 3) & 7);
    const half_t* ksrc_m = proj + (size_t)(MX + drow) * NPROJ + COL_K + h * 64 + dch * 8;
    const half_t* ksrc_x = proj + ((size_t)b * SEQ + drow) * NPROJ + COL_K + h * 64 + dch * 8;
    const half_t* vsrc_m = VTM + (size_t)(h * 64 + drow) * 256 + dch * 8;
    const half_t* vsrc_x = VT + ((size_t)(b * 16 + h) * 64 + drow) * SEQ + dch * 8;
#define ATT_DMA(tt, slot) do { const half_t* ks_ = (tt) == 0 ? ksrc_m : ksrc_x + (size_t)((tt) - 1) * 64 * NPROJ; const half_t* vs_ = (tt) == 0 ? vsrc_m : vsrc_x + ((tt) - 1) * 64; \
        __builtin_amdgcn_global_load_lds((const unsigned*)ks_, (ATT_LAS unsigned*)(L + ATT_K + (slot) * 8192 + wid * 1024), 16, 0, 0); \
        __builtin_amdgcn_global_load_lds((const unsigned*)vs_, (ATT_LAS unsigned*)(L + ATT_V + (slot) * 8192 + wid * 1024), 16, 0, 0); } while (0)
    int foff[8];
#pragma unroll
    for (int c = 0; c < 8; ++c) foff[c] = r32 * 128 + (((c) ^ (r32 & 7)) * 16);
    float m = -1e30f, l = 0.f;
    f32x16 o0, o1;
#pragma unroll
    for (int r = 0; r < 16; ++r) { o0[r] = 0.f; o1[r] = 0.f; }
    ATT_DMA(0, 0);
    unsigned long long mw_next = maskt[sq];
    asm volatile("s_waitcnt vmcnt(0)" ::: "memory");
    __syncthreads();
    for (int tt = 0; tt < NT; ++tt) {
        const int cur = tt & 1;
        const unsigned long long mw = mw_next;
        if (tt + 1 < NT) { ATT_DMA(tt + 1, cur ^ 1); mw_next = maskt[(size_t)(tt + 1) * SEQ + sq]; }
        const int kbase = tt == 0 ? 0 : 64 * (tt - 1);
        const bool active = tt == 0 || kbase <= 256 * qb + 32 * wid + 31;
        if (active) {
            f32x16 c0, c1;
#pragma unroll
            for (int r = 0; r < 16; ++r) { c0[r] = 0.f; c1[r] = 0.f; }
            const ATT_LAS char* kb = L + ATT_K + cur * 8192;
#pragma unroll
            for (int d0 = 0; d0 < 4; ++d0) {
                const f16x8 k0 = *(const ATT_LAS f16x8*)(kb + foff[2 * d0 + hi]);
                const f16x8 k1 = *(const ATT_LAS f16x8*)(kb + 4096 + foff[2 * d0 + hi]);
                c0 = __builtin_amdgcn_mfma_f32_32x32x16_f16(k0, qf[d0], c0, 0, 0, 0);
                c1 = __builtin_amdgcn_mfma_f32_32x32x16_f16(k1, qf[d0], c1, 0, 0, 0);
            }
            const int dist0 = tt == 0 ? sq + 16 - 4 * hi : sq - kbase - 4 * hi;
            const bool nearb = tt == 0 ? (256 * qb + 32 * wid + 16 - 15 < 128) : (256 * qb + 32 * wid - (kbase + 63) < 128);
            if (nearb) {
#pragma unroll
                for (int r = 0; r < 16; ++r) { const int kk = (r & 3) + 8 * (r >> 2);
                    int d0_ = dist0 - kk, d1_ = dist0 - kk - 32; d0_ = d0_ < 0 ? 0 : (d0_ > 128 ? 128 : d0_); d1_ = d1_ < 0 ? 0 : (d1_ > 128 ? 128 : d1_);
                    c0[r] += dl[d0_]; c1[r] += dl[d1_]; }
            }
            const unsigned mlo = (unsigned)mw >> (4 * hi), mhi = (unsigned)(mw >> 32) >> (4 * hi);
            float tmax = -INFINITY;
#pragma unroll
            for (int r = 0; r < 16; ++r) { const int cb = (r & 3) + 8 * (r >> 2);
                c0[r] = ((mlo >> cb) & 1u) ? c0[r] : -INFINITY; c1[r] = ((mhi >> cb) & 1u) ? c1[r] : -INFINITY;
                tmax = fmaxf(tmax, fmaxf(c0[r], c1[r])); }
            tmax = fmaxf(tmax, __shfl_xor(tmax, 32));
            const float mn = fmaxf(m, tmax), alpha = __builtin_amdgcn_exp2f(m - mn);
            m = mn;
            float ls = 0.f;
#pragma unroll
            for (int r = 0; r < 16; ++r) { c0[r] = __builtin_amdgcn_exp2f(c0[r] - mn); c1[r] = __builtin_amdgcn_exp2f(c1[r] - mn); ls += c0[r] + c1[r]; }
            l = l * alpha + ls;
            if (!__all(alpha == 1.0f)) {
#pragma unroll
                for (int r = 0; r < 16; ++r) { o0[r] *= alpha; o1[r] *= alpha; }
            }
            const ATT_LAS char* vb = L + ATT_V + cur * 8192;
#pragma unroll
            for (int s = 0; s < 4; ++s) {
                f16x8 pf;
#pragma unroll
                for (int jj = 0; jj < 8; ++jj) pf[jj] = (half_t)((s < 2) ? c0[8 * (s & 1) + jj] : c1[8 * (s & 1) + jj]);
                const f16x8 v0 = *(const ATT_LAS f16x8*)(vb + foff[2 * s + hi]);
                const f16x8 v1 = *(const ATT_LAS f16x8*)(vb + 4096 + foff[2 * s + hi]);
                o0 = __builtin_amdgcn_mfma_f32_32x32x16_f16(v0, pf, o0, 0, 0, 0);
                o1 = __builtin_amdgcn_mfma_f32_32x32x16_f16(v1, pf, o1, 0, 0, 0);
            }
        }
        asm volatile("s_waitcnt vmcnt(0)" ::: "memory");
        __syncthreads();
    }
#undef ATT_DMA
    l += __shfl_xor(l, 32);
    const float il = 1.0f / l;
    half_t* orow = (half_t*)(P.ws + OFF_HA) + ((size_t)b * SEQ + sq) * D + h * 64;
#pragma unroll
    for (int g = 0; g < 4; ++g) { f16x4 a, c;
#pragma unroll
        for (int e = 0; e < 4; ++e) { a[e] = (half_t)(o0[4 * g + e] * il); c[e] = (half_t)(o1[4 * g + e] * il); }
        *(f16x4*)(orow + 8 * g + 4 * hi) = a; *(f16x4*)(orow + 32 + 8 * g + 4 * hi) = c; }
}
DEVFN void attn_meta_rows(const Params& P, int bid, int nb) {
    const half_t* proj = (const half_t*)(P.ws + OFF_BIG); half_t* AO = (half_t*)(P.ws + OFF_HA);
    const int tid = tid_opaque() & 255, sub = tid_opaque() >> 8, head = tid >> 4;
    for (int mrow = 2 * bid + sub; mrow < NMETA; mrow += 2 * nb) {
        const int r = MX + mrow;
        float q[4]; { const f16x4 qv = *(const f16x4*)(proj + (size_t)r * NPROJ + tid * 4); q[0] = (float)qv[0]; q[1] = (float)qv[1]; q[2] = (float)qv[2]; q[3] = (float)qv[3]; }
        float m = -1e30f, l = 0.f, o[4] = {0.f, 0.f, 0.f, 0.f};
        for (int p = 0; p <= mrow; ++p) {
            const half_t* kr = proj + (size_t)(MX + p) * NPROJ + tid * 4;
            const f16x4 kv = *(const f16x4*)(kr + COL_K), vv = *(const f16x4*)(kr + COL_V);
            float d = q[0] * (float)kv[0] + q[1] * (float)kv[1] + q[2] * (float)kv[2] + q[3] * (float)kv[3];
            d += __shfl_xor(d, 1); d += __shfl_xor(d, 2); d += __shfl_xor(d, 4); d += __shfl_xor(d, 8);
            const float s = d + P.rel_bias[t5_bucket(mrow - p) * 16 + head] * LOG2E;
            const float mn = fmaxf(m, s), corr = __builtin_amdgcn_exp2f(m - mn), pe = __builtin_amdgcn_exp2f(s - mn);
            l = l * corr + pe;
#pragma unroll
            for (int c = 0; c < 4; ++c) o[c] = o[c] * corr + pe * (float)vv[c];
            m = mn;
        }
        const float il = 1.0f / l; f16x4 hh; hh[0] = (half_t)(o[0] * il); hh[1] = (half_t)(o[1] * il); hh[2] = (half_t)(o[2] * il); hh[3] = (half_t)(o[3] * il);
        *(f16x4*)(AO + (size_t)r * D + tid * 4) = hh;
    }
}
DEVFN void phase_attn(const Params& P, char* lds, int bid, int nb) {
    attn_meta_rows(P, bid, nb);
    for (int bh = bid; bh < NBATCH * 16; bh += nb)
        for (int qb = 7; qb >= 0; --qb) attn_unit(P, lds, bh >> 4, bh & 15, qb);
}

typedef float f32x2 __attribute__((ext_vector_type(2)));
DEVFN void phase_conv(const Params& P, char* lds, int bid, int nb) {
    const half_t* U = (const half_t*)(P.ws + OFF_BIG); half_t* C = (half_t*)(P.ws + OFF_C);
    const int tid = tid_opaque(), lane = tid & 63, wid = __builtin_amdgcn_readfirstlane(tid >> 6);
    const int c0 = 128 * wid + 2 * lane;
    float* ys = (float*)lds;
    f32x2 w[31];
#pragma unroll
    for (int k = 0; k < 31; ++k) w[k] = *(const f32x2*)(P.w_dw + (size_t)k * D + c0);
    const f32x2 bias = *(const f32x2*)(P.b_dw + c0);
    for (int unit = bid; unit < NBATCH * (SEQ / 32); unit += nb) {
        const int b = unit >> 6, sbase = 32 * (unit & 63);
        f32x2 uw[62];
#pragma unroll
        for (int wi = 0; wi < 62; ++wi) { const int sx = sbase - 30 + wi;
            const int row = sx >= 0 ? b * SEQ + sx : MX + (sx + 16 >= 0 ? sx + 16 : 0);
            const f16x2 ld_ = *(const f16x2*)(U + (size_t)row * D + c0);
            uw[wi] = sx + 16 >= 0 ? (f32x2){(float)ld_[0], (float)ld_[1]} : (f32x2){0.f, 0.f}; }
#pragma unroll
        for (int i = 0; i < 32; ++i) { f32x2 a = bias;
#pragma unroll
            for (int k = 0; k < 31; ++k) a = w[k] * uw[i + k] + a;
            *(f32x2*)(ys + i * D + c0) = a; }
        __syncthreads();
#pragma unroll 1
        for (int tt = 0; tt < 4; ++tt) { const int i = 4 * wid + tt;
            f32x4 y[4]; float s = 0.f;
#pragma unroll
            for (int q = 0; q < 4; ++q) { y[q] = *(const f32x4*)(ys + i * D + 4 * lane + 256 * q); s += (y[q][0] + y[q][1]) + (y[q][2] + y[q][3]); }
            const float mean = wave_sum(s) * (1.f / D); float qv = 0.f;
#pragma unroll
            for (int q = 0; q < 4; ++q) { y[q] = y[q] - mean; qv += (y[q][0] * y[q][0] + y[q][1] * y[q][1]) + (y[q][2] * y[q][2] + y[q][3] * y[q][3]); }
            const float rstd = 1.0f / sqrtf(wave_sum(qv) * (1.f / D) + LN_EPS);
            half_t* orow = C + ((size_t)b * SEQ + sbase + i) * D + 4 * lane;
#pragma unroll
            for (int q = 0; q < 4; ++q) { const f32x4 z = y[q] * rstd * *(const f32x4*)(P.cln_g + 4 * lane + 256 * q) + *(const f32x4*)(P.cln_b + 4 * lane + 256 * q); const f32x4 o = silu4(z);
                f16x4 h; h[0] = (half_t)o[0]; h[1] = (half_t)o[1]; h[2] = (half_t)o[2]; h[3] = (half_t)o[3];
                *(f16x4*)(orow + 256 * q) = h; }
        }
        __syncthreads();
    }
}

#define XB_TMO      128
#define XB_XCNT(j)  (256  + 64 * (j))
#define XB_XSUB(j)  (1280 + 64 * (j))
#define XB_XGEN(j)  (2304 + 64 * (j))
#define XB_TOP      3328
#define XB_TOPGEN   3392
#define XCD_BAR_WORDS 3456
#define XB_SPIN_CAP (1u << 18)
#define XB_LAS __attribute__((address_space(3)))
__device__ __forceinline__ unsigned xb_ld(unsigned* p)              { return __hip_atomic_load(p, __ATOMIC_RELAXED, __HIP_MEMORY_SCOPE_AGENT); }
__device__ __forceinline__ unsigned xb_add(unsigned* p, unsigned v) { return __hip_atomic_fetch_add(p, v, __ATOMIC_RELAXED, __HIP_MEMORY_SCOPE_AGENT); }
__device__ __forceinline__ unsigned xb_xcc_id() { return (unsigned)__builtin_amdgcn_s_getreg((3 << 11) | 20) & 0xFu; }
#define XB_SPIN(cond, bar) do { unsigned _sp = 0; while (cond) { __builtin_amdgcn_s_sleep(1); \
    if ((++_sp & 255u) == 0u) { if (xb_ld(&(bar)[XB_TMO])) break; if (_sp > XB_SPIN_CAP) { atomicAdd(&(bar)[XB_TMO], 1u); break; } } } } while (0)
struct XcdBarrier { unsigned* bar; unsigned x; volatile XB_LAS unsigned* st; };
__device__ __forceinline__ XcdBarrier xcd_barrier_post(unsigned* bar, volatile XB_LAS unsigned* st) {
    XcdBarrier b; b.bar = bar; b.x = xb_xcc_id(); b.st = st;
    if (threadIdx.x == 0) (void)xb_add(&bar[XB_XCNT(b.x)], 1u);
    return b;
}
__device__ __forceinline__ void xcd_barrier_complete(unsigned* bar, unsigned x, unsigned& nloc, unsigned& nx) {
    const unsigned G = gridDim.x * gridDim.y * gridDim.z;
    unsigned sum, cnt, mine, sp = 0u;
    for (;;) {
        sum = 0u; cnt = 0u; mine = 0u;
#pragma unroll
        for (unsigned j = 0; j < 16; ++j) { const unsigned c = xb_ld(&bar[XB_XCNT(j)]); sum += c; cnt += (c > 0u) ? 1u : 0u; mine = (j == x) ? c : mine; }
        if (sum == G) break;
        __builtin_amdgcn_s_sleep(1);
        if ((++sp & 255u) == 0u) { if (xb_ld(&bar[XB_TMO])) break; if (sp > XB_SPIN_CAP) { atomicAdd(&bar[XB_TMO], 1u); break; } }
    }
    nloc = mine > 0u ? mine : 1u; nx = cnt > 0u ? cnt : 1u;
}
__device__ __forceinline__ void xcd_barrier(const XcdBarrier& b) {
    asm volatile("s_waitcnt vmcnt(0)" ::: "memory");
    __syncthreads();
    if (threadIdx.x == 0) {
        unsigned* bar = b.bar;
        __builtin_amdgcn_s_waitcnt(0);
        unsigned nloc = b.st[0], nx = b.st[1];
        if (nloc == 0u) { xcd_barrier_complete(bar, b.x, nloc, nx); b.st[0] = nloc; b.st[1] = nx; }
        const unsigned old = xb_add(&bar[XB_XSUB(b.x)], 1u);
        const unsigned gen = old / nloc;
        if (old + 1u == (gen + 1u) * nloc) {
            __builtin_amdgcn_fence(__ATOMIC_RELEASE, "agent");
            asm volatile("s_waitcnt vmcnt(0)" ::: "memory");
            const unsigned og = xb_add(&bar[XB_TOP], 1u);
            const unsigned tg = og / nx;
            if (og + 1u == (tg + 1u) * nx) xb_add(&bar[XB_TOPGEN], 1u);
            else XB_SPIN(xb_ld(&bar[XB_TOPGEN]) == tg, bar);
            __builtin_amdgcn_fence(__ATOMIC_ACQUIRE, "agent");
            xb_add(&bar[XB_XGEN(b.x)], 1u);
            asm volatile("s_waitcnt vmcnt(0)" ::: "memory");
        } else {
            XB_SPIN(xb_ld(&bar[XB_XGEN(b.x)]) == gen, bar);
            __builtin_amdgcn_fence(__ATOMIC_ACQUIRE, "agent");
            asm volatile("s_waitcnt vmcnt(0)" ::: "memory");
        }
    }
    __syncthreads();
}
constexpr int MISC_OFF = 147456 - 16;

constexpr int N_PHASES = 13;
constexpr int LDS_BYTES = 147456;
static_assert(pg8::STAGE_BYTES == 131072, "LDS");

DEVFN void run_phase(const Params& P, int ph, char* lds, int bid, int nb) {
    unsigned char* ws = P.ws;
    half_t* HA = (half_t*)(ws + OFF_HA); half_t* BIG = (half_t*)(ws + OFF_BIG); half_t* CB = (half_t*)(ws + OFF_C); half_t* Y = (half_t*)(ws + OFF_Y);
    float* ST0 = (float*)(ws + OFF_ST0); float* ST1 = (float*)(ws + OFF_ST1); const float* C1 = (const float*)(ws + OFF_C1); const float* C2 = (const float*)(ws + OFF_C2);
    switch (ph) {
    case 0: phase_prep(P, lds, bid, nb); break;
    case 1: gemm_phase(HA, (const half_t*)(ws + OFF_W_IN), MP, NPROJ, D, EpiProj{BIG, NPROJ, (half_t*)P.out, (half_t*)P.out + VT_ELEMS}, lds, bid, nb); break;
    case 2: finish_colconsts(P, bid, nb); phase_indexer(P, lds, bid, nb); break;
    case 3: phase_attn(P, lds, bid, nb); break;
    case 4: meta_rows_gemm<0>(P, HA, (const half_t*)(ws + OFF_W_O), D, nullptr, ST0, nullptr, nullptr, nullptr, nullptr, nullptr, Y, lds, bid);
            gemm_phase(HA, (const half_t*)(ws + OFF_W_O), MX, D, D, EpiResidX{P.x, P.meta, Y, ST0}, lds, bid, nb); break;
    case 5: meta_rows_gemm<1>(P, Y, (const half_t*)(ws + OFF_W_GU0), D, ST0, nullptr, C1 + NC_GU0, C2 + NC_GU0, nullptr, nullptr, nullptr, BIG, lds, bid);
            gemm_phase(Y, (const half_t*)(ws + OFF_W_GU0), MX, 2 * DFF, D, EpiLnSwiGLU{BIG, DFF, ST0, C1 + NC_GU0, C2 + NC_GU0, lds}, lds, bid, nb); break;
    case 6: meta_rows_gemm<2>(P, BIG, (const half_t*)(ws + OFF_W_D0), DFF, ST0, ST1, nullptr, nullptr, P.ln1_g, P.ln1_b, nullptr, Y, lds, bid);
            gemm_phase(BIG, (const half_t*)(ws + OFF_W_D0), MX, D, DFF, EpiResidLN{Y, ST0, ST1, P.ln1_g, P.ln1_b, nullptr, lds}, lds, bid, nb); break;
    case 7: meta_rows_gemm<3>(P, Y, (const half_t*)(ws + OFF_W_PW1), D, ST1, nullptr, C1 + NC_PW1, C2 + NC_PW1, nullptr, nullptr, nullptr, BIG, lds, bid);
            gemm_phase(Y, (const half_t*)(ws + OFF_W_PW1), MX, 2 * D, D, EpiLnGLU{BIG, D, ST1, C1 + NC_PW1, C2 + NC_PW1, lds}, lds, bid, nb); break;
    case 8: phase_conv(P, lds, bid, nb); break;
    case 9: gemm_phase(CB, (const half_t*)(ws + OFF_W_PW2), MX, D, D, EpiResidLN{Y, ST1, ST0, P.ln2_g, P.ln2_b, P.b_pw2, lds}, lds, bid, nb); break;
    case 10: gemm_phase(Y, (const half_t*)(ws + OFF_W_GU1), MX, 2 * DFF, D, EpiLnSwiGLU{BIG, DFF, ST0, C1 + NC_GU1, C2 + NC_GU1, lds}, lds, bid, nb); break;
    case 11: gemm_phase(BIG, (const half_t*)(ws + OFF_W_D1), MX, D, DFF, EpiResidLN{Y, ST0, ST1, P.ln1_g + D, P.ln1_b + D, nullptr, lds}, lds, bid, nb); break;
    case 12: phase_final_ln(P, ST1, P.ln2_g + D, P.ln2_b + D, bid, nb); break;
    default: break;
    }
}

#if MODE_COOP
__global__ void __launch_bounds__(NTHREADS, 2) fwd_mega(Params P) {
    extern __shared__ __attribute__((aligned(16))) char lds[];
    cg::grid_group grid = cg::this_grid();
    volatile XB_LAS unsigned* misc = (volatile XB_LAS unsigned*)((XB_LAS char*)lds + MISC_OFF);
    if (threadIdx.x < 4) misc[threadIdx.x] = 0u;
    __syncthreads();
    const XcdBarrier bar = xcd_barrier_post((unsigned*)(P.ws + OFF_CTL), misc);
#define PHASE(k) run_phase(P, k, lds, blockIdx.x, gridDim.x)
#define SEAM() xcd_barrier(bar)
    PHASE(0); grid.sync();
    PHASE(1); SEAM(); PHASE(2); SEAM(); PHASE(3); SEAM(); PHASE(4); SEAM(); PHASE(5); SEAM(); PHASE(6); SEAM(); PHASE(7); SEAM();
    PHASE(8); SEAM(); PHASE(9); SEAM(); PHASE(10); SEAM(); PHASE(11); SEAM(); PHASE(12);
#undef PHASE
#undef SEAM
}
#else
template <int PH> __global__ void __launch_bounds__(NTHREADS, 2) fwd_phase(Params P) {
    extern __shared__ __attribute__((aligned(16))) char lds[];
    run_phase(P, PH, lds, blockIdx.x, gridDim.x);
}
template <int PH> static void launch_phases(const Params& p, hipStream_t stream) {
    hipFuncSetAttribute((const void*)fwd_phase<PH>, hipFuncAttributeMaxDynamicSharedMemorySize, LDS_BYTES);
    hipLaunchKernelGGL(fwd_phase<PH>, dim3(256), dim3(NTHREADS), LDS_BYTES, stream, p);
    if constexpr (PH + 1 < N_PHASES) launch_phases<PH + 1>(p, stream);
}
#endif

extern "C" void kernel_launch(void* const* d_in, const int* in_sizes, int n_in, void* d_out, int out_size, void* d_ws, size_t ws_size, hipStream_t stream) {
    if (n_in != 20 || ws_size < WS_END || out_size != MX * D) { fprintf(stderr, "kernel_launch: unexpected sizes n_in %d ws %zu out %d\n", n_in, ws_size, out_size); return; }
    Params p{};
    const float** pp = (const float**)&p;
    for (int i = 0; i < 20; ++i) pp[i] = (const float*)d_in[i];
    p.out = (float*)d_out; p.ws = (unsigned char*)d_ws;
#if MODE_COOP
    static int grid_blocks = 0;
    if (!grid_blocks) {
        int dev = 0, cus = 0, per_cu = 0;
        hipGetDevice(&dev); hipDeviceGetAttribute(&cus, hipDeviceAttributeMultiprocessorCount, dev);
        hipFuncSetAttribute((const void*)fwd_mega, hipFuncAttributeMaxDynamicSharedMemorySize, LDS_BYTES);
        hipOccupancyMaxActiveBlocksPerMultiprocessor(&per_cu, fwd_mega, NTHREADS, LDS_BYTES);
        if (per_cu < 1) per_cu = 1;
        grid_blocks = cus * per_cu;
    }
    hipMemsetAsync((char*)d_ws + OFF_CTL, 0, XCD_BAR_WORDS * 4, stream);
    void* args[] = {&p};
    hipError_t e = hipLaunchCooperativeKernel((void*)fwd_mega, dim3(grid_blocks), dim3(NTHREADS), args, LDS_BYTES, stream);
    if (e != hipSuccess) fprintf(stderr, "cooperative launch failed: %s (grid %d)\n", hipGetErrorString(e), grid_blocks);
#else
    launch_phases<0>(p, stream);
#endif
}
```

```cpp
#include <hip/hip_runtime.h>
#include <hip/hip_cooperative_groups.h>
#include <cstdio>
#include <cstdint>
namespace cg = cooperative_groups;

#ifndef MODE_COOP
#define MODE_COOP 1
#endif

#define DEVFN __device__ __forceinline__
typedef _Float16 half_t;
typedef _Float16 f16x8 __attribute__((ext_vector_type(8)));
typedef _Float16 f16x4 __attribute__((ext_vector_type(4)));
typedef _Float16 f16x2 __attribute__((ext_vector_type(2)));
typedef float f32x4 __attribute__((ext_vector_type(4)));

constexpr int D = 1024, NBATCH = 16, SEQ = 2048, NMETA = 16;
constexpr int MX = NBATCH * SEQ;
constexpr int MV = MX + NMETA;
constexpr int MP = 33024;
constexpr int NPROJ = 3840, NPROJ_VALID = 3656;
constexpr int DFF = 2816;
constexpr int COL_K = 1024, COL_V = 2048, COL_QI = 3072, COL_KI = 3584, COL_WI = 3648;
constexpr int MASK_W64 = 33;
constexpr float ALPHA = 1.41421356237309515f;
constexpr float LN_EPS = 1e-5f;
constexpr int NTHREADS = 512;
constexpr size_t VT_ELEMS = (size_t)NBATCH * 16 * 64 * SEQ;

constexpr size_t MiB = 1u << 20;
constexpr size_t OFF_W_IN = 0, OFF_W_O = 8 * MiB, OFF_W_GU0 = 10 * MiB, OFF_W_GU1 = 21 * MiB, OFF_W_D0 = 32 * MiB, OFF_W_D1 = 38 * MiB,
                 OFF_W_PW1 = 44 * MiB, OFF_W_PW2 = 48 * MiB, OFF_MASK = 50 * MiB, OFF_Y = 60 * MiB, OFF_ST0 = 126 * MiB, OFF_ST1 = 131 * MiB,
                 OFF_CP1 = 136 * MiB, OFF_CP2 = 138 * MiB, OFF_C1 = 140 * MiB, OFF_C2 = 140 * MiB + 65536, OFF_CTL = 141 * MiB, OFF_HA = 190 * MiB, OFF_BIG = 256 * MiB,
                 OFF_C = OFF_BIG + 65 * MiB, WS_END = OFF_BIG + 242 * MiB;
constexpr int NC_GU0 = 0, NC_GU1 = 2 * DFF, NC_PW1 = 4 * DFF, NC_TOTAL = 4 * DFF + 2 * D;
static_assert((size_t)MP * 16 * 8 <= 5 * MiB && (size_t)32 * NC_TOTAL * 4 <= 2 * MiB && (size_t)NC_TOTAL * 4 <= 65536, "stats");
static_assert((size_t)NPROJ * D * 2 <= 8 * MiB && (size_t)2 * DFF * D * 2 <= 11 * MiB && (size_t)DFF * D * 2 <= 6 * MiB, "weights");
static_assert((size_t)MP * MASK_W64 * 8 <= 10 * MiB && (size_t)MP * D * 2 <= 65 * MiB && (size_t)MP * NPROJ * 2 <= 242 * MiB, "acts");

struct Params {
    const float *x, *meta, *rel_bias, *w_in, *w_o, *w_pw1, *b_pw1, *w_dw, *b_dw, *cln_g, *cln_b, *w_pw2, *b_pw2, *ln1_g, *ln1_b, *wg, *wu, *wd, *ln2_g, *ln2_b;
    float* out; unsigned char* ws;
};

DEVFN int tid_opaque() { int t = threadIdx.x; asm volatile("" : "+v"(t)); return t; }
DEVFN float wave_sum(float v) {
#pragma unroll
    for (int o = 1; o < 64; o <<= 1) v += __shfl_xor(v, o);
    return v;
}
DEVFN float sigmoidf_(float x) { return __builtin_amdgcn_rcpf(1.0f + __builtin_amdgcn_exp2f(x * -1.4426950408889634f)); }

DEVFN void prep_item(const float* srcA, const float* srcB, int ld, int K, int Nsrc, int mode, half_t* dst, int item, float* scr  , int qrows,
                     const float* lng, const float* lnb, float* cp1, float* cp2, int lane) {
    const int nkb = K / 64, tn = item / nkb, kb = item % nkb, n0 = tn * 32, k0 = kb * 64;
    float* scr2 = scr + 64 * 33;
    { const int n = n0 + (lane & 31); const bool ok = mode == 1 || n < Nsrc;
      const float* colp = mode == 1 ? (((n >> 7) & 1) ? srcB : srcA) + ((n >> 8) * 128 + (n & 127)) : srcA + (ok ? n : 0);
      const float sc_ = !ok ? 0.f : (n < qrows ? 0.18033688011112042f : 1.f);
      float vv[32];
#pragma unroll
      for (int i = 0; i < 32; ++i) vv[i] = colp[(size_t)(k0 + 2 * i + (lane >> 5)) * ld];
#pragma unroll
      for (int i = 0; i < 32; ++i) { const int kk = 2 * i + (lane >> 5); float v = vv[i] * sc_;
          if (lng) { scr2[kk * 33 + (lane & 31)] = v * lnb[k0 + kk]; v *= lng[k0 + kk]; }
          scr[kk * 33 + (lane & 31)] = v; } }
    asm volatile("s_waitcnt lgkmcnt(0)" ::: "memory");
    { const int c = lane & 7;
#pragma unroll
      for (int j = 0; j < 4; ++j) { const int n = (lane >> 3) + 8 * j; const float* sp = scr + (8 * c) * 33 + n; f16x8 h;
#pragma unroll
          for (int e = 0; e < 8; ++e) h[e] = (half_t)sp[e * 33];
          *(f16x8*)(dst + (size_t)(n0 + n) * K + k0 + 8 * c) = h; } }
    if (lng && lane < 32) { float s1 = 0.f, s2 = 0.f;
#pragma unroll 8
        for (int k = 0; k < 64; ++k) { s1 += (float)(half_t)scr[k * 33 + lane]; s2 += scr2[k * 33 + lane]; }
        cp1[(size_t)kb * NC_TOTAL + n0 + lane] = s1; cp2[(size_t)kb * NC_TOTAL + n0 + lane] = s2; }
    asm volatile("s_waitcnt lgkmcnt(0)" ::: "memory");
}

DEVFN void phase_prep(const Params& P, char* lds, int bid, int nb) {
    unsigned char* ws = P.ws;
    float* cp1 = (float*)(ws + OFF_CP1); float* cp2 = (float*)(ws + OFF_CP2);
    const int lane = tid_opaque() & 63, wv = __builtin_amdgcn_readfirstlane(tid_opaque() >> 6), gw = bid * (NTHREADS / 64) + wv, ngw = nb * (NTHREADS / 64);
    float* scr = (float*)lds + wv * (2 * 64 * 33);
    constexpr int T_IN = (NPROJ / 32) * (D / 64), T_SQ = (D / 32) * (D / 64), T_GU = (2 * DFF / 32) * (D / 64), T_DN = (D / 32) * (DFF / 64), T_PW1 = (2 * D / 32) * (D / 64);
    constexpr int TOTAL = T_IN + T_SQ + 2 * T_GU + 2 * T_DN + T_PW1 + T_SQ;
    for (int it = gw; it < TOTAL; it += ngw) {
        int r = it;
        if (r < T_IN) { prep_item(P.w_in, nullptr, NPROJ_VALID, D, NPROJ_VALID, 0, (half_t*)(ws + OFF_W_IN), r, scr, D, nullptr, nullptr, nullptr, nullptr, lane); continue; } r -= T_IN;
        if (r < T_SQ) { prep_item(P.w_o, nullptr, D, D, D, 0, (half_t*)(ws + OFF_W_O), r, scr, 0, nullptr, nullptr, nullptr, nullptr, lane); continue; } r -= T_SQ;
        if (r < T_GU) { prep_item(P.wg, P.wu, DFF, D, DFF, 1, (half_t*)(ws + OFF_W_GU0), r, scr, 0, P.ln1_g, P.ln1_b, cp1 + NC_GU0, cp2 + NC_GU0, lane); continue; } r -= T_GU;
        if (r < T_GU) { prep_item(P.wg + (size_t)D * DFF, P.wu + (size_t)D * DFF, DFF, D, DFF, 1, (half_t*)(ws + OFF_W_GU1), r, scr, 0, P.ln1_g + D, P.ln1_b + D, cp1 + NC_GU1, cp2 + NC_GU1, lane); continue; } r -= T_GU;
        if (r < T_DN) { prep_item(P.wd, nullptr, D, DFF, D, 0, (half_t*)(ws + OFF_W_D0), r, scr, 0, nullptr, nullptr, nullptr, nullptr, lane); continue; } r -= T_DN;
        if (r < T_DN) { prep_item(P.wd + (size_t)DFF * D, nullptr, D, DFF, D, 0, (half_t*)(ws + OFF_W_D1), r, scr, 0, nullptr, nullptr, nullptr, nullptr, lane); continue; } r -= T_DN;
        if (r < T_PW1) { prep_item(P.w_pw1, P.w_pw1 + D, 2 * D, D, D, 1, (half_t*)(ws + OFF_W_PW1), r, scr, 0, P.ln2_g, P.ln2_b, cp1 + NC_PW1, cp2 + NC_PW1, lane); continue; } r -= T_PW1;
        prep_item(P.w_pw2, nullptr, D, D, D, 0, (half_t*)(ws + OFF_W_PW2), r, scr, 0, nullptr, nullptr, nullptr, nullptr, lane);
    }
    half_t* HA = (half_t*)(ws + OFF_HA);
    for (int r0 = gw; r0 < MP; r0 += 4 * ngw) {
        f32x4 v[4][4];
#pragma unroll
        for (int u = 0; u < 4; ++u) { const int r = r0 + u * ngw; const float* src = r < MX ? P.x + (size_t)r * D : (r < MV ? P.meta + (size_t)(r - MX) * D : P.meta);
#pragma unroll
            for (int j = 0; j < 4; ++j) v[u][j] = *(const f32x4*)(src + lane * 4 + 256 * j); }
#pragma unroll
        for (int u = 0; u < 4; ++u) { const int r = r0 + u * ngw; const float z = r < MV ? 1.f : 0.f;
            if (r < MP) {
#pragma unroll
                for (int j = 0; j < 4; ++j) { const f32x4 t = v[u][j] * z; f16x4 h; h[0] = (half_t)t[0]; h[1] = (half_t)t[1]; h[2] = (half_t)t[2]; h[3] = (half_t)t[3];
                    *(f16x4*)(HA + (size_t)r * D + lane * 4 + 256 * j) = h; } } }
    }
}
DEVFN void finish_colconsts(const Params& P, int bid, int nb) {
    const float* cp1 = (const float*)(P.ws + OFF_CP1); const float* cp2 = (const float*)(P.ws + OFF_CP2);
    float* c1 = (float*)(P.ws + OFF_C1); float* c2 = (float*)(P.ws + OFF_C2);
    for (int idx = bid * NTHREADS + tid_opaque(); idx < NC_TOTAL; idx += nb * NTHREADS) {
        float s1 = 0.f, s2 = 0.f;
        for (int tk = 0; tk < 16; ++tk) { s1 += cp1[(size_t)tk * NC_TOTAL + idx]; s2 += cp2[(size_t)tk * NC_TOTAL + idx]; }
        if (idx >= NC_PW1) { const int n = idx - NC_PW1; s2 += P.b_pw1[((n >> 7) & 1) * D + (n >> 8) * 128 + (n & 127)]; }
        c1[idx] = s1; c2[idx] = s2;
    }
}

namespace pg8 {
#define PG8_LAS __attribute__((address_space(3)))
constexpr int BM = 256, BK = 64, HALF = 128, HTB = HALF * BK * 2  , STAGE_BYTES = 8 * HTB, NXCD = 8, WGM = 8;
__host__ __device__ __forceinline__ int lds_byte(int r, int c) { const int st = (r >> 4) * 2 + (c >> 5), rr = r & 15, cc = c & 31, ob = rr * 64 + cc * 2; return st * 1024 + (ob ^ (((ob >> 9) & 1) << 5)); }
__host__ __device__ __forceinline__ void stage_rc(int b, int& R, int& C) { const int st = b / 1024, sb = b % 1024, swz = sb ^ (((sb >> 9) & 1) << 5); R = (st >> 1) * 16 + swz / 64; C = (st & 1) * 32 + (swz % 64) / 2; }
__host__ __device__ __forceinline__ int perm32(int rho) { const int n = rho >> 4, i = rho & 15; return 8 * (i >> 2) + 4 * n + (i & 3); }
struct Unit { int pm, pn; };
struct Gemm { const half_t* A; const half_t* Bt; int M, N, K; };
struct StaticOrder {
    int nM, nN, nwg, G, c;
    __host__ __device__ void init(int M, int N, int G_, int c_) { nM = M / BM; nN = N / BM; nwg = nM * nN; G = G_; c = c_; }
    __host__ __device__ bool next(int i, Unit& u) const {
        const long L = (long)i * G + c; if (L >= nwg) return false;
        int wgid = (int)L; { const int q = nwg / NXCD, r = nwg % NXCD, xcd = wgid % NXCD, off = wgid / NXCD; wgid = (xcd < r ? xcd * (q + 1) : r * (q + 1) + (xcd - r) * q) + off; }
        const int nig = WGM * nN, gid = wgid / nig, fm = gid * WGM, gsz = (nM - fm) < WGM ? (nM - fm) : WGM;
        u.pm = fm + ((wgid % nig) % gsz); u.pn = (wgid % nig) / gsz; return true;
    }
};
template <class Epi, bool ALIGN_EPI = true>
__device__ __forceinline__ void gemm_phase(PG8_LAS unsigned char* lds, const Gemm g, const StaticOrder& S, const Epi& E) {
    int tid = threadIdx.x; asm volatile("" : "+v"(tid));
    const int wid = __builtin_amdgcn_readfirstlane(tid >> 6), lane = tid & 63, wr = wid >> 2, wc = wid & 3, fr = lane & 15, fq = lane >> 4;
    const int K = g.K, nt = K / BK;
    unsigned voffA[2], voffB[2];
#pragma unroll
    for (int i = 0; i < 2; ++i) { int R, C; stage_rc(tid * 16 + i * 8192, R, C); const int Rb = (R & ~31) + perm32(R & 31);
        voffA[i] = (unsigned)(R * K + C) * 2u; voffB[i] = (unsigned)(Rb * K + C) * 2u; }
    const size_t kstep = (size_t)(BK * 2);
    const size_t hstep = (size_t)HALF * K * 2;
    const size_t tstep = 2 * hstep;
    const unsigned ldsw = (unsigned)wid * 1024u;
    const int aoff = lds_byte(wr * 64 + fr, fq * 8), boff = lds_byte(wc * 32 + fr, fq * 8);
#define PG8_SA(b, h) (((b) * 2 + (h)) * HTB)
#define PG8_SB(b, h) ((4 + (b) * 2 + (h)) * HTB)
#define PG8_STAGE(bufoff, gbase, voff) do { _Pragma("unroll") for (int _i = 0; _i < 2; ++_i) \
        __builtin_amdgcn_global_load_lds((const unsigned*)((const char*)(gbase) + (voff)[_i]), (PG8_LAS unsigned*)(lds + (bufoff) + ldsw + _i * 8192), 16, 0, 0); } while (0)
#define PG8_LDA(dst, b, h) do { _Pragma("unroll") for (int m = 0; m < 4; ++m) _Pragma("unroll") for (int k = 0; k < 2; ++k) dst[m][k] = *(const PG8_LAS f16x8*)(lds + PG8_SA(b, h) + aoff + m * 2048 + k * 1024); } while (0)
#define PG8_LDB(dst, b, h) do { _Pragma("unroll") for (int n = 0; n < 2; ++n) _Pragma("unroll") for (int k = 0; k < 2; ++k) dst[n][k] = *(const PG8_LAS f16x8*)(lds + PG8_SB(b, h) + boff + n * 2048 + k * 1024); } while (0)
#define PG8_MMA(ai, bj, At, Bt) do { __builtin_amdgcn_s_setprio(1); _Pragma("unroll") for (int m = 0; m < 4; ++m) _Pragma("unroll") for (int n = 0; n < 2; ++n) _Pragma("unroll") for (int k = 0; k < 2; ++k) \
        acc[ai][bj][m][n] = __builtin_amdgcn_mfma_f32_16x16x32_f16(Bt[n][k], At[m][k], acc[ai][bj][m][n], 0, 0, 0); __builtin_amdgcn_s_setprio(0); } while (0)
#define PG8_WAIT_V(n) asm volatile("s_waitcnt vmcnt(" #n ")" ::: "memory")
#define PG8_WAIT_L(n) asm volatile("s_waitcnt lgkmcnt(" #n ")" ::: "memory")
#define PG8_BAR __builtin_amdgcn_s_barrier()
#define PG8_SCHED __builtin_amdgcn_sched_barrier(0)
    Unit cur, nxt; int ui = 0;
    if (!S.next(0, cur)) return;
    f32x4 acc[2][2][4][2];
#pragma unroll
    for (int a = 0; a < 2; ++a)
#pragma unroll
        for (int b = 0; b < 2; ++b)
#pragma unroll
            for (int m = 0; m < 4; ++m)
#pragma unroll
                for (int n = 0; n < 2; ++n) acc[a][b][m][n] = (f32x4){0.f, 0.f, 0.f, 0.f};
    f16x8 At[4][2], B0[2][2], B1[2][2];
    const char* cA = (const char*)g.A + (size_t)cur.pm * tstep; const char* cB = (const char*)g.Bt + (size_t)cur.pn * tstep;
    E.prepare(cur, 0);
    PG8_STAGE(PG8_SB(0, 0), cB, voffB); PG8_STAGE(PG8_SB(0, 1), cB + hstep, voffB); PG8_STAGE(PG8_SA(0, 0), cA, voffA); PG8_STAGE(PG8_SA(0, 1), cA + hstep, voffA);
    if (wr == 1) PG8_BAR;
    PG8_WAIT_V(2); PG8_BAR;
    PG8_STAGE(PG8_SB(1, 0), cB + kstep, voffB); PG8_STAGE(PG8_SA(1, 0), cA + kstep, voffA); PG8_STAGE(PG8_SB(1, 1), cB + hstep + kstep, voffB);
    PG8_WAIT_V(6); PG8_BAR;
    for (;;) {
        const bool has_next = S.next(ui + 1, nxt);
        const char* nA = has_next ? (const char*)g.A + (size_t)nxt.pm * tstep : cA; const char* nB = has_next ? (const char*)g.Bt + (size_t)nxt.pn * tstep : cB;
        for (int t = 0; t < nt; t += 2) {
            const bool last = (t == nt - 2);
            const char* a1 = cA + (size_t)(t + 1) * kstep;
            const char* a2 = last ? nA : cA + (size_t)(t + 2) * kstep; const char* b2 = last ? nB : cB + (size_t)(t + 2) * kstep;
            const char* a3 = a2 + kstep; const char* b3 = b2 + kstep;
            if (last && has_next) E.prepare(nxt, (ui + 1) & 1);
            PG8_LDB(B0, 0, 0); PG8_LDB(B1, 0, 1); PG8_SCHED; PG8_LDA(At, 0, 0); PG8_STAGE(PG8_SA(1, 1), a1 + hstep, voffA);
            PG8_WAIT_V(8); PG8_WAIT_L(0); PG8_BAR; PG8_MMA(0, 0, At, B0); PG8_MMA(0, 1, At, B1); PG8_BAR; PG8_SCHED;
            PG8_LDA(At, 0, 1); PG8_STAGE(PG8_SB(0, 0), b2, voffB); PG8_STAGE(PG8_SB(0, 1), b2 + hstep, voffB); PG8_STAGE(PG8_SA(0, 0), a2, voffA);
            PG8_WAIT_V(8); PG8_WAIT_L(0); PG8_BAR; PG8_MMA(1, 0, At, B0); PG8_MMA(1, 1, At, B1); PG8_BAR; PG8_SCHED;
            PG8_LDB(B0, 1, 0); PG8_LDB(B1, 1, 1); PG8_SCHED; PG8_LDA(At, 1, 0); PG8_STAGE(PG8_SA(0, 1), a2 + hstep, voffA);
            PG8_WAIT_V(8); PG8_WAIT_L(0); PG8_BAR; PG8_MMA(0, 0, At, B0); PG8_MMA(0, 1, At, B1); PG8_BAR; PG8_SCHED;
            PG8_LDA(At, 1, 1); PG8_STAGE(PG8_SB(1, 0), b3, voffB); PG8_STAGE(PG8_SB(1, 1), b3 + hstep, voffB); PG8_STAGE(PG8_SA(1, 0), a3, voffA);
            PG8_WAIT_V(8); PG8_WAIT_L(0); PG8_BAR; PG8_MMA(1, 0, At, B0); PG8_MMA(1, 1, At, B1); PG8_BAR; PG8_SCHED;
        }
        if constexpr (ALIGN_EPI) { if (wr == 0) PG8_BAR; }
        E(acc, cur, ui & 1, wr, wc, fr, fq);
        if (!has_next) break;
#pragma unroll
        for (int a = 0; a < 2; ++a)
#pragma unroll
            for (int b = 0; b < 2; ++b)
#pragma unroll
                for (int m = 0; m < 4; ++m)
#pragma unroll
                    for (int n = 0; n < 2; ++n) acc[a][b][m][n] = (f32x4){0.f, 0.f, 0.f, 0.f};
        cur = nxt; cA = nA; cB = nB; ++ui;
        if constexpr (ALIGN_EPI) { if (wr == 1) PG8_BAR; }
    }
    PG8_WAIT_V(0);
    if constexpr (!ALIGN_EPI) { if (wr == 0) PG8_BAR; }
    PG8_BAR;
#undef PG8_SA
#undef PG8_SB
#undef PG8_STAGE
#undef PG8_LDA
#undef PG8_LDB
#undef PG8_MMA
#undef PG8_WAIT_V
#undef PG8_WAIT_L
#undef PG8_BAR
#undef PG8_SCHED
}
}

typedef f32x4 acc_t[2][2][4][2];
DEVFN f16x8 pack8(f32x4 a, f32x4 b) { f16x8 h; h[0] = (half_t)a[0]; h[1] = (half_t)a[1]; h[2] = (half_t)a[2]; h[3] = (half_t)a[3]; h[4] = (half_t)b[0]; h[5] = (half_t)b[1]; h[6] = (half_t)b[2]; h[7] = (half_t)b[3]; return h; }
DEVFN f32x4 silu4(f32x4 g) { f32x4 o; o[0] = g[0] * sigmoidf_(g[0]); o[1] = g[1] * sigmoidf_(g[1]); o[2] = g[2] * sigmoidf_(g[2]); o[3] = g[3] * sigmoidf_(g[3]); return o; }
DEVFN f32x4 sigm4(f32x4 g) { f32x4 o; o[0] = sigmoidf_(g[0]); o[1] = sigmoidf_(g[1]); o[2] = sigmoidf_(g[2]); o[3] = sigmoidf_(g[3]); return o; }
struct EpiStoreF16 { half_t* O; int ld;
    DEVFN void prepare(const pg8::Unit&, int) const {}
    DEVFN void operator()(const acc_t& acc, const pg8::Unit& u, int, int wr, int wc, int fr, int fq) const {
        const int row0 = u.pm * 256 + wr * 64 + fr, col0 = u.pn * 256 + wc * 32 + 8 * fq;
#pragma unroll
        for (int ai = 0; ai < 2; ++ai)
#pragma unroll
            for (int m = 0; m < 4; ++m) { half_t* rowp = O + (size_t)(row0 + ai * 128 + m * 16) * ld + col0;
#pragma unroll
                for (int bj = 0; bj < 2; ++bj) *(f16x8*)(rowp + bj * 128) = pack8(acc[ai][bj][m][0], acc[ai][bj][m][1]); }
    } };
struct EpiProj { half_t* O; int ld; half_t* VT; half_t* VTM;
    DEVFN void prepare(const pg8::Unit&, int) const {}
    DEVFN void operator()(const acc_t& acc, const pg8::Unit& u, int, int wr, int wc, int fr, int fq) const {
        const int row0 = u.pm * 256 + wr * 64 + fr, col0 = u.pn * 256 + wc * 32 + 8 * fq;
#pragma unroll
        for (int ai = 0; ai < 2; ++ai)
#pragma unroll
            for (int m = 0; m < 4; ++m) { half_t* rowp = O + (size_t)(row0 + ai * 128 + m * 16) * ld + col0;
#pragma unroll
                for (int bj = 0; bj < 2; ++bj) *(f16x8*)(rowp + bj * 128) = pack8(acc[ai][bj][m][0], acc[ai][bj][m][1]); }
        if (u.pn >= 8 && u.pn < 12) {
            const int sw = (fr & 3) | ((fr & 4) << 1) | ((fr & 8) >> 1);
#pragma unroll
            for (int ai = 0; ai < 2; ++ai)
#pragma unroll
                for (int m = 0; m < 4; ++m) { const int row = row0 + ai * 128 + m * 16;
                    half_t* base; size_t dstride;
                    if (row < MX) { base = VT + (size_t)(row >> 11) * 1024 * SEQ + (((row & 2047) & ~15) | sw); dstride = SEQ; }
                    else { base = VTM + (((row - MX) & ~15) | sw); dstride = 256; }
#pragma unroll
                    for (int bj = 0; bj < 2; ++bj)
#pragma unroll
                        for (int n = 0; n < 2; ++n)
#pragma unroll
                            for (int e = 0; e < 4; ++e) base[(size_t)(col0 - COL_V + bj * 128 + 4 * n + e) * dstride] = (half_t)acc[ai][bj][m][n][e]; }
        }
    } };
constexpr int TAB_OFF = 131072;
DEVFN void rowstat_fill(const float* st, int pm, char* lds, int parity) {
    const int t = tid_opaque();
    if (t < 256) { const f32x4* p = (const f32x4*)(st + (size_t)(pm * 256 + t) * 32); float s = 0.f, q = 0.f;
#pragma unroll
        for (int i = 0; i < 8; ++i) { const f32x4 v = p[i]; s += v[0] + v[2]; q += v[1] + v[3]; }
        const float mean = s * (1.f / D), var = fmaxf(q * (1.f / D) - mean * mean, 0.f);
        float* tab = (float*)(lds + TAB_OFF) + parity * 512;
        tab[2 * t] = mean; tab[2 * t + 1] = 1.0f / sqrtf(var + LN_EPS); }
}
DEVFN void stat_acc(const f16x8 h, float& s, float& q) {
#pragma unroll
    for (int i = 0; i < 8; ++i) { const float v = (float)h[i]; s += v; q = fmaf(v, v, q); }
}
DEVFN void stat_store(float* st, int row, int slot, float s, float q, int fq) {
    s += __shfl_xor(s, 16); s += __shfl_xor(s, 32); q += __shfl_xor(q, 16); q += __shfl_xor(q, 32);
    if (fq == 0) { float* p = st + (size_t)row * 32 + slot * 2; p[0] = s; p[1] = q; }
}
struct EpiLnSwiGLU { half_t* O; int ld; const float* st; const float* c1; const float* c2; char* lds;
    DEVFN void prepare(const pg8::Unit& u, int parity) const { rowstat_fill(st, u.pm, lds, parity); }
    DEVFN void operator()(const acc_t& acc, const pg8::Unit& u, int parity, int wr, int wc, int fr, int fq) const {
        const int rl0 = wr * 64 + fr, col0 = u.pn * 128 + wc * 32 + 8 * fq, n0 = u.pn * 256 + wc * 32 + 8 * fq;
        const float* tab = (const float*)(lds + TAB_OFF) + parity * 512;
        f32x4 k1[2][2], k2[2][2];
#pragma unroll
        for (int bj = 0; bj < 2; ++bj)
#pragma unroll
            for (int n = 0; n < 2; ++n) { k1[bj][n] = *(const f32x4*)(c1 + n0 + bj * 128 + 4 * n); k2[bj][n] = *(const f32x4*)(c2 + n0 + bj * 128 + 4 * n); }
#pragma unroll
        for (int ai = 0; ai < 2; ++ai)
#pragma unroll
            for (int m = 0; m < 4; ++m) { const int rl = rl0 + ai * 128 + m * 16; const float mean = tab[2 * rl], rstd = tab[2 * rl + 1];
                f32x4 g[2], up[2];
#pragma unroll
                for (int n = 0; n < 2; ++n) { g[n] = (acc[ai][0][m][n] - k1[0][n] * mean) * rstd + k2[0][n]; up[n] = (acc[ai][1][m][n] - k1[1][n] * mean) * rstd + k2[1][n]; }
                *(f16x8*)(O + (size_t)(u.pm * 256 + rl) * ld + col0) = pack8(silu4(g[0]) * up[0], silu4(g[1]) * up[1]); }
    } };
struct EpiLnGLU { half_t* O; int ld; const float* st; const float* c1; const float* c2; char* lds;
    DEVFN void prepare(const pg8::Unit& u, int parity) const { rowstat_fill(st, u.pm, lds, parity); }
    DEVFN void operator()(const acc_t& acc, const pg8::Unit& u, int parity, int wr, int wc, int fr, int fq) const {
        const int rl0 = wr * 64 + fr, col0 = u.pn * 128 + wc * 32 + 8 * fq, n0 = u.pn * 256 + wc * 32 + 8 * fq;
        const float* tab = (const float*)(lds + TAB_OFF) + parity * 512;
        f32x4 k1[2][2], k2[2][2];
#pragma unroll
        for (int bj = 0; bj < 2; ++bj)
#pragma unroll
            for (int n = 0; n < 2; ++n) { k1[bj][n] = *(const f32x4*)(c1 + n0 + bj * 128 + 4 * n); k2[bj][n] = *(const f32x4*)(c2 + n0 + bj * 128 + 4 * n); }
#pragma unroll
        for (int ai = 0; ai < 2; ++ai)
#pragma unroll
            for (int m = 0; m < 4; ++m) { const int rl = rl0 + ai * 128 + m * 16; const float mean = tab[2 * rl], rstd = tab[2 * rl + 1];
                f32x4 a[2], sg[2];
#pragma unroll
                for (int n = 0; n < 2; ++n) { a[n] = (acc[ai][0][m][n] - k1[0][n] * mean) * rstd + k2[0][n]; sg[n] = (acc[ai][1][m][n] - k1[1][n] * mean) * rstd + k2[1][n]; }
                *(f16x8*)(O + (size_t)(u.pm * 256 + rl) * ld + col0) = pack8(a[0] * sigm4(sg[0]), a[1] * sigm4(sg[1])); }
    } };
struct EpiResidX { const float* x; const float* meta; half_t* Y; float* sto;
    DEVFN void prepare(const pg8::Unit&, int) const {}
    DEVFN void operator()(const acc_t& acc, const pg8::Unit& u, int, int wr, int wc, int fr, int fq) const {
        const int row0 = u.pm * 256 + wr * 64 + fr, col0 = u.pn * 256 + wc * 32 + 8 * fq;
#pragma unroll
        for (int ai = 0; ai < 2; ++ai)
#pragma unroll
            for (int m = 0; m < 4; ++m) { const int row = row0 + ai * 128 + m * 16;
                const float* src = row < MX ? x + (size_t)row * D : (row < MV ? meta + (size_t)(row - MX) * D : nullptr);
                float s = 0.f, q = 0.f;
#pragma unroll
                for (int bj = 0; bj < 2; ++bj) { const int col = col0 + bj * 128;
                    const f32x4 r0 = src ? *(const f32x4*)(src + col) : (f32x4){0.f, 0.f, 0.f, 0.f}, r1 = src ? *(const f32x4*)(src + col + 4) : (f32x4){0.f, 0.f, 0.f, 0.f};
                    const f16x8 h = pack8(r0 * ALPHA + acc[ai][bj][m][0], r1 * ALPHA + acc[ai][bj][m][1]);
                    *(f16x8*)(Y + (size_t)row * D + col) = h; stat_acc(h, s, q); }
                stat_store(sto, row, u.pn * 4 + wc, s, q, fq); }
    } };
struct EpiResidLN { half_t* Y; const float* sti; float* sto; const float* g; const float* b; const float* bias; char* lds;
    DEVFN void prepare(const pg8::Unit& u, int parity) const { rowstat_fill(sti, u.pm, lds, parity); }
    DEVFN void operator()(const acc_t& acc, const pg8::Unit& u, int parity, int wr, int wc, int fr, int fq) const {
        const int rl0 = wr * 64 + fr, col0 = u.pn * 256 + wc * 32 + 8 * fq;
        const float* tab = (const float*)(lds + TAB_OFF) + parity * 512;
        f32x4 gg[2][2], bb[2][2];
#pragma unroll
        for (int bj = 0; bj < 2; ++bj)
#pragma unroll
            for (int n = 0; n < 2; ++n) { const int c = col0 + bj * 128 + 4 * n; gg[bj][n] = *(const f32x4*)(g + c) * ALPHA;
                bb[bj][n] = *(const f32x4*)(b + c) * ALPHA; if (bias) bb[bj][n] += *(const f32x4*)(bias + c); }
#pragma unroll
        for (int ai = 0; ai < 2; ++ai)
#pragma unroll
            for (int m = 0; m < 4; ++m) { const int rl = rl0 + ai * 128 + m * 16, row = u.pm * 256 + rl; const float mean = tab[2 * rl], rstd = tab[2 * rl + 1];
                float s = 0.f, q = 0.f;
#pragma unroll
                for (int bj = 0; bj < 2; ++bj) { half_t* yp = Y + (size_t)row * D + col0 + bj * 128; const f16x8 yv = *(const f16x8*)yp;
                    f32x4 y0, y1;
#pragma unroll
                    for (int e = 0; e < 4; ++e) { y0[e] = ((float)yv[e] - mean) * rstd; y1[e] = ((float)yv[4 + e] - mean) * rstd; }
                    const f16x8 h = pack8(y0 * gg[bj][0] + bb[bj][0] + acc[ai][bj][m][0], y1 * gg[bj][1] + bb[bj][1] + acc[ai][bj][m][1]);
                    *(f16x8*)yp = h; stat_acc(h, s, q); }
                stat_store(sto, row, u.pn * 4 + wc, s, q, fq); }
    } };
template <class Epi>
DEVFN void gemm_phase(const half_t* A, const half_t* Bt, int M, int N, int K, const Epi& epi, char* lds, int bid, int nb) {
    pg8::Gemm g{A, Bt, M, N, K}; pg8::StaticOrder S; S.init(M, N, nb, bid);
    pg8::gemm_phase<Epi, true>((PG8_LAS unsigned char*)lds, g, S, epi);
}

DEVFN void meta_rowstat(const float* st, int row, float& mean, float& rstd) {
    const f32x4* p = (const f32x4*)(st + (size_t)row * 32); float s = 0.f, q = 0.f;
#pragma unroll
    for (int i = 0; i < 8; ++i) { const f32x4 v = p[i]; s += v[0] + v[2]; q += v[1] + v[3]; }
    mean = s * (1.f / D); rstd = 1.0f / sqrtf(fmaxf(q * (1.f / D) - mean * mean, 0.f) + LN_EPS);
}
template <int MODE>
DEVFN void meta_rows_gemm(const Params& P, const half_t* A  , const half_t* Bt, int K, const float* sti, float* sto, const float* c1, const float* c2,
                          const float* lg, const float* lb, const float* bias, half_t* O, char* lds, int bid) {
    constexpr int NT = (MODE == 0 || MODE == 2) ? 4 : 2;
    const int ntask = MODE == 1 ? DFF / 16 : (MODE == 3 ? D / 16 : D / 64);
    if (bid >= ntask) return;
    const int tid = tid_opaque(), lane = tid & 63, wid = __builtin_amdgcn_readfirstlane(tid >> 6), fr = lane & 15, fq = lane >> 4;
    int rowg[NT];
    if (MODE == 0 || MODE == 2) { for (int t = 0; t < NT; ++t) rowg[t] = 64 * bid + 16 * t; }
    else { const int j0 = 16 * bid; rowg[0] = 256 * (j0 >> 7) + (j0 & 127); rowg[1] = rowg[0] + 128; }
    f32x4 acc[NT];
#pragma unroll
    for (int t = 0; t < NT; ++t) acc[t] = (f32x4){0.f, 0.f, 0.f, 0.f};
    const int kw = K / 8, kbeg = wid * kw;
    const half_t* ap = A + (size_t)(MX + fr) * K + kbeg + fq * 8;
    for (int k0 = 0; k0 < kw; k0 += 32) {
        const f16x8 af = *(const f16x8*)(ap + k0);
#pragma unroll
        for (int t = 0; t < NT; ++t) { const f16x8 bf = *(const f16x8*)(Bt + (size_t)(rowg[t] + fr) * K + kbeg + fq * 8 + k0);
            acc[t] = __builtin_amdgcn_mfma_f32_16x16x32_f16(bf, af, acc[t], 0, 0, 0); }
    }
    f32x4* red = (f32x4*)lds;
#pragma unroll
    for (int t = 0; t < NT; ++t) red[(wid * NT + t) * 64 + lane] = acc[t];
    __syncthreads();
    if (wid == 0) {
#pragma unroll
        for (int t = 0; t < NT; ++t) { f32x4 s = red[t * 64 + lane];
#pragma unroll
            for (int w = 1; w < 8; ++w) s += red[(w * NT + t) * 64 + lane];
            acc[t] = s; }
        const int row = MX + fr;
        if (MODE == 0) {
            float s = 0.f, q = 0.f;
#pragma unroll
            for (int t = 0; t < NT; ++t) { const int col = rowg[t] + 4 * fq; const f32x4 y = *(const f32x4*)(P.meta + (size_t)fr * D + col) * ALPHA + acc[t];
                f16x4 h; h[0] = (half_t)y[0]; h[1] = (half_t)y[1]; h[2] = (half_t)y[2]; h[3] = (half_t)y[3]; *(f16x4*)(O + (size_t)row * D + col) = h;
#pragma unroll
                for (int e = 0; e < 4; ++e) { const float v = (float)h[e]; s += v; q = fmaf(v, v, q); } }
            stat_store(sto, row, bid, s, q, fq);
        } else if (MODE == 2) {
            float mean, rstd; meta_rowstat(sti, row, mean, rstd);
            float s = 0.f, q = 0.f;
#pragma unroll
            for (int t = 0; t < NT; ++t) { const int col = rowg[t] + 4 * fq; half_t* yp = O + (size_t)row * D + col; const f16x4 yv = *(const f16x4*)yp;
                const f32x4 g = *(const f32x4*)(lg + col), bb = *(const f32x4*)(lb + col), bi = bias ? *(const f32x4*)(bias + col) : (f32x4){0.f, 0.f, 0.f, 0.f};
                f16x4 h;
#pragma unroll
                for (int e = 0; e < 4; ++e) { const float hn = (((float)yv[e] - mean) * rstd * g[e] + bb[e]) * ALPHA + bi[e] + acc[t][e]; h[e] = (half_t)hn; const float v = (float)h[e]; s += v; q = fmaf(v, v, q); }
                *(f16x4*)yp = h; }
            stat_store(sto, row, bid, s, q, fq);
        } else {
            float mean, rstd; meta_rowstat(sti, row, mean, rstd);
            const int j0 = 16 * bid + 4 * fq;
            const f32x4 ka1 = *(const f32x4*)(c1 + rowg[0] + 4 * fq), ka2 = *(const f32x4*)(c2 + rowg[0] + 4 * fq), kb1 = *(const f32x4*)(c1 + rowg[1] + 4 * fq), kb2 = *(const f32x4*)(c2 + rowg[1] + 4 * fq);
            const f32x4 a = (acc[0] - ka1 * mean) * rstd + ka2, bq = (acc[1] - kb1 * mean) * rstd + kb2;
            const f32x4 o = MODE == 1 ? silu4(a) * bq : a * sigm4(bq);
            f16x4 h; h[0] = (half_t)o[0]; h[1] = (half_t)o[1]; h[2] = (half_t)o[2]; h[3] = (half_t)o[3];
            *(f16x4*)(O + (size_t)row * (MODE == 1 ? DFF : D) + j0) = h;
        }
    }
    __syncthreads();
}

DEVFN void phase_final_ln(const Params& P, const float* st, const float* g, const float* b, int bid, int nb) {
    const half_t* Y = (const half_t*)(P.ws + OFF_Y);
    const int lane = tid_opaque() & 63, gw = bid * (NTHREADS / 64) + (tid_opaque() >> 6), ngw = nb * (NTHREADS / 64);
    f32x4 gg[2][2], bb[2][2];
#pragma unroll
    for (int j = 0; j < 2; ++j)
#pragma unroll
        for (int e = 0; e < 2; ++e) { gg[j][e] = *(const f32x4*)(g + lane * 8 + 512 * j + 4 * e); bb[j][e] = *(const f32x4*)(b + lane * 8 + 512 * j + 4 * e); }
    for (int r0 = gw; r0 < MX; r0 += 4 * ngw) {
        float s[4], q[4]; f16x8 yv[4][2];
#pragma unroll
        for (int u = 0; u < 4; ++u) { const int r = r0 + u * ngw;
            s[u] = st[(size_t)r * 32 + (lane & 15) * 2]; q[u] = st[(size_t)r * 32 + (lane & 15) * 2 + 1];
#pragma unroll
            for (int j = 0; j < 2; ++j) yv[u][j] = *(const f16x8*)(Y + (size_t)r * D + lane * 8 + 512 * j); }
#pragma unroll
        for (int u = 0; u < 4; ++u) { const int r = r0 + u * ngw;
#pragma unroll
            for (int o = 1; o < 16; o <<= 1) { s[u] += __shfl_xor(s[u], o); q[u] += __shfl_xor(q[u], o); }
            const float mean = s[u] * (1.f / D), rstd = 1.0f / sqrtf(fmaxf(q[u] * (1.f / D) - mean * mean, 0.f) + LN_EPS);
#pragma unroll
            for (int j = 0; j < 2; ++j) { f32x4 o0, o1;
#pragma unroll
                for (int e = 0; e < 4; ++e) { o0[e] = ((float)yv[u][j][e] - mean) * rstd; o1[e] = ((float)yv[u][j][4 + e] - mean) * rstd; }
                float* op = P.out + (size_t)r * D + lane * 8 + 512 * j;
                *(f32x4*)op = o0 * gg[j][0] + bb[j][0]; *(f32x4*)(op + 4) = o1 * gg[j][1] + bb[j][1]; } }
    }
}

DEVFN int key_row(int b, int p) { return p < NMETA ? MX + p : b * SEQ + p - NMETA; }
constexpr int IDX_ROW = 2116;
DEVFN int half_sum_i(int v) {
#pragma unroll
    for (int o = 1; o < 32; o <<= 1) v += __shfl_xor(v, o);
    return v;
}
DEVFN void phase_indexer(const Params& P, char* lds, int bid, int nb) {
    float* sc = (float*)lds;
    const half_t* proj = (const half_t*)(P.ws + OFF_BIG);
    unsigned long long* maskt = (unsigned long long*)(P.ws + OFF_MASK);
    const int wid = __builtin_amdgcn_readfirstlane(tid_opaque() >> 6);
    for (int L = bid; L < NBATCH * (SEQ / 16); L += nb) {
        const int tid = tid_opaque(), lane = tid & 63, fr = lane & 15, quad = lane >> 4;
        const int i = (SEQ / 16 - 1) - (L >> 4), b = L & 15, s0 = 16 * i;
        if (s0 + 32 <= 256) {
            const int q = tid >> 5, s = s0 + q;
            for (int k = tid & 31; k < 33; k += 32) {
                unsigned long long bits;
                if (k == 0) bits = 0xFFFFull;
                else { const int base = 64 * (k - 1); bits = (s >= base + 63) ? ~0ull : (s < base ? 0ull : ((2ull << (s - base)) - 1ull)); }
                maskt[((size_t)b * 33 + k) * SEQ + s] = bits;
            }
            continue;
        }
        {
            const half_t* qrow = proj + (size_t)(b * SEQ + s0 + fr) * NPROJ;
            f16x8 bq[8][2];
#pragma unroll
            for (int h = 0; h < 8; ++h)
#pragma unroll
                for (int kh = 0; kh < 2; ++kh) bq[h][kh] = *(const f16x8*)(qrow + COL_QI + h * 64 + kh * 32 + quad * 8);
            float w[8]; { const f16x8 wv = *(const f16x8*)(qrow + COL_WI);
#pragma unroll
                for (int h = 0; h < 8; ++h) w[h] = (float)wv[h] * 0.04419417382415922f; }
            const int nblk = i + 2;
            int j = wid;
            const half_t* kp = proj + (size_t)(j == 0 ? MX + fr : b * SEQ + 16 * (j - 1) + fr) * NPROJ + COL_KI + quad * 8;
            f16x8 a0 = *(const f16x8*)kp, a1 = *(const f16x8*)(kp + 32);
            for (; j < nblk; j += 8) {
                const int jn = (j + 8 < nblk) ? j + 8 : j;
                const half_t* kn = proj + (size_t)(jn == 0 ? MX + fr : b * SEQ + 16 * (jn - 1) + fr) * NPROJ + COL_KI + quad * 8;
                const f16x8 n0 = *(const f16x8*)kn, n1 = *(const f16x8*)(kn + 32);
                f32x4 s4 = (f32x4){0.f, 0.f, 0.f, 0.f};
#pragma unroll
                for (int h = 0; h < 8; ++h) {
                    f32x4 acc = __builtin_amdgcn_mfma_f32_16x16x32_f16(a0, bq[h][0], (f32x4){0.f, 0.f, 0.f, 0.f}, 0, 0, 0);
                    acc = __builtin_amdgcn_mfma_f32_16x16x32_f16(a1, bq[h][1], acc, 0, 0, 0);
#pragma unroll
                    for (int e = 0; e < 4; ++e) s4[e] = fmaf(w[h], fmaxf(acc[e], 0.f), s4[e]);
                }
                s4 = s4 + 0.0f;
                const int slot = (j == 0 ? 0 : 64 + 16 * (j - 1)) + 4 * quad;
                *(f32x4*)(sc + fr * IDX_ROW + slot) = s4;
                a0 = n0; a1 = n1;
            }
        }
        __syncthreads();
#pragma unroll 1
        for (int qi2 = 0; qi2 < 2; ++qi2) {
            const int ln = tid_opaque() & 63, qq = 2 * wid + qi2, sq = s0 + qq;
            typedef __attribute__((address_space(3))) unsigned lds_u32;
            typedef unsigned u32x4 __attribute__((ext_vector_type(4)));
            lds_u32* hist = (lds_u32*)(__attribute__((address_space(3))) char*)lds + qq * IDX_ROW;
            const float* row = sc + qq * IDX_ROW;
            float v[33]; float vmin = INFINITY, vmax = -INFINITY;
#pragma unroll
            for (int j = 0; j < 33; ++j) { const int slot = 64 * j + ln; const bool valid = (slot < 16) | ((slot >= 64) & (slot - 64 <= sq));
                const float ld_ = row[slot];
                const float x = valid ? ld_ : -INFINITY; v[j] = x; vmax = fmaxf(vmax, x); vmin = fminf(vmin, valid ? x : INFINITY); }
#pragma unroll
            for (int o = 1; o < 64; o <<= 1) { vmin = fminf(vmin, __shfl_xor(vmin, o)); vmax = fmaxf(vmax, __shfl_xor(vmax, o)); }
#pragma unroll
            for (int k = 0; k < 8; ++k) *(__attribute__((address_space(3))) u32x4*)(hist + 256 * k + 4 * ln) = (u32x4){0u, 0u, 0u, 0u};
            const float range = vmax - vmin, scale = range > 0.f ? 2047.0f / range : 0.f;
            unsigned bins[17];
#pragma unroll
            for (int j = 0; j < 33; ++j) { const unsigned key = v[j] > -INFINITY ? 1u : 0u;
                int t_ = (int)(((key ? v[j] : vmin) - vmin) * scale); t_ = t_ > 2047 ? 2047 : t_;
                __hip_atomic_fetch_add(hist + (key ? t_ : 2048 + ln), 1u, __ATOMIC_RELAXED, __HIP_MEMORY_SCOPE_WORKGROUP);
                const unsigned bn1 = key ? (unsigned)t_ + 1u : 0u;
                if (j & 1) bins[j >> 1] |= bn1 << 16; else bins[j >> 1] = bn1;
                const unsigned u_ = __float_as_uint(v[j]); v[j] = __uint_as_float(u_ ^ (((unsigned)((int)u_ >> 31)) | 0x80000000u)); }
            unsigned tot = 0u;
#pragma unroll
            for (int k = 0; k < 8; ++k) { const u32x4 hq = *(const __attribute__((address_space(3))) u32x4*)(hist + 2016 - 32 * ln + 4 * k); tot += (hq[0] + hq[1]) + (hq[2] + hq[3]); }
            unsigned incl = tot;
#pragma unroll
            for (int o = 1; o < 64; o <<= 1) { const unsigned t_ = __shfl_up(incl, o); incl += ln >= o ? t_ : 0u; }
            const unsigned excl = incl - tot;
            int src = __ffsll((long long)__ballot((excl < 256u) & (256u <= incl))) - 1;
            const unsigned exclO = __shfl(excl, src);
            const int top = 2047 - 32 * src;
            const unsigned cb_ = hist[top - (ln & 31)], c1_ = ln < 32 ? cb_ : 0u;
            unsigned incl2 = c1_;
#pragma unroll
            for (int o = 1; o < 64; o <<= 1) { const unsigned t_ = __shfl_up(incl2, o); incl2 += ln >= o ? t_ : 0u; }
            const unsigned excl2 = incl2 - c1_ + exclO;
            src = __ffsll((long long)__ballot((excl2 < 256u) & (256u <= excl2 + c1_))) - 1;
            const int Bsel = top - src; const unsigned above = __shfl(excl2, src), cB = __shfl(c1_, src);
            const unsigned ub1 = (unsigned)Bsel + 1u;
            int rleft = (int)(256u - above);
            const unsigned allB = rleft >= (int)cB ? 1u : 0u;
            rleft = allB ? 0 : rleft;
            unsigned selm0 = 0u, selm1 = 0u;
            while (rleft > 0) {
                unsigned bk = 0u, bp = 0u;
#pragma unroll
                for (int j = 0; j < 33; ++j) { const unsigned bn1 = (j & 1) ? (bins[j >> 1] >> 16) : (bins[j >> 1] & 0xFFFFu);
                    const unsigned sm = j < 32 ? selm0 : selm1;
                    const unsigned k2 = (bn1 << 1) | ((sm >> (j & 31)) & 1u);
                    const unsigned kk = k2 == (ub1 << 1) ? __float_as_uint(v[j]) : 0u;
                    bp = kk > bk ? (unsigned)j : bp; bk = kk > bk ? kk : bk; }
                bp = (bp << 6) + (unsigned)ln;
                unsigned long long best = ((unsigned long long)bk << 32) | (0xFFFFFFFFu - bp);
#pragma unroll
                for (int o = 1; o < 64; o <<= 1) { const unsigned long long ot = __shfl_xor(best, o); best = ot > best ? ot : best; }
                const unsigned wp = 0xFFFFFFFFu - (unsigned)best, wj = wp >> 6;
                const unsigned bit = (((wp & 63u) == (unsigned)ln) & ((unsigned)(best >> 32) != 0u)) ? (1u << (wj & 31u)) : 0u;
                selm0 |= wj < 32u ? bit : 0u; selm1 |= wj >= 32u ? bit : 0u;
                rleft -= 1;
            }
            unsigned long long myw = 0ull;
            const unsigned thr2 = (ub1 << 1) | 1u;
#pragma unroll
            for (int j = 0; j < 33; ++j) { const unsigned bn1 = (j & 1) ? (bins[j >> 1] >> 16) : (bins[j >> 1] & 0xFFFFu);
                const unsigned sm = j < 32 ? selm0 : selm1;
                const unsigned k2 = (bn1 << 1) | allB | ((sm >> (j & 31)) & 1u);
                const unsigned long long sb = __ballot(k2 >= thr2);
                myw = ln == j ? sb : myw; }
            if (ln < 33) maskt[((size_t)b * 33 + ln) * SEQ + sq] = myw;
        }
        __syncthreads();
    }
}

DEVFN int t5_bucket(int d) {
    if (d < 16) return d;
    const int bd[15] = {19, 21, 24, 27, 31, 35, 40, 46, 52, 59, 67, 77, 87, 99, 113};
    int b = 16;
#pragma unroll
    for (int i = 0; i < 15; ++i) b += (d >= bd[i]) ? 1 : 0;
    return b;
}
constexpr float LOG2E = 1.4426950408889634f;
constexpr float QSCALE = 0.125f * LOG2E;
typedef float f32x16 __attribute__((ext_vector_type(16)));
#define ATT_LAS __attribute__((address_space(3)))
constexpr int ATT_K = 0, ATT_V = 24576, ATT_DL = 49152, ATT_M = 50176, ATT_LDS = ATT_M + 33 * 2048;
DEVFN void attn_unit(const Params& P, char* lds, int b, int h, int qb) {
    const int tid = tid_opaque(), lane = tid & 63, wid = __builtin_amdgcn_readfirstlane(tid >> 6), r32 = lane & 31, hi = lane >> 5;
    const half_t* proj = (const half_t*)(P.ws + OFF_BIG);
    const half_t* VT = (const half_t*)P.out; const half_t* VTM = VT + VT_ELEMS;
    const unsigned long long* maskt = (const unsigned long long*)(P.ws + OFF_MASK) + (size_t)b * 33 * SEQ;
    ATT_LAS char* L = (ATT_LAS char*)lds;
    float* dl = (float*)(lds + ATT_DL);
    const int sq = 256 * qb + 32 * wid + r32;
    const int NT = 4 * qb + 5;
    if (tid < 129) dl[tid] = tid < 128 ? (P.rel_bias[t5_bucket(tid) * 16 + h] - P.rel_bias[31 * 16 + h]) * LOG2E : 0.f;
    f16x8 qf[4];
#pragma unroll
    for (int d0 = 0; d0 < 4; ++d0) qf[d0] = *(const f16x8*)(proj + ((size_t)b * SEQ + sq) * NPROJ + h * 64 + 16 * d0 + 8 * hi);
    const int drow = wid * 8 + (lane >> 3), dch = (lane & 7) ^ ((drow >> 1) & 7);
    const half_t* ksrc_m = proj + (size_t)(MX + drow) * NPROJ + COL_K + h * 64 + dch * 8;
    const half_t* ksrc_x = proj + ((size_t)b * SEQ + drow) * NPROJ + COL_K + h * 64 + dch * 8;
    const half_t* vsrc_m = VTM + (size_t)(h * 64 + drow) * 256 + dch * 8;
    const half_t* vsrc_x = VT + ((size_t)(b * 16 + h) * 64 + drow) * SEQ + dch * 8;
#define ATT_DMA_K(tt, slot) do { const half_t* ks_ = (tt) == 0 ? ksrc_m : ksrc_x + (size_t)((tt) - 1) * 64 * NPROJ; \
        __builtin_amdgcn_global_load_lds((const unsigned*)ks_, (ATT_LAS unsigned*)(L + ATT_K + (slot) * 8192 + wid * 1024), 16, 0, 0); } while (0)
#define ATT_DMA_V(tt, slot) do { const half_t* vs_ = (tt) == 0 ? vsrc_m : vsrc_x + ((tt) - 1) * 64; \
        __builtin_amdgcn_global_load_lds((const unsigned*)vs_, (ATT_LAS unsigned*)(L + ATT_V + (slot) * 8192 + wid * 1024), 16, 0, 0); } while (0)
    int foff[8];
#pragma unroll
    for (int c = 0; c < 8; ++c) foff[c] = r32 * 128 + (((c) ^ ((r32 >> 1) & 7)) * 16);
    float mhat = 0.f;
    f32x16 o0, o1;
#pragma unroll
    for (int r = 0; r < 16; ++r) { o0[r] = 0.f; o1[r] = 0.f; }
    constexpr float THR = 8.0f;
    f32x16 negm, ol;
#pragma unroll
    for (int r = 0; r < 16; ++r) { negm[r] = 0.f; ol[r] = 0.f; }
    f16x8 ones;
#pragma unroll
    for (int jj = 0; jj < 8; ++jj) ones[jj] = (half_t)1.0f;
    typedef __fp16 pk_t __attribute__((ext_vector_type(2)));
    const int wq0 = 256 * qb + 32 * wid;
    const ATT_LAS unsigned long long* mlds = (const ATT_LAS unsigned long long*)(L + ATT_M);
    { ATT_LAS unsigned long long* mw_ = (ATT_LAS unsigned long long*)(L + ATT_M); const unsigned long long* mg = maskt + 256 * qb + (tid & 255);
      for (int j = tid >> 8; j < NT; j += 2) mw_[j * 256 + (tid & 255)] = mg[(size_t)j * SEQ]; }
    ATT_DMA_K(0, 0); ATT_DMA_V(0, 0); ATT_DMA_K(1, 1); ATT_DMA_V(1, 1);
    asm volatile("s_waitcnt vmcnt(2) lgkmcnt(0)" ::: "memory");
    __builtin_amdgcn_s_barrier(); asm volatile("" ::: "memory");
    int s0_ = 0, s1_ = 1, s2_ = 2;
    for (int tt = 0; tt < NT; ++tt) {
        if (tt + 2 < NT) { ATT_DMA_K(tt + 2, s2_); ATT_DMA_V(tt + 2, s2_); }
        const unsigned long long mw = mlds[tt * 256 + 32 * wid + r32];
        const int kbase = tt == 0 ? 0 : 64 * (tt - 1);
        const bool active = tt == 0 || kbase <= wq0 + 31;
        if (active) {
            f32x16 c0 = negm, c1 = negm;
            const ATT_LAS char* kb = L + ATT_K + s0_ * 8192;
#pragma unroll
            for (int d0 = 0; d0 < 4; ++d0) {
                const f16x8 k0 = *(const ATT_LAS f16x8*)(kb + foff[2 * d0 + hi]);
                const f16x8 k1 = *(const ATT_LAS f16x8*)(kb + 4096 + foff[2 * d0 + hi]);
                c0 = __builtin_amdgcn_mfma_f32_32x32x16_f16(k0, qf[d0], c0, 0, 0, 0);
                c1 = __builtin_amdgcn_mfma_f32_32x32x16_f16(k1, qf[d0], c1, 0, 0, 0);
            }
            const int dist0 = tt == 0 ? sq + 16 - 4 * hi : sq - kbase - 4 * hi;
            const bool nearb = tt == 0 ? (wq0 + 16 - 15 < 128) : (wq0 - (kbase + 63) < 128);
            if (nearb) {
#pragma unroll
                for (int r = 0; r < 16; ++r) { const int kk = (r & 3) + 8 * (r >> 2);
                    int d0_ = dist0 - kk, d1_ = dist0 - kk - 32; d0_ = d0_ < 0 ? 0 : (d0_ > 128 ? 128 : d0_); d1_ = d1_ < 0 ? 0 : (d1_ > 128 ? 128 : d1_);
                    c0[r] += dl[d0_]; c1[r] += dl[d1_]; }
            }
            const unsigned mlo = (unsigned)mw >> (4 * hi), mhi = (unsigned)(mw >> 32) >> (4 * hi);
#pragma unroll
            for (int r = 0; r < 16; ++r) { const int cb = (r & 3) + 8 * (r >> 2);
                c0[r] = ((mlo >> cb) & 1u) ? c0[r] : -INFINITY; c1[r] = ((mhi >> cb) & 1u) ? c1[r] : -INFINITY; }
            float rm = __builtin_fmaxf(__builtin_fmaxf(c0[0], c1[0]), c0[1]);
#pragma unroll
            for (int r = 1; r < 16; r += 1) rm = (r == 1) ? __builtin_fmaxf(rm, c1[1]) : __builtin_fmaxf(__builtin_fmaxf(rm, c0[r]), c1[r]);
            rm = fmaxf(rm, __shfl_xor(rm, 32));
            if (__any(rm > THR)) {
                const float dlt = fmaxf(rm, 0.f), f = __builtin_amdgcn_exp2f(-dlt);
                mhat += dlt;
#pragma unroll
                for (int r = 0; r < 16; ++r) { c0[r] -= dlt; c1[r] -= dlt; o0[r] *= f; o1[r] *= f; negm[r] = -mhat; }
                ol[0] *= f;
            }
            const ATT_LAS char* vb = L + ATT_V + s0_ * 8192;
#pragma unroll
            for (int s_ = 0; s_ < 4; ++s_) {
                unsigned pw[4];
#pragma unroll
                for (int jj = 0; jj < 4; ++jj) { const float pa = __builtin_amdgcn_exp2f((s_ < 2) ? c0[8 * (s_ & 1) + 2 * jj] : c1[8 * (s_ & 1) + 2 * jj]),
                                                             pb = __builtin_amdgcn_exp2f((s_ < 2) ? c0[8 * (s_ & 1) + 2 * jj + 1] : c1[8 * (s_ & 1) + 2 * jj + 1]);
                    pw[jj] = __builtin_bit_cast(unsigned, __builtin_amdgcn_cvt_pkrtz(pa, pb)); }
                typedef unsigned u32x4_ __attribute__((ext_vector_type(4)));
                const f16x8 pf = __builtin_bit_cast(f16x8, (u32x4_){pw[0], pw[1], pw[2], pw[3]});
                const f16x8 v0 = *(const ATT_LAS f16x8*)(vb + foff[2 * s_ + hi]); const f16x8 v1 = *(const ATT_LAS f16x8*)(vb + 4096 + foff[2 * s_ + hi]);
                o0 = __builtin_amdgcn_mfma_f32_32x32x16_f16(v0, pf, o0, 0, 0, 0); o1 = __builtin_amdgcn_mfma_f32_32x32x16_f16(v1, pf, o1, 0, 0, 0);
                ol = __builtin_amdgcn_mfma_f32_32x32x16_f16(ones, pf, ol, 0, 0, 0);
            }
        }
        if (tt + 2 < NT) asm volatile("s_waitcnt vmcnt(2) lgkmcnt(0)" ::: "memory"); else asm volatile("s_waitcnt vmcnt(0) lgkmcnt(0)" ::: "memory");
        __builtin_amdgcn_s_barrier(); asm volatile("" ::: "memory");
        { const int t_ = s0_; s0_ = s1_; s1_ = s2_; s2_ = t_; }
    }
#define ATT_STEP
#define ATT_QK
#undef ATT_STEP
#undef ATT_QK
#undef ATT_DMA_K
#undef ATT_DMA_V
    const float il = 1.0f / ol[0];
    half_t* orow = (half_t*)(P.ws + OFF_HA) + ((size_t)b * SEQ + sq) * D + h * 64;
#pragma unroll
    for (int g = 0; g < 4; ++g) { f16x4 a, c;
#pragma unroll
        for (int e = 0; e < 4; ++e) { a[e] = (half_t)(o0[4 * g + e] * il); c[e] = (half_t)(o1[4 * g + e] * il); }
        *(f16x4*)(orow + 8 * g + 4 * hi) = a; *(f16x4*)(orow + 32 + 8 * g + 4 * hi) = c; }
}
DEVFN void attn_meta_rows(const Params& P, int bid, int nb) {
    const half_t* proj = (const half_t*)(P.ws + OFF_BIG); half_t* AO = (half_t*)(P.ws + OFF_HA);
    const int tid = tid_opaque() & 255, sub = tid_opaque() >> 8, head = tid >> 4;
    for (int mrow = 2 * bid + sub; mrow < NMETA; mrow += 2 * nb) {
        const int r = MX + mrow;
        float q[4]; { const f16x4 qv = *(const f16x4*)(proj + (size_t)r * NPROJ + tid * 4); q[0] = (float)qv[0]; q[1] = (float)qv[1]; q[2] = (float)qv[2]; q[3] = (float)qv[3]; }
        float m = -1e30f, l = 0.f, o[4] = {0.f, 0.f, 0.f, 0.f};
        for (int p = 0; p <= mrow; ++p) {
            const half_t* kr = proj + (size_t)(MX + p) * NPROJ + tid * 4;
            const f16x4 kv = *(const f16x4*)(kr + COL_K), vv = *(const f16x4*)(kr + COL_V);
            float d = q[0] * (float)kv[0] + q[1] * (float)kv[1] + q[2] * (float)kv[2] + q[3] * (float)kv[3];
            d += __shfl_xor(d, 1); d += __shfl_xor(d, 2); d += __shfl_xor(d, 4); d += __shfl_xor(d, 8);
            const float s = d + P.rel_bias[t5_bucket(mrow - p) * 16 + head] * LOG2E;
            const float mn = fmaxf(m, s), corr = __builtin_amdgcn_exp2f(m - mn), pe = __builtin_amdgcn_exp2f(s - mn);
            l = l * corr + pe;
#pragma unroll
            for (int c = 0; c < 4; ++c) o[c] = o[c] * corr + pe * (float)vv[c];
            m = mn;
        }
        const float il = 1.0f / l; f16x4 hh; hh[0] = (half_t)(o[0] * il); hh[1] = (half_t)(o[1] * il); hh[2] = (half_t)(o[2] * il); hh[3] = (half_t)(o[3] * il);
        *(f16x4*)(AO + (size_t)r * D + tid * 4) = hh;
    }
}
DEVFN void phase_attn(const Params& P, char* lds, int bid, int nb) {
    attn_meta_rows(P, bid, nb);
    for (int bh = bid; bh < NBATCH * 16; bh += nb)
        for (int qb = 7; qb >= 0; --qb) attn_unit(P, lds, bh >> 4, bh & 15, qb);
}

typedef float f32x2 __attribute__((ext_vector_type(2)));
DEVFN void phase_conv(const Params& P, char* lds, int bid, int nb) {
    const half_t* U = (const half_t*)(P.ws + OFF_BIG); half_t* C = (half_t*)(P.ws + OFF_C);
    const int tid = tid_opaque(), lane = tid & 63, wid = __builtin_amdgcn_readfirstlane(tid >> 6);
    const int c0 = 128 * wid + 2 * lane;
    float* ys = (float*)lds;
    f32x2 w[31];
#pragma unroll
    for (int k = 0; k < 31; ++k) w[k] = *(const f32x2*)(P.w_dw + (size_t)k * D + c0);
    const f32x2 bias = *(const f32x2*)(P.b_dw + c0);
    for (int unit = bid; unit < NBATCH * (SEQ / 32); unit += nb) {
        const int b = unit >> 6, sbase = 32 * (unit & 63);
        f32x2 uw[62];
#pragma unroll
        for (int wi = 0; wi < 62; ++wi) { const int sx = sbase - 30 + wi;
            const int row = sx >= 0 ? b * SEQ + sx : MX + (sx + 16 >= 0 ? sx + 16 : 0);
            const f16x2 ld_ = *(const f16x2*)(U + (size_t)row * D + c0);
            uw[wi] = sx + 16 >= 0 ? (f32x2){(float)ld_[0], (float)ld_[1]} : (f32x2){0.f, 0.f}; }
#pragma unroll
        for (int i = 0; i < 32; ++i) { f32x2 a = bias;
#pragma unroll
            for (int k = 0; k < 31; ++k) a = w[k] * uw[i + k] + a;
            *(f32x2*)(ys + i * D + c0) = a; }
        __syncthreads();
#pragma unroll 1
        for (int tt = 0; tt < 4; ++tt) { const int i = 4 * wid + tt;
            f32x4 y[4]; float s = 0.f;
#pragma unroll
            for (int q = 0; q < 4; ++q) { y[q] = *(const f32x4*)(ys + i * D + 4 * lane + 256 * q); s += (y[q][0] + y[q][1]) + (y[q][2] + y[q][3]); }
            const float mean = wave_sum(s) * (1.f / D); float qv = 0.f;
#pragma unroll
            for (int q = 0; q < 4; ++q) { y[q] = y[q] - mean; qv += (y[q][0] * y[q][0] + y[q][1] * y[q][1]) + (y[q][2] * y[q][2] + y[q][3] * y[q][3]); }
            const float rstd = 1.0f / sqrtf(wave_sum(qv) * (1.f / D) + LN_EPS);
            half_t* orow = C + ((size_t)b * SEQ + sbase + i) * D + 4 * lane;
#pragma unroll
            for (int q = 0; q < 4; ++q) { const f32x4 z = y[q] * rstd * *(const f32x4*)(P.cln_g + 4 * lane + 256 * q) + *(const f32x4*)(P.cln_b + 4 * lane + 256 * q); const f32x4 o = silu4(z);
                f16x4 h; h[0] = (half_t)o[0]; h[1] = (half_t)o[1]; h[2] = (half_t)o[2]; h[3] = (half_t)o[3];
                *(f16x4*)(orow + 256 * q) = h; }
        }
        __syncthreads();
    }
}

#define XB_TMO      128
#define XB_XCNT(j)  (256  + 64 * (j))
#define XB_XSUB(j)  (1280 + 64 * (j))
#define XB_XGEN(j)  (2304 + 64 * (j))
#define XB_TOP      3328
#define XB_TOPGEN   3392
#define XCD_BAR_WORDS 3456
#define XB_SPIN_CAP (1u << 18)
#define XB_LAS __attribute__((address_space(3)))
__device__ __forceinline__ unsigned xb_ld(unsigned* p)              { return __hip_atomic_load(p, __ATOMIC_RELAXED, __HIP_MEMORY_SCOPE_AGENT); }
__device__ __forceinline__ unsigned xb_add(unsigned* p, unsigned v) { return __hip_atomic_fetch_add(p, v, __ATOMIC_RELAXED, __HIP_MEMORY_SCOPE_AGENT); }
__device__ __forceinline__ unsigned xb_xcc_id() { return (unsigned)__builtin_amdgcn_s_getreg((3 << 11) | 20) & 0xFu; }
#define XB_SPIN(cond, bar) do { unsigned _sp = 0; while (cond) { __builtin_amdgcn_s_sleep(1); \
    if ((++_sp & 255u) == 0u) { if (xb_ld(&(bar)[XB_TMO])) break; if (_sp > XB_SPIN_CAP) { atomicAdd(&(bar)[XB_TMO], 1u); break; } } } } while (0)
struct XcdBarrier { unsigned* bar; unsigned x; volatile XB_LAS unsigned* st; };
__device__ __forceinline__ XcdBarrier xcd_barrier_post(unsigned* bar, volatile XB_LAS unsigned* st) {
    XcdBarrier b; b.bar = bar; b.x = xb_xcc_id(); b.st = st;
    if (threadIdx.x == 0) (void)xb_add(&bar[XB_XCNT(b.x)], 1u);
    return b;
}
__device__ __forceinline__ void xcd_barrier_complete(unsigned* bar, unsigned x, unsigned& nloc, unsigned& nx) {
    const unsigned G = gridDim.x * gridDim.y * gridDim.z;
    unsigned sum, cnt, mine, sp = 0u;
    for (;;) {
        sum = 0u; cnt = 0u; mine = 0u;
#pragma unroll
        for (unsigned j = 0; j < 16; ++j) { const unsigned c = xb_ld(&bar[XB_XCNT(j)]); sum += c; cnt += (c > 0u) ? 1u : 0u; mine = (j == x) ? c : mine; }
        if (sum == G) break;
        __builtin_amdgcn_s_sleep(1);
        if ((++sp & 255u) == 0u) { if (xb_ld(&bar[XB_TMO])) break; if (sp > XB_SPIN_CAP) { atomicAdd(&bar[XB_TMO], 1u); break; } }
    }
    nloc = mine > 0u ? mine : 1u; nx = cnt > 0u ? cnt : 1u;
}
__device__ __forceinline__ void xcd_barrier(const XcdBarrier& b) {
    asm volatile("s_waitcnt vmcnt(0)" ::: "memory");
    __syncthreads();
    if (threadIdx.x == 0) {
        unsigned* bar = b.bar;
        __builtin_amdgcn_s_waitcnt(0);
        unsigned nloc = b.st[0], nx = b.st[1];
        if (nloc == 0u) { xcd_barrier_complete(bar, b.x, nloc, nx); b.st[0] = nloc; b.st[1] = nx; }
        const unsigned old = xb_add(&bar[XB_XSUB(b.x)], 1u);
        const unsigned gen = old / nloc;
        if (old + 1u == (gen + 1u) * nloc) {
            __builtin_amdgcn_fence(__ATOMIC_RELEASE, "agent");
            asm volatile("s_waitcnt vmcnt(0)" ::: "memory");
            const unsigned og = xb_add(&bar[XB_TOP], 1u);
            const unsigned tg = og / nx;
            if (og + 1u == (tg + 1u) * nx) xb_add(&bar[XB_TOPGEN], 1u);
            else XB_SPIN(xb_ld(&bar[XB_TOPGEN]) == tg, bar);
            __builtin_amdgcn_fence(__ATOMIC_ACQUIRE, "agent");
            xb_add(&bar[XB_XGEN(b.x)], 1u);
            asm volatile("s_waitcnt vmcnt(0)" ::: "memory");
        } else {
            XB_SPIN(xb_ld(&bar[XB_XGEN(b.x)]) == gen, bar);
            __builtin_amdgcn_fence(__ATOMIC_ACQUIRE, "agent");
            asm volatile("s_waitcnt vmcnt(0)" ::: "memory");
        }
    }
    __syncthreads();
}
constexpr int MISC_OFF = 147456 - 16;

constexpr int N_PHASES = 13;
constexpr int LDS_BYTES = 147456;
static_assert(pg8::STAGE_BYTES == 131072, "LDS");

DEVFN void run_phase(const Params& P, int ph, char* lds, int bid, int nb) {
    unsigned char* ws = P.ws;
    half_t* HA = (half_t*)(ws + OFF_HA); half_t* BIG = (half_t*)(ws + OFF_BIG); half_t* CB = (half_t*)(ws + OFF_C); half_t* Y = (half_t*)(ws + OFF_Y);
    float* ST0 = (float*)(ws + OFF_ST0); float* ST1 = (float*)(ws + OFF_ST1); const float* C1 = (const float*)(ws + OFF_C1); const float* C2 = (const float*)(ws + OFF_C2);
    switch (ph) {
    case 0: phase_prep(P, lds, bid, nb); break;
    case 1: gemm_phase(HA, (const half_t*)(ws + OFF_W_IN), MP, NPROJ, D, EpiProj{BIG, NPROJ, (half_t*)P.out, (half_t*)P.out + VT_ELEMS}, lds, bid, nb); break;
    case 2: finish_colconsts(P, bid, nb); phase_indexer(P, lds, bid, nb); break;
    case 3: phase_attn(P, lds, bid, nb); break;
    case 4: meta_rows_gemm<0>(P, HA, (const half_t*)(ws + OFF_W_O), D, nullptr, ST0, nullptr, nullptr, nullptr, nullptr, nullptr, Y, lds, bid);
            gemm_phase(HA, (const half_t*)(ws + OFF_W_O), MX, D, D, EpiResidX{P.x, P.meta, Y, ST0}, lds, bid, nb); break;
    case 5: meta_rows_gemm<1>(P, Y, (const half_t*)(ws + OFF_W_GU0), D, ST0, nullptr, C1 + NC_GU0, C2 + NC_GU0, nullptr, nullptr, nullptr, BIG, lds, bid);
            gemm_phase(Y, (const half_t*)(ws + OFF_W_GU0), MX, 2 * DFF, D, EpiLnSwiGLU{BIG, DFF, ST0, C1 + NC_GU0, C2 + NC_GU0, lds}, lds, bid, nb); break;
    case 6: meta_rows_gemm<2>(P, BIG, (const half_t*)(ws + OFF_W_D0), DFF, ST0, ST1, nullptr, nullptr, P.ln1_g, P.ln1_b, nullptr, Y, lds, bid);
            gemm_phase(BIG, (const half_t*)(ws + OFF_W_D0), MX, D, DFF, EpiResidLN{Y, ST0, ST1, P.ln1_g, P.ln1_b, nullptr, lds}, lds, bid, nb); break;
    case 7: meta_rows_gemm<3>(P, Y, (const half_t*)(ws + OFF_W_PW1), D, ST1, nullptr, C1 + NC_PW1, C2 + NC_PW1, nullptr, nullptr, nullptr, BIG, lds, bid);
            gemm_phase(Y, (const half_t*)(ws + OFF_W_PW1), MX, 2 * D, D, EpiLnGLU{BIG, D, ST1, C1 + NC_PW1, C2 + NC_PW1, lds}, lds, bid, nb); break;
    case 8: phase_conv(P, lds, bid, nb); break;
    case 9: gemm_phase(CB, (const half_t*)(ws + OFF_W_PW2), MX, D, D, EpiResidLN{Y, ST1, ST0, P.ln2_g, P.ln2_b, P.b_pw2, lds}, lds, bid, nb); break;
    case 10: gemm_phase(Y, (const half_t*)(ws + OFF_W_GU1), MX, 2 * DFF, D, EpiLnSwiGLU{BIG, DFF, ST0, C1 + NC_GU1, C2 + NC_GU1, lds}, lds, bid, nb); break;
    case 11: gemm_phase(BIG, (const half_t*)(ws + OFF_W_D1), MX, D, DFF, EpiResidLN{Y, ST0, ST1, P.ln1_g + D, P.ln1_b + D, nullptr, lds}, lds, bid, nb); break;
    case 12: phase_final_ln(P, ST1, P.ln2_g + D, P.ln2_b + D, bid, nb); break;
    default: break;
    }
}

#if MODE_COOP
__global__ void __launch_bounds__(NTHREADS, 2) fwd_mega(Params P) {
    extern __shared__ __attribute__((aligned(16))) char lds[];
    cg::grid_group grid = cg::this_grid();
    volatile XB_LAS unsigned* misc = (volatile XB_LAS unsigned*)((XB_LAS char*)lds + MISC_OFF);
    if (threadIdx.x < 4) misc[threadIdx.x] = 0u;
    __syncthreads();
    const XcdBarrier bar = xcd_barrier_post((unsigned*)(P.ws + OFF_CTL), misc);
#define PHASE(k) run_phase(P, k, lds, blockIdx.x, gridDim.x)
#define SEAM() xcd_barrier(bar)
    PHASE(0); grid.sync();
    PHASE(1); SEAM(); PHASE(2); SEAM(); PHASE(3); SEAM(); PHASE(4); SEAM(); PHASE(5); SEAM(); PHASE(6); SEAM(); PHASE(7); SEAM();
    PHASE(8); SEAM(); PHASE(9); SEAM(); PHASE(10); SEAM(); PHASE(11); SEAM(); PHASE(12);
#undef PHASE
#undef SEAM
}
#else
template <int PH> __global__ void __launch_bounds__(NTHREADS, 2) fwd_phase(Params P) {
    extern __shared__ __attribute__((aligned(16))) char lds[];
    run_phase(P, PH, lds, blockIdx.x, gridDim.x);
}
template <int PH> static void launch_phases(const Params& p, hipStream_t stream) {
    hipFuncSetAttribute((const void*)fwd_phase<PH>, hipFuncAttributeMaxDynamicSharedMemorySize, LDS_BYTES);
    hipLaunchKernelGGL(fwd_phase<PH>, dim3(256), dim3(NTHREADS), LDS_BYTES, stream, p);
    if constexpr (PH + 1 < N_PHASES) launch_phases<PH + 1>(p, stream);
}
#endif

extern "C" void kernel_launch(void* const* d_in, const int* in_sizes, int n_in, void* d_out, int out_size, void* d_ws, size_t ws_size, hipStream_t stream) {
    if (n_in != 20 || ws_size < WS_END || out_size != MX * D) { fprintf(stderr, "kernel_launch: unexpected sizes n_in %d ws %zu out %d\n", n_in, ws_size, out_size); return; }
    Params p{};
    const float** pp = (const float**)&p;
    for (int i = 0; i < 20; ++i) pp[i] = (const float*)d_in[i];
    p.out = (float*)d_out; p.ws = (unsigned char*)d_ws;
#if MODE_COOP
    static int grid_blocks = 0;
    if (!grid_blocks) {
        int dev = 0, cus = 0, per_cu = 0;
        hipGetDevice(&dev); hipDeviceGetAttribute(&cus, hipDeviceAttributeMultiprocessorCount, dev);
        hipFuncSetAttribute((const void*)fwd_mega, hipFuncAttributeMaxDynamicSharedMemorySize, LDS_BYTES);
        hipOccupancyMaxActiveBlocksPerMultiprocessor(&per_cu, fwd_mega, NTHREADS, LDS_BYTES);
        if (per_cu < 1) per_cu = 1;
        grid_blocks = cus * per_cu;
    }
    hipMemsetAsync((char*)d_ws + OFF_CTL, 0, XCD_BAR_WORDS * 4, stream);
    void* args[] = {&p};
    hipError_t e = hipLaunchCooperativeKernel((void*)fwd_mega, dim3(grid_blocks), dim3(NTHREADS), args, LDS_BYTES, stream);
    if (e != hipSuccess) fprintf(stderr, "cooperative launch failed: %s (grid %d)\n", hipGetErrorString(e), grid_blocks);
#else
    launch_phases<0>(p, stream);
#endif
}
```
